# Optimizing an MI355X kernel written in HIP

```python
import jax, jax.numpy as jnp
from jax import lax
import numpy as np

D_MODEL = 4096
BATCH = 4
SEQ = 2048
DEPTH = 2
DEC_BATCH = 32
DEC_SEQ = 4
PAST_LEN = 16384
PAGE_SIZE = 128

HEAD_DIM = 64
D_ATTN = D_MODEL // 2
N_Q_HEADS = D_ATTN // HEAD_DIM
N_KV_HEADS = N_Q_HEADS // 8
GQA_GROUP = N_Q_HEADS // N_KV_HEADS
D_KV = N_KV_HEADS * HEAD_DIM
WINDOW = 128
D_SGU = D_MODEL // 2
N_SGU_GROUPS = 8
SGU_GROUP_DIM = D_SGU // N_SGU_GROUPS
CHUNK = 128
ALPHA = (2 * DEPTH) ** 0.25
BETA = (8 * DEPTH) ** -0.25
LN_EPS = 1e-5
COL_SIZES = (D_ATTN, D_KV, D_KV, D_ATTN, D_SGU, D_SGU, D_SGU, D_MODEL, D_MODEL)
IN_COLS = D_ATTN + 2 * D_KV + D_ATTN + 3 * D_SGU + 2 * D_MODEL

kernel_name = "hybrid_swa_sink_chunk_sgu_decoder_step"


def layer_norm(x, gain, bias):
    xf = x.astype(jnp.float32)
    mu = jnp.mean(xf, axis=-1, keepdims=True)
    var = jnp.mean(jnp.square(xf - mu), axis=-1, keepdims=True)
    return ((xf - mu) * lax.rsqrt(var + LN_EPS)).astype(x.dtype) * gain + bias


def split_cols(proj):
    idx = np.cumsum(np.array(COL_SIZES))[:-1].tolist()
    return jnp.split(proj, idx, axis=-1)


def window_attention(q, k, v, sinks, q_pos, k_pos):
    scores = jnp.einsum('bnqkgd,bnlkd->bnkgql', q, k).astype(jnp.float32) * (HEAD_DIM ** -0.5)
    rel = q_pos[:, :, None] - k_pos[:, None, :]
    valid = (rel >= 0) & (rel < WINDOW) & (k_pos[:, None, :] >= 0)
    scores = jnp.where(valid[None, :, None, None], scores, -jnp.inf)
    sink = jnp.broadcast_to(sinks.astype(jnp.float32).reshape(1, 1, N_KV_HEADS, GQA_GROUP, 1, 1),
                            scores.shape[:-1] + (1,))
    probs = jax.nn.softmax(jnp.concatenate([scores, sink], axis=-1), axis=-1)[..., :-1]
    return jnp.einsum('bnkgql,bnlkd->bnqkgd', probs.astype(v.dtype), v)


def trunk_layer(x, c, w_ada, b_ada, w_in, sinks, sgu_g, sgu_b, w_s, b_s, w_pa, w_pb, w_o, ln_g, ln_b,
                cache_k=None, cache_v=None):
    B, T, _ = x.shape
    mod = jax.nn.silu(c) @ w_ada + b_ada
    shift, scale, gate = jnp.split(mod, 3, axis=-1)
    h = x * (1 + scale[:, None]) + shift[:, None]
    q, k, v, z_a, u, v_b, z_b, g_a, g_b = split_cols(h @ w_in)
    q = q.reshape(B, T, N_KV_HEADS, GQA_GROUP, HEAD_DIM)
    k = k.reshape(B, T, N_KV_HEADS, HEAD_DIM)
    v = v.reshape(B, T, N_KV_HEADS, HEAD_DIM)
    v_b = layer_norm(v_b, sgu_g, sgu_b)
    w_masked = w_s * jnp.tril(jnp.ones((CHUNK, CHUNK), w_s.dtype))
    if cache_k is None:
        nb = T // WINDOW
        pad = ((0, 0), (WINDOW, 0), (0, 0), (0, 0))
        kp = jnp.pad(k, pad).reshape(B, nb + 1, WINDOW, N_KV_HEADS, HEAD_DIM)
        vp = jnp.pad(v, pad).reshape(B, nb + 1, WINDOW, N_KV_HEADS, HEAD_DIM)
        k_blk = jnp.concatenate([kp[:, :-1], kp[:, 1:]], axis=2)
        v_blk = jnp.concatenate([vp[:, :-1], vp[:, 1:]], axis=2)
        q_blk = q.reshape(B, nb, WINDOW, N_KV_HEADS, GQA_GROUP, HEAD_DIM)
        starts = jnp.arange(nb) * WINDOW
        q_pos = starts[:, None] + jnp.arange(WINDOW)[None]
        k_pos = starts[:, None] - WINDOW + jnp.arange(2 * WINDOW)[None]
        attn = window_attention(q_blk, k_blk, v_blk, sinks, q_pos, k_pos)
        vc = v_b.reshape(B, T // CHUNK, CHUNK, N_SGU_GROUPS, SGU_GROUP_DIM)
        s = jnp.einsum('gts,bnsgc->bntgc', w_masked, vc) + b_s.T[None, None, :, :, None]
    else:
        k_blk = jnp.concatenate([cache_k, k], axis=1)[:, None]
        v_blk = jnp.concatenate([cache_v, v], axis=1)[:, None]
        q_pos = (PAST_LEN + jnp.arange(T))[None]
        k_pos = (PAST_LEN - WINDOW + jnp.arange(WINDOW + T))[None]
        attn = window_attention(q[:, None], k_blk, v_blk, sinks, q_pos, k_pos)
        vc = v_b.reshape(B, T, N_SGU_GROUPS, SGU_GROUP_DIM)
        s = jnp.einsum('gts,bsgc->btgc', w_masked[:, :T, :T], vc) + b_s[:, :T].T[None, :, :, None]
    attn = attn.reshape(B, T, D_ATTN) * jax.nn.silu(z_a)
    out_b = u * s.reshape(B, T, D_SGU) * jax.nn.silu(z_b)
    merged = jax.nn.sigmoid(g_a) * (attn @ w_pa) + jax.nn.sigmoid(g_b) * (out_b @ w_pb)
    y = merged @ w_o
    x = layer_norm(ALPHA * x + gate[:, None] * y, ln_g, ln_b)
    return x, k, v, v_b


def setup_inputs(seed: int = 0) -> dict:
    key = jax.random.key(seed)
    ks = jax.random.split(key, 20)
    f32 = jnp.float32
    nrm = lambda k, shape, s: jax.random.normal(k, shape, f32) * s
    return {
        "x_prompt": nrm(ks[0], (BATCH, SEQ, D_MODEL), 1.0),
        "x_sample": nrm(ks[1], (DEC_BATCH, DEC_SEQ, D_MODEL), 1.0),
        "cache_k": nrm(ks[2], (DEPTH, DEC_BATCH, WINDOW, N_KV_HEADS, HEAD_DIM), 1.0),
        "cache_v": nrm(ks[3], (DEPTH, DEC_BATCH, WINDOW, N_KV_HEADS, HEAD_DIM), 1.0),
        "c_prompt": nrm(ks[4], (BATCH, D_MODEL), 1.0),
        "c_sample": nrm(ks[5], (DEC_BATCH, D_MODEL), 1.0),
        "w_ada": nrm(ks[6], (DEPTH, D_MODEL, 3 * D_MODEL), 0.5 * D_MODEL ** -0.5),
        "b_ada": nrm(ks[7], (DEPTH, 3 * D_MODEL), 0.02),
        "w_in": nrm(ks[8], (DEPTH, D_MODEL, IN_COLS), D_MODEL ** -0.5),
        "attn_sinks": nrm(ks[9], (DEPTH, N_Q_HEADS), 1.0),
        "sgu_ln_gain": 1.0 + nrm(ks[10], (DEPTH, D_SGU), 0.05),
        "sgu_ln_bias": nrm(ks[11], (DEPTH, D_SGU), 0.02),
        "sgu_w_s": nrm(ks[12], (DEPTH, N_SGU_GROUPS, CHUNK, CHUNK), 0.5 * CHUNK ** -0.5),
        "sgu_b_s": 1.0 + nrm(ks[13], (DEPTH, N_SGU_GROUPS, CHUNK), 0.1),
        "w_pa": nrm(ks[14], (DEPTH, D_ATTN, D_MODEL), BETA * D_ATTN ** -0.5),
        "w_pb": nrm(ks[15], (DEPTH, D_SGU, D_MODEL), BETA * D_SGU ** -0.5),
        "w_o": nrm(ks[16], (DEPTH, D_MODEL, D_MODEL), BETA * D_MODEL ** -0.5),
        "ln_gain": 1.0 + nrm(ks[17], (DEPTH, D_MODEL), 0.05),
        "ln_bias": nrm(ks[18], (DEPTH, D_MODEL), 0.02),
    }


def reference(x_prompt, x_sample, cache_k, cache_v, c_prompt, c_sample, w_ada, b_ada, w_in, attn_sinks,
              sgu_ln_gain, sgu_ln_bias, sgu_w_s, sgu_b_s, w_pa, w_pb, w_o, ln_gain, ln_bias):
    xp, xs = x_prompt, x_sample
    win_k_p, win_v_p, new_k_s, new_v_s, sgu_v_s = [], [], [], [], []
    for l in range(DEPTH):
        params = (w_ada[l], b_ada[l], w_in[l], attn_sinks[l], sgu_ln_gain[l], sgu_ln_bias[l],
                  sgu_w_s[l], sgu_b_s[l], w_pa[l], w_pb[l], w_o[l], ln_gain[l], ln_bias[l])
        xp, kp, vp, _ = trunk_layer(xp, c_prompt, *params)
        xs, ks_, vs_, vbs = trunk_layer(xs, c_sample, *params, cache_k=cache_k[l], cache_v=cache_v[l])
        win_k_p.append(kp[:, -WINDOW:])
        win_v_p.append(vp[:, -WINDOW:])
        new_k_s.append(ks_)
        new_v_s.append(vs_)
        sgu_v_s.append(vbs)
    win_k_prompt = jnp.stack(win_k_p)
    win_v_prompt = jnp.stack(win_v_p)
    new_k_sample = jnp.stack(new_k_s)
    new_v_sample = jnp.stack(new_v_s)
    sgu_v_sample = jnp.stack(sgu_v_s)
    return (xp, xs, win_k_prompt, win_v_prompt, new_k_sample, new_v_sample, sgu_v_sample)
```

```cpp
#include <hip/hip_runtime.h>
#include <cstdio>
#include <cstdint>

namespace pg8 {
#define PG8_LAS __attribute__((address_space(3)))
typedef unsigned short bf16_t;
typedef short bf16x8 __attribute__((ext_vector_type(8)));
typedef float f32x4 __attribute__((ext_vector_type(4)));
typedef unsigned u32x4 __attribute__((ext_vector_type(4)));
typedef unsigned u32x2 __attribute__((ext_vector_type(2)));
typedef int v4i_t __attribute__((ext_vector_type(4)));
constexpr int BM = 256, BK = 64, HALF = 128, HTB = HALF * BK * 2  , STAGE_BYTES = 8 * HTB, NXCD = 8, WGM = 8;

__host__ __device__ __forceinline__ int lds_byte(int r, int c) { const int st = (r >> 4) * 2 + (c >> 5), rr = r & 15, cc = c & 31, ob = rr * 64 + cc * 2; return st * 1024 + (ob ^ (((ob >> 9) & 1) << 5)); }
__host__ __device__ __forceinline__ void stage_rc(int b, int& R, int& C) { const int st = b / 1024, sb = b % 1024, swz = sb ^ (((sb >> 9) & 1) << 5); R = (st >> 1) * 16 + swz / 64; C = (st & 1) * 32 + (swz % 64) / 2; }
__host__ __device__ __forceinline__ int perm32(int rho) { const int n = rho >> 4, i = rho & 15; return 8 * (i >> 2) + 4 * n + (i & 3); }

struct Unit { int pm, pn; };
struct Gemm { const bf16_t* A; const bf16_t* Bt; int M, N, K; };

template <int MC, int NC> struct StaticOrderC {
    static constexpr int nM = MC / BM, nN = NC / BM, nwg = nM * nN;
    int G, c;
    __host__ __device__ void init(int G_, int c_) { G = G_; c = c_; }
    __host__ __device__ static void map(int L, Unit& u) {
        int wgid = L; { constexpr int q = nwg / NXCD, r = nwg % NXCD; const int xcd = wgid % NXCD, off = wgid / NXCD; wgid = (xcd < r ? xcd * (q + 1) : r * (q + 1) + (xcd - r) * q) + off; }
        constexpr int nig = WGM * nN; const int gid = wgid / nig, fm = gid * WGM, gsz = (nM - fm) < WGM ? (nM - fm) : WGM;
        u.pm = fm + ((wgid % nig) % gsz); u.pn = (wgid % nig) / gsz;
    }
    __host__ __device__ bool next(int i, Unit& u) const {
        const int L = i * G + c; if (L >= nwg) return false;
        int wgid = L; { constexpr int q = nwg / NXCD, r = nwg % NXCD; const int xcd = wgid % NXCD, off = wgid / NXCD; wgid = (xcd < r ? xcd * (q + 1) : r * (q + 1) + (xcd - r) * q) + off; }
        constexpr int nig = WGM * nN; const int gid = wgid / nig, fm = gid * WGM, gsz = (nM - fm) < WGM ? (nM - fm) : WGM;
        u.pm = fm + ((wgid % nig) % gsz); u.pn = (wgid % nig) / gsz; return true;
    }
    __device__ __forceinline__ void a_ready(const Unit&) const {}
    __device__ __forceinline__ void done(const Unit&) const {}
};

__device__ __forceinline__ unsigned cvt_pk_bf16(float lo, float hi) { unsigned r; asm volatile("v_cvt_pk_bf16_f32 %0, %1, %2" : "=v"(r) : "v"(lo), "v"(hi)); return r; }

template <int KC, int LD, class Epi, class Sched, bool ALIGN_EPI = false, bool SP2 = false, bool HM = false, bool F8 = false>
__device__ __forceinline__ void gemm_phase(PG8_LAS unsigned char* lds, const Gemm g, const Sched& S, const Epi& E, const int wid_) {
    const int wid = __builtin_amdgcn_readfirstlane(wid_);
    int lane_; asm volatile("v_mbcnt_lo_u32_b32 %0, -1, 0\n\tv_mbcnt_hi_u32_b32 %0, -1, %0" : "=v"(lane_));
    const int lane = lane_, tid = wid * 64 + lane, wr = wid >> 2, wc = wid & 3, fr = lane & 15, fq = lane >> 4;
    constexpr int K = KC, nt = K / BK;
    unsigned voffA[2], voffB[2];
#pragma unroll
    for (int i = 0; i < 2; ++i) { int R, C; stage_rc(tid * 16 + i * 8192, R, C); const int Rb = Epi::PERM ? ((R & ~31) + perm32(R & 31)) : R;
        voffA[i] = (unsigned)(R * LD + C) * 2u; voffB[i] = (unsigned)(Rb * LD + C) * 2u; }
    constexpr unsigned kstep = (unsigned)(BK * 2);
    constexpr unsigned hstep = (unsigned)(HALF * LD * 2);
    constexpr unsigned tstep = 2 * hstep;
    const __amdgpu_buffer_rsrc_t rA = __builtin_amdgcn_make_buffer_rsrc((void*)g.A, 0, 0x7fffffff, 0x00020000), rB = __builtin_amdgcn_make_buffer_rsrc((void*)g.Bt, 0, 0x7fffffff, 0x00020000);
    const unsigned ldsw = (unsigned)wid * 1024u;
    const int aoff = lds_byte(wr * 64 + fr, fq * 8), boff = lds_byte(wc * 32 + fr, fq * 8);
#define PG8_SA(b, h) (((b) * 2 + (h)) * HTB)
#define PG8_SB(b, h) ((4 + (b) * 2 + (h)) * HTB)
#define PG8_STAGE_R(rs, bufoff, goff, voff) do { _Pragma("unroll") for (int _i = 0; _i < 2; ++_i) \
        __builtin_amdgcn_raw_ptr_buffer_load_lds(rs, (PG8_LAS unsigned*)(lds + (bufoff) + ldsw + _i * 8192), 16, (voff)[_i], (int)(goff), 0, 0); } while (0)
#define PG8_STAGE_A(bufoff, goff, voff) PG8_STAGE_R(rA, bufoff, goff, voff)
#define PG8_STAGE_B(bufoff, goff, voff) PG8_STAGE_R(rB, bufoff, goff, voff)
#define PG8_LDA(dst, b, h) do { _Pragma("unroll") for (int m = 0; m < 4; ++m) _Pragma("unroll") for (int k = 0; k < 2; ++k) dst[m][k] = *(const PG8_LAS bf16x8*)(lds + PG8_SA(b, h) + aoff + m * 2048 + k * 1024); } while (0)
#define PG8_LDB(dst, b, h) do { _Pragma("unroll") for (int n = 0; n < 2; ++n) _Pragma("unroll") for (int k = 0; k < 2; ++k) dst[n][k] = *(const PG8_LAS bf16x8*)(lds + PG8_SB(b, h) + boff + n * 2048 + k * 1024); } while (0)
#define PG8_CAT(x0, x1) __builtin_shufflevector(__builtin_bit_cast(v4i_t, x0), __builtin_bit_cast(v4i_t, x1), 0, 1, 2, 3, 4, 5, 6, 7)
#define PG8_MMA(ai, bj, At, Bt) do { __builtin_amdgcn_s_setprio(1); if constexpr (F8) { _Pragma("unroll") for (int m = 0; m < 4; ++m) _Pragma("unroll") for (int n = 0; n < 2; ++n) \
        acc[ai][bj][m][n] = __builtin_amdgcn_mfma_scale_f32_16x16x128_f8f6f4(PG8_CAT(Bt[n][0], Bt[n][1]), PG8_CAT(At[m][0], At[m][1]), acc[ai][bj][m][n], 0, 0, 0, 0x7f7f7f7f, 0, 0x7f7f7f7f); } \
        else { _Pragma("unroll") for (int m = 0; m < 4; ++m) _Pragma("unroll") for (int n = 0; n < 2; ++n) _Pragma("unroll") for (int k = 0; k < 2; ++k) \
        acc[ai][bj][m][n] = __builtin_amdgcn_mfma_f32_16x16x32_bf16(Bt[n][k], At[m][k], acc[ai][bj][m][n], 0, 0, 0); } __builtin_amdgcn_s_setprio(0); } while (0)
#define PG8_WAIT_V(n) asm volatile("s_waitcnt vmcnt(" #n ")" ::: "memory")
#define PG8_WAIT_L(n) asm volatile("s_waitcnt lgkmcnt(" #n ")" ::: "memory")
#define PG8_BAR __builtin_amdgcn_s_barrier()
#define PG8_SCHED __builtin_amdgcn_sched_barrier(0)
    Unit cur, nxt; int ui = 0;
    if (!S.next(0, cur)) return;
    f32x4 acc[2][2][4][2];
#pragma unroll
    for (int a = 0; a < 2; ++a)
#pragma unroll
        for (int b = 0; b < 2; ++b)
#pragma unroll
            for (int m = 0; m < 4; ++m)
#pragma unroll
                for (int n = 0; n < 2; ++n) acc[a][b][m][n] = (f32x4){0.f, 0.f, 0.f, 0.f};
    bf16x8 At[4][2], B0[2][2], B1[2][2];
    constexpr unsigned astep = HM ? hstep : tstep;
    unsigned cA = (unsigned)cur.pm * astep, cB = (unsigned)cur.pn * tstep;
    S.a_ready(cur);
    if constexpr (SP2) {
        PG8_STAGE_B(PG8_SB(0, 0), cB, voffB); PG8_STAGE_B(PG8_SB(0, 1), cB + hstep, voffB); PG8_STAGE_A(PG8_SA(0, 0), cA, voffA); PG8_STAGE_A(PG8_SA(0, 1), cA + hstep, voffA);
        if (wr == 1) PG8_BAR;
        PG8_WAIT_V(2); PG8_BAR;
        PG8_STAGE_B(PG8_SB(1, 0), cB + kstep, voffB); PG8_STAGE_A(PG8_SA(1, 0), cA + kstep, voffA); PG8_STAGE_B(PG8_SB(1, 1), cB + hstep + kstep, voffB);
        PG8_WAIT_V(6); PG8_BAR;
    } else {
        PG8_STAGE_B(PG8_SB(0, 0), cB, voffB); PG8_STAGE_A(PG8_SA(0, 0), cA, voffA); PG8_STAGE_B(PG8_SB(0, 1), cB + hstep, voffB); PG8_STAGE_A(PG8_SA(0, 1), cA + hstep, voffA);
        if (wr == 1) PG8_BAR;
        PG8_WAIT_V(4); PG8_BAR;
        PG8_STAGE_B(PG8_SB(1, 0), cB + kstep, voffB); PG8_STAGE_A(PG8_SA(1, 0), cA + kstep, voffA); PG8_STAGE_B(PG8_SB(1, 1), cB + hstep + kstep, voffB);
        PG8_WAIT_V(6); PG8_BAR;
    }
    for (;;) {
        const bool has_next = S.next(ui + 1, nxt);
        const unsigned nA = has_next ? (unsigned)nxt.pm * astep : cA, nB = has_next ? (unsigned)nxt.pn * tstep : cB;
        for (int t = 0; t < nt; t += 2) {
            const bool last = (t == nt - 2);
            const unsigned a1 = cA + (unsigned)(t + 1) * kstep;
            const unsigned a2 = last ? nA : cA + (unsigned)(t + 2) * kstep, b2 = last ? nB : cB + (unsigned)(t + 2) * kstep;
            const unsigned a3 = a2 + kstep, b3 = b2 + kstep;
            if (last && has_next) S.a_ready(nxt);
            if constexpr (Epi::MIDK) { if (t == (nt >> 1)) E.mid(acc, cur, wr, wc, fr, fq); }
            if constexpr (SP2) {
            PG8_LDB(B0, 0, 0); PG8_LDB(B1, 0, 1); PG8_SCHED; PG8_LDA(At, 0, 0); PG8_STAGE_A(PG8_SA(1, 1), a1 + hstep, voffA);
            PG8_WAIT_V(8); PG8_WAIT_L(0); PG8_BAR; PG8_MMA(0, 0, At, B0); PG8_MMA(0, 1, At, B1); PG8_BAR; PG8_SCHED;
            if constexpr (!HM) PG8_LDA(At, 0, 1); PG8_STAGE_B(PG8_SB(0, 0), b2, voffB); PG8_STAGE_B(PG8_SB(0, 1), b2 + hstep, voffB); PG8_STAGE_A(PG8_SA(0, 0), a2, voffA);
            PG8_WAIT_V(8); PG8_WAIT_L(0); PG8_BAR; if constexpr (!HM) { PG8_MMA(1, 0, At, B0); PG8_MMA(1, 1, At, B1); } PG8_BAR; PG8_SCHED;
            PG8_LDB(B0, 1, 0); PG8_LDB(B1, 1, 1); PG8_SCHED; PG8_LDA(At, 1, 0); PG8_STAGE_A(PG8_SA(0, 1), a2 + hstep, voffA);
            PG8_WAIT_V(8); PG8_WAIT_L(0); PG8_BAR; PG8_MMA(0, 0, At, B0); PG8_MMA(0, 1, At, B1); PG8_BAR; PG8_SCHED;
            if constexpr (!HM) PG8_LDA(At, 1, 1); PG8_STAGE_B(PG8_SB(1, 0), b3, voffB); PG8_STAGE_B(PG8_SB(1, 1), b3 + hstep, voffB); PG8_STAGE_A(PG8_SA(1, 0), a3, voffA);
            PG8_WAIT_V(8); PG8_WAIT_L(0); PG8_BAR; if constexpr (!HM) { PG8_MMA(1, 0, At, B0); PG8_MMA(1, 1, At, B1); } PG8_BAR; PG8_SCHED;
            } else {
            PG8_LDB(B0, 0, 0); PG8_SCHED; PG8_LDA(At, 0, 0); PG8_STAGE_A(PG8_SA(1, 1), a1 + hstep, voffA);
            PG8_WAIT_L(8); PG8_BAR; PG8_WAIT_L(0); PG8_MMA(0, 0, At, B0); PG8_BAR; PG8_SCHED;
            PG8_LDB(B1, 0, 1); PG8_STAGE_B(PG8_SB(0, 0), b2, voffB);
            PG8_BAR; PG8_WAIT_L(0); PG8_MMA(0, 1, At, B1); PG8_BAR;
            PG8_LDA(At, 0, 1); PG8_STAGE_A(PG8_SA(0, 0), a2, voffA);
            PG8_BAR; PG8_WAIT_L(0); PG8_MMA(1, 0, At, B0); PG8_BAR; PG8_SCHED;
            PG8_STAGE_B(PG8_SB(0, 1), b2 + hstep, voffB);
            PG8_WAIT_V(6); PG8_BAR; PG8_MMA(1, 1, At, B1); PG8_BAR;
            PG8_LDB(B0, 1, 0); PG8_SCHED; PG8_LDA(At, 1, 0); PG8_STAGE_A(PG8_SA(0, 1), a2 + hstep, voffA);
            PG8_WAIT_L(8); PG8_BAR; PG8_WAIT_L(0); PG8_MMA(0, 0, At, B0); PG8_BAR; PG8_SCHED;
            PG8_LDB(B1, 1, 1); PG8_STAGE_B(PG8_SB(1, 0), b3, voffB);
            PG8_BAR; PG8_WAIT_L(0); PG8_MMA(0, 1, At, B1); PG8_BAR;
            PG8_LDA(At, 1, 1); PG8_STAGE_A(PG8_SA(1, 0), a3, voffA);
            PG8_BAR; PG8_WAIT_L(0); PG8_MMA(1, 0, At, B0); PG8_BAR; PG8_SCHED;
            PG8_STAGE_B(PG8_SB(1, 1), b3 + hstep, voffB);
            PG8_WAIT_V(6); PG8_BAR; PG8_MMA(1, 1, At, B1); PG8_BAR;
            }
        }
        if constexpr (ALIGN_EPI) { if (wr == 0) PG8_BAR; }
        E(acc, cur, wr, wc, fr, fq); S.done(cur);
        if (!has_next) break;
#pragma unroll
        for (int a = 0; a < 2; ++a)
#pragma unroll
            for (int b = 0; b < 2; ++b)
#pragma unroll
                for (int m = 0; m < 4; ++m)
#pragma unroll
                    for (int n = 0; n < 2; ++n) acc[a][b][m][n] = (f32x4){0.f, 0.f, 0.f, 0.f};
        cur = nxt; cA = nA; cB = nB; ++ui;
        if constexpr (ALIGN_EPI) { if (wr == 1) PG8_BAR; }
    }
    PG8_WAIT_V(0);
    if constexpr (!ALIGN_EPI) { if (wr == 0) PG8_BAR; }
    PG8_BAR;
#undef PG8_SA
#undef PG8_SB
#undef PG8_STAGE_R
#undef PG8_STAGE_A
#undef PG8_STAGE_B
#undef PG8_LDA
#undef PG8_LDB
#undef PG8_MMA
#undef PG8_CAT
#undef PG8_WAIT_V
#undef PG8_WAIT_L
#undef PG8_BAR
#undef PG8_SCHED
}
}

#ifndef PG8_SP2
#define PG8_SP2 true
#endif
#ifndef PG8_ALIGN
#define PG8_ALIGN true
#endif
#ifndef MK_SPLIT
#define MK_SPLIT 0
#endif

constexpr int NWAVES = 8;
constexpr int D = 4096, MP = 8192, MS = 128, MTOT = MP + MS, MPAD = 8448, NIN = 18944, DA = 2048, DKV = 256, DSG = 2048;
constexpr int NSEQ = 36, NMOD = 3 * D, SEQ = 2048, WIN = 128;
constexpr int PB8 = D + 128, LD8 = PB8 / 2, K8 = D / 2;
constexpr float SA8 = 32.f, SB8 = 8.f, SWP = 128.f, SMG = 16.f, SWO = 256.f, SH8 = 8.f, SWI = 128.f,
                SQ8 = 16.f, SZA8 = 8.f, SUZ8 = 4.f, SVB8 = 8.f, SG8 = 256.f;
constexpr int LDK = D + 64;
constexpr float ALPHA = 1.4142135623730951f;
constexpr float LN_EPS = 1e-5f;
constexpr float LOG2E = 1.4426950408889634f;
constexpr float QSCALE = 0.125f * LOG2E;
constexpr size_t O_YP = 0, O_YS = 33554432, O_WK = 34078720, O_WV = 34340864, O_NK = 34603008, O_NV = 34668544, O_SV = 34734080, O_END = 35258368;

constexpr size_t MiB = 1u << 20;
constexpr size_t WS_CTL = 0, CTL_ZERO_BYTES = 32768;
constexpr size_t WS_MOD = 1 * MiB;
constexpr size_t WS_WSB = 5 * MiB;
constexpr size_t WS_VST = 6 * MiB;
constexpr size_t WS_RST = 9 * MiB;
constexpr size_t WS_KB = 14 * MiB;
constexpr size_t WS_VB = 19 * MiB;
constexpr size_t WS_WIN = 24 * MiB;
constexpr size_t WS_WP = 328 * MiB;
constexpr size_t WS_WO = 394 * MiB;
constexpr size_t WS_HB = 460 * MiB;
constexpr size_t WS_QB = 528 * MiB;
constexpr size_t WS_ZA = 561 * MiB;
constexpr size_t WS_UZ = 594 * MiB;
constexpr size_t WS_VBB = 627 * MiB;
constexpr size_t WS_VBS = 644 * MiB;
constexpr size_t WS_RR = 660 * MiB;
constexpr size_t WS_SGB = 726 * MiB;
constexpr size_t WS_AB = 792 * MiB;
constexpr size_t WS_MG = 860 * MiB;
constexpr size_t WS_RBUF = 928 * MiB;
constexpr size_t WS_RB0 = 928 * MiB;
constexpr size_t WS_RB1 = 992 * MiB;
constexpr size_t WS_RS = 1056 * MiB;
constexpr size_t WS_X1S = 1058 * MiB;
constexpr size_t WS_ST0 = 1060 * MiB;
constexpr size_t WS_HB8 = 1192 * MiB;
constexpr size_t WS_WIN8 = 1228 * MiB;
constexpr size_t WS_END = 1384 * MiB;
static_assert(WS_HB8 + (size_t)MPAD * PB8 <= WS_WIN8 && WS_WIN8 + 2ull * NIN * PB8 <= WS_END, "d_ws map (fp8)");
static_assert(WS_WIN + 2ull * NIN * LDK * 2 <= WS_WP && WS_WP + 2ull * D * LDK * 2 <= WS_WO && WS_WO + 2ull * D * LDK * 2 <= WS_HB && WS_HB + (size_t)MPAD * LDK * 2 <= WS_QB && WS_AB + (size_t)MPAD * LDK * 2 <= WS_MG && WS_MG + (size_t)MPAD * LDK * 2 <= WS_RBUF, "d_ws map");
static_assert((4096 + 3456) * 4 <= (int)CTL_ZERO_BYTES, "barrier words inside the zeroed region");
constexpr int CW_TMO = 0, CW_CODE = 1, CW_WORK0 = 512, CW_WORK1 = 1024, CW_ADA1 = 192, CW_DONE1 = 256, CW_WORK2 = 1536, CW_BAR = 4096;

constexpr int RING_BYTES = 131072;
constexpr int LDSCTL_OFF = 155648, MISC_OFF = LDSCTL_OFF + 320, PTAB_OFF = LDSCTL_OFF + 512;
constexpr int LDS_BYTES = 159744;

#define GAS __attribute__((address_space(1)))
#define LAS __attribute__((address_space(3)))
typedef unsigned short bf16;
typedef unsigned v4u __attribute__((ext_vector_type(4)));
typedef unsigned v2u __attribute__((ext_vector_type(2)));
typedef float f32x4 __attribute__((ext_vector_type(4)));
typedef float f32x2 __attribute__((ext_vector_type(2)));
typedef GAS unsigned gu32;
#define RLX_AGENT __ATOMIC_RELAXED, __HIP_MEMORY_SCOPE_AGENT
#define LDS_WAIT() asm volatile("s_waitcnt lgkmcnt(0)" ::: "memory")
#define VM_WAIT() asm volatile("s_waitcnt vmcnt(0)" ::: "memory")
__device__ __forceinline__ unsigned f2bf(float f) { unsigned u = __builtin_bit_cast(unsigned, f); return (u + 0x7fffu + ((u >> 16) & 1u)) >> 16; }
__device__ __forceinline__ unsigned pk2(float lo, float hi) { return f2bf(lo) | (f2bf(hi) << 16); }
__device__ __forceinline__ float bflo(unsigned u) { return __builtin_bit_cast(float, u << 16); }
__device__ __forceinline__ float bfhi(unsigned u) { return __builtin_bit_cast(float, u & 0xffff0000u); }
__device__ __forceinline__ unsigned pk4_fp8(float a, float b, float c, float d) { int w = 0; w = __builtin_amdgcn_cvt_pk_fp8_f32(a, b, w, false); w = __builtin_amdgcn_cvt_pk_fp8_f32(c, d, w, true); return (unsigned)w; }
__device__ __forceinline__ int lane_now() { int l; asm volatile("v_mbcnt_lo_u32_b32 %0, -1, 0\n\tv_mbcnt_hi_u32_b32 %0, -1, %0" : "=v"(l)); return l; }
template <int K> __device__ __forceinline__ float xadd(float v) {
    if constexpr (K < 32) return v + __builtin_bit_cast(float, __builtin_amdgcn_ds_swizzle(__builtin_bit_cast(int, v), (K << 10) | 0x1f));
    else { const unsigned u = __builtin_bit_cast(unsigned, v); auto rr = __builtin_amdgcn_permlane32_swap(u, u, false, false); return __builtin_bit_cast(float, (unsigned)rr[0]) + __builtin_bit_cast(float, (unsigned)rr[1]); }
}
template <int K> __device__ __forceinline__ float xmax(float v) {
    if constexpr (K < 32) return fmaxf(v, __builtin_bit_cast(float, __builtin_amdgcn_ds_swizzle(__builtin_bit_cast(int, v), (K << 10) | 0x1f)));
    else { const unsigned u = __builtin_bit_cast(unsigned, v); auto rr = __builtin_amdgcn_permlane32_swap(u, u, false, false); return fmaxf(__builtin_bit_cast(float, (unsigned)rr[0]), __builtin_bit_cast(float, (unsigned)rr[1])); }
}
__device__ __forceinline__ float xadd_wave(float v) { v = xadd<1>(v); v = xadd<2>(v); v = xadd<4>(v); v = xadd<8>(v); v = xadd<16>(v); return xadd<32>(v); }
__device__ __forceinline__ float xmax_wave(float v) { v = xmax<1>(v); v = xmax<2>(v); v = xmax<4>(v); v = xmax<8>(v); v = xmax<16>(v); return xmax<32>(v); }
__device__ __forceinline__ float xadd_32(float v) { v = xadd<1>(v); v = xadd<2>(v); v = xadd<4>(v); v = xadd<8>(v); return xadd<16>(v); }
__device__ __forceinline__ f32x4 f8x4(unsigned w) { const f32x2 a = __builtin_amdgcn_cvt_pk_f32_fp8((int)w, false), b = __builtin_amdgcn_cvt_pk_f32_fp8((int)w, true); return (f32x4){a.x, a.y, b.x, b.y}; }
__device__ __forceinline__ float f8x1(unsigned char b) { return __builtin_amdgcn_cvt_f32_fp8((int)b, 0); }
__device__ __forceinline__ float sigmoidf_(float x) { return __builtin_amdgcn_rcpf(1.0f + __builtin_amdgcn_exp2f(-x * LOG2E)); }
__device__ __forceinline__ float siluf_(float x) { return x * sigmoidf_(x); }

#define XB_TMO      128
#define XB_XCNT(j)  (256  + 64 * (j))
#define XB_XSUB(j)  (1280 + 64 * (j))
#define XB_XGEN(j)  (2304 + 64 * (j))
#define XB_TOP      3328
#define XB_TOPGEN   3392
#define XCD_BAR_WORDS 3456
#define XB_SPIN_CAP (1u << 18)
__device__ __forceinline__ unsigned xb_ld(unsigned* p)              { return __hip_atomic_load(p, __ATOMIC_RELAXED, __HIP_MEMORY_SCOPE_AGENT); }
__device__ __forceinline__ unsigned xb_add(unsigned* p, unsigned v) { return __hip_atomic_fetch_add(p, v, __ATOMIC_RELAXED, __HIP_MEMORY_SCOPE_AGENT); }
__device__ __forceinline__ unsigned xb_xcc_id() { return (unsigned)__builtin_amdgcn_s_getreg((3 << 11) | 20) & 0xFu; }
#define XB_SPIN(cond, bar) do { unsigned _sp = 0; while (cond) { __builtin_amdgcn_s_sleep(1); \
    if ((++_sp & 255u) == 0u) { if (xb_ld(&(bar)[XB_TMO])) break; if (_sp > XB_SPIN_CAP) { atomicAdd(&(bar)[XB_TMO], 1u); break; } } } } while (0)
struct XcdBarrier { unsigned* bar; unsigned x; volatile LAS unsigned* st; };
__device__ __forceinline__ XcdBarrier xcd_barrier_post(unsigned* bar, volatile LAS unsigned* st) {
    XcdBarrier b; b.bar = bar; b.x = xb_xcc_id(); b.st = st;
    if (threadIdx.x == 0) (void)xb_add(&bar[XB_XCNT(b.x)], 1u);
    return b;
}
__device__ __forceinline__ void xcd_barrier_complete(unsigned* bar, unsigned x, unsigned& nloc, unsigned& nx) {
    const unsigned G = gridDim.x * gridDim.y * gridDim.z;
    unsigned sum, cnt, mine, sp = 0u;
    for (;;) {
        sum = 0u; cnt = 0u; mine = 0u;
#pragma unroll
        for (unsigned j = 0; j < 16; ++j) { const unsigned c = xb_ld(&bar[XB_XCNT(j)]); sum += c; cnt += (c > 0u) ? 1u : 0u; mine = (j == x) ? c : mine; }
        if (sum == G) break;
        __builtin_amdgcn_s_sleep(1);
        if ((++sp & 255u) == 0u) { if (xb_ld(&bar[XB_TMO])) break; if (sp > XB_SPIN_CAP) { atomicAdd(&bar[XB_TMO], 1u); break; } }
    }
    nloc = mine > 0u ? mine : 1u; nx = cnt > 0u ? cnt : 1u;
}
__device__ __forceinline__ void xcd_barrier(const XcdBarrier& b, const bool leader) {
    asm volatile("s_waitcnt vmcnt(0)" ::: "memory");
    __syncthreads();
    if (leader) {
        unsigned* bar = b.bar; unsigned bx_ = b.x;
        asm volatile("" : "+s"(bar), "+s"(bx_));
        __builtin_amdgcn_s_waitcnt(0);
        unsigned nloc = b.st[0], nx = b.st[1];
        if (nloc == 0u) { xcd_barrier_complete(bar, bx_, nloc, nx); b.st[0] = nloc; b.st[1] = nx; }
        const unsigned old = xb_add(&bar[XB_XSUB(bx_)], 1u);
        const unsigned gen = old / nloc;
        if (old + 1u == (gen + 1u) * nloc) {
            __builtin_amdgcn_fence(__ATOMIC_RELEASE, "agent");
            asm volatile("s_waitcnt vmcnt(0)" ::: "memory");
            const unsigned og = xb_add(&bar[XB_TOP], 1u);
            const unsigned tg = og / nx;
            if (og + 1u == (tg + 1u) * nx) xb_add(&bar[XB_TOPGEN], 1u);
            else XB_SPIN(xb_ld(&bar[XB_TOPGEN]) == tg, bar);
            __builtin_amdgcn_fence(__ATOMIC_ACQUIRE, "agent");
            xb_add(&bar[XB_XGEN(bx_)], 1u);
            asm volatile("s_waitcnt vmcnt(0)" ::: "memory");
        } else {
            XB_SPIN(xb_ld(&bar[XB_XGEN(bx_)]) == gen, bar);
            __builtin_amdgcn_fence(__ATOMIC_ACQUIRE, "agent");
            asm volatile("s_waitcnt vmcnt(0)" ::: "memory");
        }
    }
    __syncthreads();
}

struct Frame {
    LAS unsigned char* lds;
    unsigned char* ws;
    float* out;
    int tid, lane, wave, bx;
    static constexpr int G = 256;
};
enum { I_XP = 0, I_XS, I_CK, I_CV, I_CP, I_CS, I_WADA, I_BADA, I_WIN, I_SINK, I_SG, I_SB, I_SW, I_SBS, I_WPA, I_WPB, I_WO, I_LNG, I_LNB };
__device__ __forceinline__ const float* inp(const Frame& F, int k) {
    volatile LAS unsigned* t = (volatile LAS unsigned*)(F.lds + PTAB_OFF) + 2 * k;
    const unsigned lo = __builtin_amdgcn_readfirstlane(t[0]), hi = __builtin_amdgcn_readfirstlane(t[1]);
    return (const float*)(const GAS float*)(((unsigned long long)hi << 32) | lo);
}
#define WSP(T, off) ((T*)(F.ws + (off)))
__device__ __forceinline__ int row_seq(int row) { return row < MP ? (row >> 11) : 4 + ((row - MP) >> 2); }

__device__ __forceinline__ void ada_item(Frame& F, int item) {
    const int l = item / 96, cb = item % 96;
    LAS float* sc = (LAS float*)(F.lds);
    LAS float* red = (LAS float*)(F.lds + 40960);
    const float* W = inp(F, I_WADA) + (size_t)l * D * NMOD + cb * 128;
    const float* cp = inp(F, I_CP); const float* cs = inp(F, I_CS);
    const int half = F.lane >> 5, c4 = (F.lane & 31) * 4;
    f32x4 acc[18];
#pragma unroll
    for (int s = 0; s < 18; ++s) acc[s] = (f32x4){0.f, 0.f, 0.f, 0.f};
    f32x4 w[8];
    const float* Wl = W + (size_t)(F.wave * 16) * NMOD + c4;
#pragma unroll
    for (int j = 0; j < 8; ++j) w[j] = __builtin_nontemporal_load((const f32x4*)(Wl + (size_t)j * NMOD));
    const int sq0 = F.tid >> 7, kk = F.tid & 127;
    float cv[9];
    cv[0] = cp[sq0 * D + kk];
#pragma unroll
    for (int j = 1; j < 9; ++j) cv[j] = cs[(sq0 + 4 * j - 4) * D + kk];
    for (int ch = 0; ch < 32; ++ch) {
        LAS float* scb = sc + (ch & 1) * 5120;
#pragma unroll
        for (int j = 0; j < 9; ++j) { const int s = sq0 + 4 * j; scb[kk * 40 + (s < 18 ? s : s + 2)] = siluf_(cv[j]); }
        { const int cn = (ch + 1 < 32 ? ch + 1 : ch) * 128 + kk;
          cv[0] = cp[sq0 * D + cn];
#pragma unroll
          for (int j = 1; j < 9; ++j) cv[j] = cs[(sq0 + 4 * j - 4) * D + cn]; }
        __syncthreads();
#pragma unroll
        for (int h2 = 0; h2 < 2; ++h2) {
            const float* Wn = Wl + (size_t)((h2 == 0 ? ch * 128 + 8 : (ch + 1 < 32 ? (ch + 1) * 128 : ch * 128))) * NMOD;
            f32x4 ac[5];
            { const LAS f32x4* a4 = (const LAS f32x4*)(scb + (F.wave * 16 + h2 * 8) * 40 + half * 20);
#pragma unroll
              for (int s4 = 0; s4 < 5; ++s4) ac[s4] = a4[s4]; }
#pragma unroll
            for (int j = 0; j < 8; ++j) {
                f32x4 an[5];
                if (j + 1 < 8) { const LAS f32x4* a4 = (const LAS f32x4*)(scb + (F.wave * 16 + h2 * 8 + j + 1) * 40 + half * 20);
#pragma unroll
                    for (int s4 = 0; s4 < 5; ++s4) an[s4] = a4[s4]; }
                const f32x4 wv = w[j];
#pragma unroll
                for (int s4 = 0; s4 < 5; ++s4) { const f32x4 a = ac[s4];
                    acc[4 * s4 + 0] += a.x * wv; acc[4 * s4 + 1] += a.y * wv;
                    if (s4 < 4) { acc[4 * s4 + 2] += a.z * wv; acc[4 * s4 + 3] += a.w * wv; } }
                w[j] = __builtin_nontemporal_load((const f32x4*)(Wn + (size_t)j * NMOD));
                if (j + 1 < 8) {
#pragma unroll
                    for (int s4 = 0; s4 < 5; ++s4) ac[s4] = an[s4]; }
                __builtin_amdgcn_sched_barrier(0);
            }
        }
    }
    float* mod = WSP(float, WS_MOD); const float* bada = inp(F, I_BADA);
#pragma unroll
    for (int p = 0; p < 2; ++p) {
        __syncthreads();
#pragma unroll
        for (int s9 = 0; s9 < 9; ++s9) *(LAS f32x4*)(red + (F.wave * 18 + half * 9 + s9) * 128 + c4) = acc[p * 9 + s9];
        __syncthreads();
        for (int i = F.tid; i < 18 * 128; i += 512) { const int r = i >> 7, c = i & 127; float v = 0.f;
#pragma unroll
            for (int w8 = 0; w8 < 8; ++w8) v += red[(w8 * 18 + r) * 128 + c];
            const int sq = (r < 9) ? p * 9 + r : 18 + p * 9 + (r - 9), col = cb * 128 + c;
            mod[(size_t)(l * NSEQ + sq) * NMOD + col] = v + bada[l * NMOD + col]; }
    }
    __syncthreads();
}

__device__ __forceinline__ void tr_load(const float* src, int Nsrc, int lane, float (&v)[32]) {
    unsigned off = (unsigned)((lane >> 5) * Nsrc + (lane & 31)) * 4u; const unsigned step = (unsigned)Nsrc * 8u;
#pragma unroll
    for (int i = 0; i < 32; ++i) { v[i] = __builtin_nontemporal_load((const float*)((const char*)src + off)); off += step; }
}
__device__ __forceinline__ void tr_store(void* dst, int f8, float scale, LAS float* scr, int lane, const float (&v)[32]) {
#pragma unroll
    for (int i = 0; i < 32; ++i) scr[(2 * i + (lane >> 5)) * 33 + (lane & 31)] = v[i];
    LDS_WAIT(); asm volatile("" ::: "memory");
    const int c = lane & 7;
#pragma unroll
    for (int j = 0; j < 4; ++j) { const int n = (lane >> 3) + 8 * j; const LAS float* s = scr + (8 * c) * 33 + n;
        if (f8) { v2u o; o.x = pk4_fp8(s[0 * 33] * scale, s[1 * 33] * scale, s[2 * 33] * scale, s[3 * 33] * scale); o.y = pk4_fp8(s[4 * 33] * scale, s[5 * 33] * scale, s[6 * 33] * scale, s[7 * 33] * scale);
            *(GAS v2u*)((unsigned char*)dst + (size_t)n * PB8 + 8 * c) = o; }
        else { v4u o; o.x = pg8::cvt_pk_bf16(s[0 * 33], s[1 * 33]); o.y = pg8::cvt_pk_bf16(s[2 * 33], s[3 * 33]); o.z = pg8::cvt_pk_bf16(s[4 * 33], s[5 * 33]); o.w = pg8::cvt_pk_bf16(s[6 * 33], s[7 * 33]);
            *(GAS v4u*)((bf16*)dst + (size_t)n * LDK + 8 * c) = o; } }
    LDS_WAIT(); asm volatile("" ::: "memory");
}
__host__ __device__ __forceinline__ int win_row(int c) {
    if (c < 4608) return c;
    if (c < 6656) { const int j = (c - 4608) >> 7, i = (c - 4608) & 127; return 4608 + 256 * j + i; }
    if (c < 8704) return 8704 + (c - 6656);
    if (c < 10752) { const int j = (c - 8704) >> 7, i = (c - 8704) & 127; return 4608 + 256 * j + 128 + i; }
    if (c < 14848) { const int j = (c - 10752) >> 7, i = (c - 10752) & 127; return 10752 + 256 * j + i; }
    { const int j = (c - 14848) >> 7, i = (c - 14848) & 127; return 10752 + 256 * j + 128 + i; }
}
constexpr int I_IN = 64 * 592, I_PA = 32 * 128, I_O = 64 * 128, I_LAYER = I_IN + 2 * I_PA + I_O, I_TR = 2 * I_LAYER, I_WS = 128, I_ALL = I_TR + I_WS;
static_assert(I_TR % 8 == 0 && I_WS % 8 == 0 && I_IN % 8 == 0, "chunks of 8 items never straddle the item kinds");
__device__ __forceinline__ void tr_desc(Frame& F, int it, const float*& src, int& Nsrc, void*& dst, void*& dst2, int& f8, float& scale) {
    const int l = it / I_LAYER; int r = it % I_LAYER; f8 = 0; scale = 1.f; dst2 = nullptr;
    if (r < I_IN) { const int kb = r / 592, nb = r % 592, wrow = win_row(32 * nb); Nsrc = NIN; f8 = 1; scale = SWI;
        src = inp(F, I_WIN) + (size_t)l * D * NIN + (size_t)(64 * kb) * NIN + 32 * nb; dst = WSP(unsigned char, WS_WIN8) + (size_t)l * NIN * PB8 + (size_t)wrow * PB8 + 64 * kb;
        if ((wrow >= 2048 && wrow < 2560) || (wrow >= 8704 && wrow < 10752)) { f8 = 2; dst2 = WSP(bf16, WS_WIN) + (size_t)l * NIN * LDK + (size_t)wrow * LDK + 64 * kb; }
        return; }
    r -= I_IN; Nsrc = D; f8 = 1; scale = SWP;
    if (r < I_PA) { const int kb = r / 128, nb = r % 128;
        src = inp(F, I_WPA) + (size_t)l * DA * D + (size_t)(64 * kb) * D + 32 * nb; dst = WSP(unsigned char, WS_WP) + (size_t)l * D * PB8 + (size_t)(32 * nb) * PB8 + 64 * kb; return; }
    r -= I_PA;
    if (r < I_PA) { const int kb = r / 128, nb = r % 128;
        src = inp(F, I_WPB) + (size_t)l * DSG * D + (size_t)(64 * kb) * D + 32 * nb; dst = WSP(unsigned char, WS_WP) + (size_t)l * D * PB8 + (size_t)(32 * nb) * PB8 + 2048 + 64 * kb; return; }
    r -= I_PA; scale = SWO;
    { const int kb = r / 128, nb = r % 128;
        src = inp(F, I_WO) + (size_t)l * D * D + (size_t)(64 * kb) * D + 32 * nb; dst = WSP(unsigned char, WS_WO) + (size_t)l * D * PB8 + (size_t)(32 * nb) * PB8 + 64 * kb; }
}
__device__ __forceinline__ void copy_chunk(Frame& F, int base, LAS float* scr) {
    if (base >= I_TR) {
        const float* sw = inp(F, I_SW); bf16* Wsb = WSP(bf16, WS_WSB);
        for (int it = base; it < base + 8; ++it) { const int e0 = (it - I_TR) * 2048 + F.lane * 4;
#pragma unroll
            for (int j = 0; j < 8; ++j) { const int e = e0 + j * 256; const f32x4 v = *(const f32x4*)(sw + e); const int s = e & 127, t = (e >> 7) & 127;
                v2u o; o.x = pk2(s <= t ? v.x : 0.f, s + 1 <= t ? v.y : 0.f); o.y = pk2(s + 2 <= t ? v.z : 0.f, s + 3 <= t ? v.w : 0.f);
                *(GAS v2u*)(Wsb + e) = o; } }
        return;
    }
    float va[32], vb[32]; const float* src; int ns; void *da, *db, *da2, *db2; int fa, fb; float sa, sb;
    tr_desc(F, base, src, ns, da, da2, fa, sa); tr_load(src, ns, F.lane, va);
#pragma unroll 1
    for (int j = 0; j < 8; j += 2) {
        tr_desc(F, base + j + 1, src, ns, db, db2, fb, sb); tr_load(src, ns, F.lane, vb);
        tr_store(da, fa != 0, sa, scr, F.lane, va); if (fa == 2) tr_store(da2, 0, 1.f, scr, F.lane, va);
        if (j + 2 < 8) { tr_desc(F, base + j + 2, src, ns, da, da2, fa, sa); tr_load(src, ns, F.lane, va); }
        tr_store(db, fb != 0, sb, scr, F.lane, vb); if (fb == 2) tr_store(db2, 0, 1.f, scr, F.lane, vb);
    }
}

__device__ __forceinline__ int pull8(gu32* q, int nchunks, int& s, int& left, int lane) {
    while (left > 0) { int k = 0; if (lane == 0) k = (int)__hip_atomic_fetch_add((unsigned*)(q + 64 * s), 1u, RLX_AGENT);
        const int c = 8 * __builtin_amdgcn_readfirstlane(k) + s; if (c < nchunks) return 8 * c;
        s = (s + 1) & 7; --left; }
    return -1; }
__device__ __forceinline__ void steal_copies(Frame& F, bool until_done, int q, int quota) {
    gu32* ctl = (gu32*)(F.ws + WS_CTL); LAS float* scr = (LAS float*)(F.lds + F.wave * 16384);
    gu32* head = ctl + (q == 1 ? CW_WORK1 : CW_WORK2); const int n = q == 1 ? I_IN : I_LAYER - I_IN, base = q == 1 ? I_LAYER : I_LAYER + I_IN;
    int sh = F.bx & 7, left = 8;
    for (int it = 0; it < quota; ++it) {
        if (until_done) { unsigned d = 0; if (F.lane == 0) d = __hip_atomic_load((unsigned*)(ctl + CW_DONE1), RLX_AGENT); if ((unsigned)__builtin_amdgcn_readfirstlane(d) >= (unsigned)Frame::G) break; }
        const int v = pull8(head, n / 8, sh, left, F.lane); if (v < 0) break;
        copy_chunk(F, base + v, scr);
    }
}

__device__ __forceinline__ void h_rows(Frame& F, const float* x, int row0, int nrows, int seq, int slice, int l) {
    const int col = slice * 1024 + F.lane * 4;
    const float* md = WSP(float, WS_MOD) + (size_t)(l * NSEQ + seq) * NMOD; bf16* Hb = WSP(bf16, WS_HB); unsigned char* Hb8 = WSP(unsigned char, WS_HB8);
    const bool wb = row0 >= MP || (row0 & 2047) >= 1792;
    f32x4 sh[4], sc[4];
#pragma unroll
    for (int j = 0; j < 4; ++j) { sh[j] = *(const f32x4*)(md + col + 256 * j); sc[j] = *(const f32x4*)(md + D + col + 256 * j) + 1.0f; }
    for (int r0 = 0; r0 < nrows; r0 += 4) {
        f32x4 xv[4][4];
#pragma unroll
        for (int rr = 0; rr < 4; ++rr)
#pragma unroll
            for (int j = 0; j < 4; ++j) xv[rr][j] = *(const f32x4*)(x + (size_t)(r0 + rr) * D + col + 256 * j);
#pragma unroll
        for (int rr = 0; rr < 4; ++rr) { const int r = r0 + rr;
#pragma unroll
            for (int j = 0; j < 4; ++j) { const f32x4 v = xv[rr][j] * sc[j] + sh[j];
                *(GAS unsigned*)(Hb8 + (size_t)(row0 + r) * PB8 + col + 256 * j) = pk4_fp8(v.x * SH8, v.y * SH8, v.z * SH8, v.w * SH8);
                if (wb) { v2u o; o.x = pk2(v.x, v.y); o.y = pk2(v.z, v.w); *(GAS v2u*)(Hb + (size_t)(row0 + r) * LDK + col + 256 * j) = o; } } }
    }
}

constexpr int G1_NBF = 18, G1_NF8W = 256 - G1_NBF, G1_UNITS = 33 * 74;
struct OrderF8 { int c;
    __device__ __forceinline__ bool next(int i, pg8::Unit& u) const {
        int L;
        if (i < 8) L = i * 256 + c;
        else { if (c >= G1_NF8W) return false; L = 2048 + (i - 8) * G1_NF8W + c; if (L >= G1_UNITS) return false; }
        pg8::StaticOrderC<MPAD, NIN>::map(L, u); return true; }
    __device__ __forceinline__ void a_ready(const pg8::Unit&) const {}
    __device__ __forceinline__ void done(const pg8::Unit&) const {} };
struct OrderBf { int c;
    __device__ __forceinline__ bool next(int i, pg8::Unit& u) const {
        const int j = c - G1_NF8W; if (i != 0 || j < 0) return false;
        if (j < 8) { u.pm = 8 * (j >> 1) + 7; u.pn = 8 + (j & 1); }
        else { const int jj = j - 8; u.pm = 32; u.pn = jj < 2 ? 8 + jj : 34 + (jj - 2); }
        return true; }
    __device__ __forceinline__ void a_ready(const pg8::Unit&) const {}
    __device__ __forceinline__ void done(const pg8::Unit&) const {} };

__host__ __device__ __forceinline__ bool is_bf16_unit(int pm, int pn) { return ((pn == 8 || pn == 9) && ((pm & 7) == 7 || pm == 32)) || (pm == 32 && pn >= 34 && pn < 42); }
template <bool F8> struct EpiInT {
    static constexpr bool PERM = true, MIDK = false;
    unsigned char* ws; float* outl;
    int l;
    __device__ __forceinline__ void mid(pg8::f32x4 (&)[2][2][4][2], const pg8::Unit&, int, int, int, int) const {}
    __device__ __forceinline__ void operator()(const pg8::f32x4 (&acc)[2][2][4][2], const pg8::Unit& u, int wr, int wc, int fr_, int fq_) const {
        if (F8 && is_bf16_unit(u.pm, u.pn)) return;
        constexpr float DS = F8 ? 1.0f / (SH8 * SWI) : 1.0f;
        const int ln_ = lane_now(), fr = ln_ & 15, fq = ln_ >> 4; (void)fr_; (void)fq_;
        const int row0 = u.pm * 256 + wr * 64 + fr, c8 = wc * 32 + 8 * fq, pn = u.pn;
        if (pn < 8 || (pn >= 10 && pn < 18) || (pn >= 34 && pn < 42)) {
            const int kind = pn < 8 ? 0 : (pn < 18 ? 1 : 2);
            unsigned char* base = kind == 0 ? (ws + WS_QB) + pn * 256 : (kind == 1 ? (ws + WS_ZA) + (pn - 10) * 256 : (ws + WS_VBB) + (pn - 34) * 256);
            const float osc = kind == 0 ? QSCALE * SQ8 : (kind == 1 ? SZA8 : SVB8);
            f32x2* vst = (f32x2*)(ws + WS_VST);
#pragma unroll
            for (int ai = 0; ai < 2; ++ai)
#pragma unroll
                for (int m = 0; m < 4; ++m) { const int row = row0 + ai * 128 + m * 16; unsigned char* rowp = base + (size_t)row * 2048 + c8; float s1 = 0.f, s2 = 0.f;
#pragma unroll
                    for (int bj = 0; bj < 2; ++bj) { f32x4 v0 = acc[ai][bj][m][0] * DS, v1 = acc[ai][bj][m][1] * DS;
                        if (kind == 1) { v0 = (f32x4){siluf_(v0.x), siluf_(v0.y), siluf_(v0.z), siluf_(v0.w)}; v1 = (f32x4){siluf_(v1.x), siluf_(v1.y), siluf_(v1.z), siluf_(v1.w)}; }
                        if (kind == 2) { s1 += (v0.x + v0.y) + (v0.z + v0.w) + (v1.x + v1.y) + (v1.z + v1.w);
                                         s2 += (v0.x * v0.x + v0.y * v0.y) + (v0.z * v0.z + v0.w * v0.w) + (v1.x * v1.x + v1.y * v1.y) + (v1.z * v1.z + v1.w * v1.w); }
                        if (!F8 && kind == 2) {
                            v4u w; w.x = pg8::cvt_pk_bf16(v0.x, v0.y); w.y = pg8::cvt_pk_bf16(v0.z, v0.w); w.z = pg8::cvt_pk_bf16(v1.x, v1.y); w.w = pg8::cvt_pk_bf16(v1.z, v1.w);
                            *(v4u*)((bf16*)(ws + WS_VBS) + (size_t)(row - MP) * 2048 + (pn - 34) * 256 + c8 + bj * 128) = w;
                        } else {
                            v0 = v0 * osc; v1 = v1 * osc;
                            v2u w; w.x = pk4_fp8(v0.x, v0.y, v0.z, v0.w); w.y = pk4_fp8(v1.x, v1.y, v1.z, v1.w);
                            *(v2u*)(rowp + bj * 128) = w; } }
                    if (kind == 2) { s1 = xadd<32>(xadd<16>(s1)); s2 = xadd<32>(xadd<16>(s2));
                        if (fq == 0) vst[(size_t)row * 32 + (pn - 34) * 4 + wc] = (f32x2){s1, s2}; }
                }
        } else if (pn < 10) {
            bf16* base = (bf16*)(ws + (pn == 8 ? WS_KB : WS_VB));
            float* ow = outl + (pn == 8 ? O_WK : O_WV) + (size_t)l * 131072; float* on = outl + (pn == 8 ? O_NK : O_NV) + (size_t)l * 32768;
#pragma unroll
            for (int ai = 0; ai < 2; ++ai)
#pragma unroll
                for (int m = 0; m < 4; ++m) { const int row = row0 + ai * 128 + m * 16; bf16* rowp = base + (size_t)row * 256 + c8;
                    const int rin = wr * 64 + m * 16 + fr;
                    float* fo = nullptr;
                    if (!F8) { if (u.pm < 32) { if ((u.pm & 7) == 7 && ai == 1) fo = ow + ((size_t)(u.pm >> 3) * 128 + rin) * 256; } else if (ai == 0) fo = on + (size_t)rin * 256; }
#pragma unroll
                    for (int bj = 0; bj < 2; ++bj) { const f32x4 v0 = acc[ai][bj][m][0] * DS, v1 = acc[ai][bj][m][1] * DS;
                        v4u w; w.x = pg8::cvt_pk_bf16(v0.x, v0.y); w.y = pg8::cvt_pk_bf16(v0.z, v0.w); w.z = pg8::cvt_pk_bf16(v1.x, v1.y); w.w = pg8::cvt_pk_bf16(v1.z, v1.w);
                        *(v4u*)(rowp + bj * 128) = w;
                        if (fo) { *(f32x4*)(fo + bj * 128 + c8) = v0; *(f32x4*)(fo + bj * 128 + c8 + 4) = v1; } }
                }
        } else if (pn < 34) {
            unsigned char* base = (ws + WS_UZ) + (pn - 18) * 128;
#pragma unroll
            for (int ai = 0; ai < 2; ++ai)
#pragma unroll
                for (int m = 0; m < 4; ++m) { const int row = row0 + ai * 128 + m * 16;
                    const f32x4 u0 = acc[ai][0][m][0] * DS, u1 = acc[ai][0][m][1] * DS, z0 = acc[ai][1][m][0] * DS, z1 = acc[ai][1][m][1] * DS;
                    v2u w; w.x = pk4_fp8(u0.x * siluf_(z0.x) * SUZ8, u0.y * siluf_(z0.y) * SUZ8, u0.z * siluf_(z0.z) * SUZ8, u0.w * siluf_(z0.w) * SUZ8);
                    w.y = pk4_fp8(u1.x * siluf_(z1.x) * SUZ8, u1.y * siluf_(z1.y) * SUZ8, u1.z * siluf_(z1.z) * SUZ8, u1.w * siluf_(z1.w) * SUZ8);
                    *(v2u*)(base + (size_t)row * 2048 + c8) = w; }
        } else {
            const int cb = (pn - 42) * 128 + c8; bf16* RR = (bf16*)(ws + WS_RR); unsigned char* SGB = ws + WS_SGB;
#pragma unroll
            for (int ai = 0; ai < 2; ++ai)
#pragma unroll
                for (int m = 0; m < 4; ++m) { const int row = row0 + ai * 128 + m * 16;
                    float ra[8], sb[8];
#pragma unroll
                    for (int n = 0; n < 2; ++n)
#pragma unroll
                        for (int e = 0; e < 4; ++e) { const float sa = sigmoidf_(acc[ai][0][m][n][e] * DS); const float s = fmaxf(sigmoidf_(acc[ai][1][m][n][e] * DS), 1.52587890625e-05f);
                            sb[n * 4 + e] = s; ra[n * 4 + e] = sa * __builtin_amdgcn_rcpf(s); }
                    v4u w; w.x = pg8::cvt_pk_bf16(ra[0], ra[1]); w.y = pg8::cvt_pk_bf16(ra[2], ra[3]); w.z = pg8::cvt_pk_bf16(ra[4], ra[5]); w.w = pg8::cvt_pk_bf16(ra[6], ra[7]);
                    *(v4u*)(RR + (size_t)row * D + cb) = w;
                    v2u x; x.x = pk4_fp8(sb[0] * SG8, sb[1] * SG8, sb[2] * SG8, sb[3] * SG8); x.y = pk4_fp8(sb[4] * SG8, sb[5] * SG8, sb[6] * SG8, sb[7] * SG8);
                    *(v2u*)(SGB + (size_t)row * D + cb) = x; }
        }
    }
};

struct EpiMerge {
    static constexpr bool PERM = true, MIDK = true;
    const bf16* RR; const unsigned char* SGB; unsigned char* MG;
    __device__ __forceinline__ void mid(pg8::f32x4 (&acc)[2][2][4][2], const pg8::Unit& u, int wr, int wc, int, int) const {
        const int ln_ = lane_now(), fr = ln_ & 15, fq = ln_ >> 4;
        unsigned off0 = ((unsigned)(u.pm * 256 + wr * 64 + fr) * D + (unsigned)(u.pn * 256 + wc * 32 + 8 * fq)) * 2u;
        asm volatile("" : "+v"(off0));
        v4u w[2][4][2];
#pragma unroll
        for (int ai = 0; ai < 2; ++ai)
#pragma unroll
            for (int m = 0; m < 4; ++m)
#pragma unroll
                for (int bj = 0; bj < 2; ++bj) w[ai][m][bj] = *(const v4u*)((const char*)RR + off0 + (unsigned)((ai * 128 + m * 16) * D * 2) + bj * 256);
#pragma unroll
        for (int ai = 0; ai < 2; ++ai) {
#pragma unroll
            for (int m = 0; m < 4; ++m)
#pragma unroll
                for (int bj = 0; bj < 2; ++bj) { const v4u x = w[ai][m][bj];
                    acc[ai][bj][m][0] = acc[ai][bj][m][0] * ((f32x4){bflo(x.x), bfhi(x.x), bflo(x.y), bfhi(x.y)} * (SB8 / SA8));
                    acc[ai][bj][m][1] = acc[ai][bj][m][1] * ((f32x4){bflo(x.z), bfhi(x.z), bflo(x.w), bfhi(x.w)} * (SB8 / SA8)); }
            asm volatile("" ::: "memory");
        }
    }
    __device__ __forceinline__ void operator()(const pg8::f32x4 (&acc)[2][2][4][2], const pg8::Unit& u, int wr, int wc, int, int) const {
        const int ln_ = lane_now(), fr = ln_ & 15, fq = ln_ >> 4;
        unsigned off0 = (unsigned)(u.pm * 256 + wr * 64 + fr) * D + (unsigned)(u.pn * 256 + wc * 32 + 8 * fq);
        asm volatile("" : "+v"(off0));
        const unsigned offm = (unsigned)(u.pm * 256 + wr * 64 + fr) * (unsigned)PB8 + (unsigned)(u.pn * 256 + wc * 32 + 8 * fq);
        v2u sv[2][4][2];
#pragma unroll
        for (int ai = 0; ai < 2; ++ai)
#pragma unroll
            for (int m = 0; m < 4; ++m)
#pragma unroll
                for (int bj = 0; bj < 2; ++bj) sv[ai][m][bj] = *(const v2u*)(SGB + off0 + (unsigned)((ai * 128 + m * 16) * D) + bj * 128);
#pragma unroll
        for (int ai = 0; ai < 2; ++ai) {
#pragma unroll
            for (int m = 0; m < 4; ++m)
#pragma unroll
                for (int bj = 0; bj < 2; ++bj) { const v2u s = sv[ai][m][bj];
                    const f32x4 v0 = acc[ai][bj][m][0] * (f8x4(s.x) * (SMG / (SB8 * SWP * SG8)));
                    const f32x4 v1 = acc[ai][bj][m][1] * (f8x4(s.y) * (SMG / (SB8 * SWP * SG8)));
                    v2u w; w.x = pk4_fp8(v0.x, v0.y, v0.z, v0.w); w.y = pk4_fp8(v1.x, v1.y, v1.z, v1.w);
                    *(v2u*)(MG + offm + (unsigned)((ai * 128 + m * 16) * PB8) + bj * 128) = w; }
            asm volatile("" ::: "memory");
        }
    }
};

template <int L> struct EpiOutT {
    static constexpr bool PERM = false, MIDK = false;
    const float* xp; const bf16* rb0; const f32x2* st0; const float *g0, *b0;
    const float* gate;
    bf16* rb; f32x2* rst;
    __device__ __forceinline__ void mid(pg8::f32x4 (&)[2][2][4][2], const pg8::Unit&, int, int, int, int) const {}
    __device__ __forceinline__ void operator()(const pg8::f32x4 (&acc)[2][2][4][2], const pg8::Unit& u, int wr, int wc, int fr_, int fq_) const {
        const int ln_ = lane_now(), fr = ln_ & 15, fq = ln_ >> 4; (void)fr_; (void)fq_;
        const unsigned col0 = (unsigned)(u.pn * 256 + wc * 32 + 4 * fq);
        const unsigned rowb = (unsigned)(u.pm * 256 + wr * 64 + fr);
        const unsigned eo0 = rowb * D + col0;
        const char* gb = (const char*)(gate + (size_t)(u.pm >> 3) * NMOD) + col0 * 4u;
        f32x4 gv[2][2], g0v[2][2], b0v[2][2];
#pragma unroll
        for (int bj = 0; bj < 2; ++bj)
#pragma unroll
            for (int n = 0; n < 2; ++n) { gv[bj][n] = *(const f32x4*)(gb + (bj * 128 + n * 16) * 4);
                if (L == 1) { g0v[bj][n] = *(const f32x4*)((const char*)g0 + (col0 + bj * 128 + n * 16) * 4u); b0v[bj][n] = *(const f32x4*)((const char*)b0 + (col0 + bj * 128 + n * 16) * 4u); } }
#pragma unroll
        for (int ap = 0; ap < 4; ++ap) { const int ai = ap >> 1, m0 = (ap & 1) * 2;
            f32x4 xv[2][2][2]; v2u xb[2][2][2]; f32x2 st[2];
#pragma unroll
            for (int mm = 0; mm < 2; ++mm) { const unsigned eo = eo0 + (unsigned)((ai * 128 + (m0 + mm) * 16) * D);
                if (L == 1) st[mm] = st0[rowb + (unsigned)(ai * 128 + (m0 + mm) * 16)];
#pragma unroll
                for (int bj = 0; bj < 2; ++bj)
#pragma unroll
                    for (int n = 0; n < 2; ++n) {
                        if (L == 0) xv[mm][bj][n] = *(const f32x4*)((const char*)xp + (eo + bj * 128 + n * 16) * 4u);
                        else xb[mm][bj][n] = *(const v2u*)((const char*)rb0 + (eo + bj * 128 + n * 16) * 2u); } }
#pragma unroll
            for (int mm = 0; mm < 2; ++mm) { const int m = m0 + mm; const unsigned eo = eo0 + (unsigned)((ai * 128 + m * 16) * D); const unsigned row = rowb + (unsigned)(ai * 128 + m * 16);
                float s1 = 0.f, s2 = 0.f;
#pragma unroll
                for (int bj = 0; bj < 2; ++bj)
#pragma unroll
                    for (int n = 0; n < 2; ++n) { f32x4 x;
                        if (L == 0) x = xv[mm][bj][n];
                        else { const v2u w = xb[mm][bj][n]; x = ((f32x4){bflo(w.x), bfhi(w.x), bflo(w.y), bfhi(w.y)} - st[mm].x) * st[mm].y * g0v[bj][n] + b0v[bj][n]; }
                        const f32x4 r = x * ALPHA + gv[bj][n] * (acc[ai][bj][m][n] * (1.0f / (SMG * SWO)));
                        v2u o; o.x = pg8::cvt_pk_bf16(r.x, r.y); o.y = pg8::cvt_pk_bf16(r.z, r.w);
                        *(v2u*)((char*)rb + (eo + bj * 128 + n * 16) * 2u) = o;
                        s1 += (r.x + r.y) + (r.z + r.w); s2 += (r.x * r.x + r.y * r.y) + (r.z * r.z + r.w * r.w); }
                s1 = xadd<32>(xadd<16>(s1)); s2 = xadd<32>(xadd<16>(s2));
                if (fq == 0) rst[(size_t)row * 64 + u.pn * 4 + wc] = (f32x2){s1, s2};
            }
            asm volatile("" ::: "memory");
        }
    }
};

typedef short bf16x8_t __attribute__((ext_vector_type(8)));
typedef short s16x4_t __attribute__((ext_vector_type(4)));
typedef float f32x16 __attribute__((ext_vector_type(16)));
__device__ __forceinline__ s16x4_t vtr(const LAS char* p) { return __builtin_bit_cast(s16x4_t, __builtin_amdgcn_ds_read_tr16_b64_v4i16((LAS s16x4_t*)p)); }
__device__ __forceinline__ bf16x8_t cat8(s16x4_t a, s16x4_t b) { return (bf16x8_t){a[0], a[1], a[2], a[3], b[0], b[1], b[2], b[3]}; }
#define MFMA32(a, b, c) __builtin_amdgcn_mfma_f32_32x32x16_bf16((a), (b), (c), 0, 0, 0)

__device__ __forceinline__ void attn_prompt_unit(Frame& F, int l, int unit) {
    const int kv = unit & 3, n = (unit >> 2) & 15, b = unit >> 6, tid = F.tid, lane = F.lane;
    LAS char* Kl = (LAS char*)F.lds; LAS char* Vl = Kl + 32768;
    const bf16* Kb = WSP(bf16, WS_KB); const bf16* Vb = WSP(bf16, WS_VB); const unsigned char* Qb = WSP(unsigned char, WS_QB); const unsigned char* Za = WSP(unsigned char, WS_ZA); unsigned char* AB = WSP(unsigned char, WS_AB);
    const int rowq0 = b * SEQ + n * 128, rowk0 = rowq0 - 128;
#pragma unroll
    for (int i = 0; i < 4; ++i) { const int idx = tid + 512 * i;
        { const int chunk = idx >> 8, key = idx & 255; v4u v = (v4u){0u, 0u, 0u, 0u};
          if (n > 0 || key >= 128) v = *(const v4u*)(Kb + (size_t)(rowk0 + key) * 256 + kv * 64 + chunk * 8);
          *(LAS v4u*)(Kl + chunk * 4096 + key * 16) = v; }
        { const int dh = idx >> 10, key = (idx >> 2) & 255, c4 = idx & 3; v4u v = (v4u){0u, 0u, 0u, 0u};
          if (n > 0 || key >= 128) v = *(const v4u*)(Vb + (size_t)(rowk0 + key) * 256 + kv * 64 + dh * 32 + c4 * 8);
          *(LAS v4u*)(Vl + dh * 16384 + key * 64 + c4 * 16) = v; } }
    const int h = lane >> 5, r32 = lane & 31, head = kv * 8 + F.wave;
    v2u qn[4];
#pragma unroll
    for (int ks = 0; ks < 4; ++ks) qn[ks] = *(const v2u*)(Qb + (size_t)(rowq0 + r32) * 2048 + head * 64 + 16 * ks + 8 * h);
    __syncthreads();
    const float sink2 = inp(F, I_SINK)[l * 32 + head] * LOG2E;
    const LAS char* kbase = Kl + h * 4096 + r32 * 16;
    const LAS char* vbase = Vl + (4 * h + ((lane & 15) >> 2)) * 64 + ((lane >> 4) & 1) * 32 + (lane & 3) * 8;
#pragma unroll 1
    for (int c = 0; c < 4; ++c) {
        const size_t qrow = (size_t)(rowq0 + 32 * c + r32);
        bf16x8_t qf[4];
#pragma unroll
        for (int ks = 0; ks < 4; ++ks) { const f32x4 a = f8x4(qn[ks].x) * (1.0f / SQ8), b2 = f8x4(qn[ks].y) * (1.0f / SQ8);
            v4u w; w.x = pg8::cvt_pk_bf16(a.x, a.y); w.y = pg8::cvt_pk_bf16(a.z, a.w); w.z = pg8::cvt_pk_bf16(b2.x, b2.y); w.w = pg8::cvt_pk_bf16(b2.z, b2.w);
            qf[ks] = __builtin_bit_cast(bf16x8_t, w); }
        { const size_t qnext = qrow + (c + 1 < 4 ? 32 : 0);
#pragma unroll
            for (int ks = 0; ks < 4; ++ks) qn[ks] = *(const v2u*)(Qb + qnext * 2048 + head * 64 + 16 * ks + 8 * h); }
        unsigned zv[2][4];
#pragma unroll
        for (int dt = 0; dt < 2; ++dt)
#pragma unroll
            for (int g4 = 0; g4 < 4; ++g4) zv[dt][g4] = *(const unsigned*)(Za + qrow * 2048 + head * 64 + 32 * dt + 8 * g4 + 4 * h);
        f32x16 S[5];
#pragma unroll
        for (int k5 = 0; k5 < 5; ++k5)
#pragma unroll
            for (int r = 0; r < 16; ++r) S[k5][r] = 0.f;
        {
          bf16x8_t kf[2][5];
#pragma unroll
          for (int k5 = 0; k5 < 5; ++k5) kf[0][k5] = *(const LAS bf16x8_t*)(kbase + (32 * (c + k5)) * 16);
#pragma unroll
          for (int ks = 0; ks < 4; ++ks) {
              if (ks + 1 < 4) {
#pragma unroll
                  for (int k5 = 0; k5 < 5; ++k5) kf[(ks + 1) & 1][k5] = *(const LAS bf16x8_t*)(kbase + (2 * (ks + 1)) * 4096 + (32 * (c + k5)) * 16); }
              __builtin_amdgcn_sched_barrier(0);
#pragma unroll
              for (int k5 = 0; k5 < 5; ++k5) S[k5] = MFMA32(kf[ks & 1][k5], qf[ks], S[k5]);
              __builtin_amdgcn_sched_barrier(0);
          } }
        float mx = sink2;
#pragma unroll
        for (int k5 = 0; k5 < 5; ++k5) { const bool dead = (n == 0) && (c + k5 < 4);
#pragma unroll
            for (int r = 0; r < 16; ++r) { const int kk = (r & 3) + 8 * (r >> 2) + 4 * h; float v = S[k5][r];
                if (k5 == 0) v = (kk > r32) ? v : -INFINITY;
                if (k5 == 4) v = (kk <= r32) ? v : -INFINITY;
                if (dead) v = -INFINITY;
                S[k5][r] = v; mx = fmaxf(mx, v); } }
        mx = xmax<32>(mx);
        float ls = 0.f;
#pragma unroll
        for (int k5 = 0; k5 < 5; ++k5)
#pragma unroll
            for (int r = 0; r < 16; ++r) { const float p = __builtin_amdgcn_exp2f(S[k5][r] - mx); S[k5][r] = p; ls += p; }
        ls = xadd<32>(ls); ls += __builtin_amdgcn_exp2f(sink2 - mx);
        f32x16 O[2];
#pragma unroll
        for (int r = 0; r < 16; ++r) { O[0][r] = 0.f; O[1][r] = 0.f; }
        {
          s16x4_t vq[2][2][2];
          const LAS char* vp0 = vbase + (32 * c) * 64;
#pragma unroll
          for (int dt = 0; dt < 2; ++dt) { vq[0][dt][0] = vtr(vp0 + dt * 16384); vq[0][dt][1] = vtr(vp0 + dt * 16384 + 512); }
#pragma unroll
          for (int j = 0; j < 10; ++j) { const int k5 = j >> 1, s = j & 1;
              if (j + 1 < 10) { const LAS char* vp = vp0 + (16 * (j + 1)) * 64;
#pragma unroll
                  for (int dt = 0; dt < 2; ++dt) { vq[(j + 1) & 1][dt][0] = vtr(vp + dt * 16384); vq[(j + 1) & 1][dt][1] = vtr(vp + dt * 16384 + 512); } }
              v4u pw; pw.x = pg8::cvt_pk_bf16(S[k5][8 * s + 0], S[k5][8 * s + 1]); pw.y = pg8::cvt_pk_bf16(S[k5][8 * s + 2], S[k5][8 * s + 3]);
              pw.z = pg8::cvt_pk_bf16(S[k5][8 * s + 4], S[k5][8 * s + 5]); pw.w = pg8::cvt_pk_bf16(S[k5][8 * s + 6], S[k5][8 * s + 7]);
              const bf16x8_t pf = __builtin_bit_cast(bf16x8_t, pw);
              __builtin_amdgcn_sched_barrier(0);
#pragma unroll
              for (int dt = 0; dt < 2; ++dt) O[dt] = MFMA32(cat8(vq[j & 1][dt][0], vq[j & 1][dt][1]), pf, O[dt]);
              __builtin_amdgcn_sched_barrier(0);
          } }
        const float inv = SA8 / (SZA8 * ls);
#pragma unroll
        for (int dt = 0; dt < 2; ++dt)
#pragma unroll
            for (int g4 = 0; g4 < 4; ++g4) { const int d0 = head * 64 + 32 * dt + 8 * g4 + 4 * h;
                const f32x4 z = f8x4(zv[dt][g4]);
                *(unsigned*)(AB + qrow * PB8 + d0) = pk4_fp8(O[dt][4 * g4 + 0] * inv * z.x, O[dt][4 * g4 + 1] * inv * z.y, O[dt][4 * g4 + 2] * inv * z.z, O[dt][4 * g4 + 3] * inv * z.w); }
    }
    __syncthreads();
}
__device__ __forceinline__ void attn_sample_unit(Frame& F, int l, int unit) {
    const int kv = unit & 3, b = unit >> 2, h = kv * 8 + F.wave, lane = F.lane, tid = F.tid;
    LAS float* Kf = (LAS float*)F.lds;
    LAS float* Vf = Kf + 8704;
    LAS float* qs = Kf + 17408 + F.wave * 1024;
    LAS float* ps = qs + 256;
    const unsigned char* Qb = WSP(unsigned char, WS_QB); const unsigned char* Za = WSP(unsigned char, WS_ZA); unsigned char* AB = WSP(unsigned char, WS_AB);
    const int row0 = MP + b * 4;
    const float* ck = inp(F, I_CK) + ((size_t)(l * 32 + b) * 128) * 256 + kv * 64;
    const float* cv = inp(F, I_CV) + ((size_t)(l * 32 + b) * 128) * 256 + kv * 64;
    const float* nk = F.out + O_NK + (size_t)(l * 128 + b * 4) * 256 + kv * 64;
    const float* nv = F.out + O_NV + (size_t)(l * 128 + b * 4) * 256 + kv * 64;
    unsigned char zq[4];
#pragma unroll
    for (int t = 0; t < 4; ++t) zq[t] = Za[(size_t)(row0 + t) * 2048 + h * 64 + lane];
    { f32x4 kx[5], vx[5]; unsigned char qv[4];
#pragma unroll
      for (int j = 0; j < 5; ++j) { const int i = tid + 512 * j, ic = i < 132 * 16 ? i : 132 * 16 - 1, key = ic >> 4, d4 = (ic & 15) * 4;
        kx[j] = *(const f32x4*)((key < 128 ? ck + (size_t)key * 256 : nk + (size_t)(key - 128) * 256) + d4);
        vx[j] = *(const f32x4*)((key < 128 ? cv + (size_t)key * 256 : nv + (size_t)(key - 128) * 256) + d4); }
#pragma unroll
      for (int t = 0; t < 4; ++t) qv[t] = Qb[(size_t)(row0 + t) * 2048 + h * 64 + lane];
#pragma unroll
      for (int j = 0; j < 5; ++j) { const int i = tid + 512 * j, key = i >> 4, d4 = (i & 15) * 4;
        if (i < 132 * 16) { LAS float* kd = Kf + key * 65 + d4; kd[0] = kx[j].x; kd[1] = kx[j].y; kd[2] = kx[j].z; kd[3] = kx[j].w;
            *(LAS f32x4*)(Vf + key * 64 + d4) = vx[j]; } }
#pragma unroll
      for (int t = 0; t < 4; ++t) qs[t * 64 + lane] = f8x1(qv[t]) * (1.0f / SQ8); }
    __syncthreads();
    const float sink2 = inp(F, I_SINK)[l * 32 + h] * LOG2E;
    float sc[3][4];
#pragma unroll
    for (int ps_ = 0; ps_ < 3; ++ps_) {
        const int key = ps_ * 64 + lane; const bool inr = key < 132; const LAS float* kr = Kf + (inr ? key : 0) * 65;
        float s[4] = {0.f, 0.f, 0.f, 0.f};
#pragma unroll 4
        for (int d4 = 0; d4 < 16; ++d4) { const float k0 = kr[d4 * 4], k1 = kr[d4 * 4 + 1], k2 = kr[d4 * 4 + 2], k3 = kr[d4 * 4 + 3];
#pragma unroll
            for (int t = 0; t < 4; ++t) { const f32x4 qx = *(const LAS f32x4*)(qs + t * 64 + d4 * 4); s[t] += (qx.x * k0 + qx.y * k1) + (qx.z * k2 + qx.w * k3); } }
#pragma unroll
        for (int t = 0; t < 4; ++t) { const bool ok = inr && (key < 128 ? key > t : (key - 128) <= t); sc[ps_][t] = ok ? s[t] : -INFINITY; }
    }
#pragma unroll
    for (int t = 0; t < 4; ++t) {
        float mx = fmaxf(fmaxf(sc[0][t], sc[1][t]), fmaxf(sc[2][t], sink2));
        mx = xmax_wave(mx);
        float p0 = __builtin_amdgcn_exp2f(sc[0][t] - mx), p1 = __builtin_amdgcn_exp2f(sc[1][t] - mx), p2 = __builtin_amdgcn_exp2f(sc[2][t] - mx);
        float sum = p0 + p1 + p2;
        sum = xadd_wave(sum);
        const float inv = 1.0f / (sum + __builtin_amdgcn_exp2f(sink2 - mx));
        ps[t * 136 + lane] = p0 * inv; ps[t * 136 + 64 + lane] = p1 * inv; if (lane < 8) ps[t * 136 + 128 + lane] = p2 * inv;
    }
    LDS_WAIT(); asm volatile("" ::: "memory");
    float o[4] = {0.f, 0.f, 0.f, 0.f};
#pragma unroll 4
    for (int key = 0; key < 132; ++key) { const float v = Vf[key * 64 + lane];
#pragma unroll
        for (int t = 0; t < 4; ++t) o[t] += ps[t * 136 + key] * v; }
#pragma unroll
    for (int t = 0; t < 4; ++t) { const size_t row = (size_t)(row0 + t); const float z = f8x1(zq[t]) * (1.0f / SZA8);
        AB[row * PB8 + h * 64 + lane] = (unsigned char)(pk4_fp8(o[t] * z * SA8, 0.f, 0.f, 0.f) & 0xffu); }
    __syncthreads();
}
__device__ __forceinline__ void sgu_prompt_unit(Frame& F, int l, int unit, int par) {
    const int g = unit & 7, n = (unit >> 3) & 15, b = unit >> 7, tid = F.tid, lane = F.lane, w = F.wave;
    LAS f32x2* rs = (LAS f32x2*)(F.lds + 65536) + par * 128;
    LAS char* Lw = (LAS char*)F.lds + w * 8192;
    const f32x2* vst = WSP(f32x2, WS_VST); const unsigned char* Vbb = WSP(unsigned char, WS_VBB); const unsigned char* UZ = WSP(unsigned char, WS_UZ); unsigned char* AB = WSP(unsigned char, WS_AB); const bf16* Wsb = WSP(bf16, WS_WSB);
    const int row0 = b * SEQ + n * 128, colw = g * 256 + 32 * w, h = lane >> 5, r32 = lane & 31, ch = lane & 3;
    f32x2 pst[8];
    { const int row = tid >> 2, part = tid & 3;
#pragma unroll
      for (int k = 0; k < 8; ++k) pst[k] = vst[(size_t)(row0 + row) * 32 + part * 8 + k]; }
    v2u xv[8];
#pragma unroll
    for (int i = 0; i < 8; ++i) xv[i] = *(const v2u*)(Vbb + (size_t)(row0 + (lane >> 2) + 16 * i) * 2048 + colw + ch * 8);
    unsigned uzv[4][4];
#pragma unroll
    for (int tb = 0; tb < 4; ++tb)
#pragma unroll
        for (int g4 = 0; g4 < 4; ++g4) uzv[tb][g4] = *(const unsigned*)(UZ + (size_t)(row0 + 32 * tb + r32) * 2048 + colw + 8 * g4 + 4 * h);
    const float* sg = inp(F, I_SG) + l * 2048 + colw + ch * 8; const float* sb = inp(F, I_SB) + l * 2048 + colw + ch * 8;
    const f32x4 g0 = *(const f32x4*)sg, g1 = *(const f32x4*)(sg + 4), b0 = *(const f32x4*)sb, b1 = *(const f32x4*)(sb + 4);
    const float* bs = inp(F, I_SBS) + (size_t)(l * 8 + g) * 128;
    float bst[4];
#pragma unroll
    for (int tb = 0; tb < 4; ++tb) bst[tb] = bs[32 * tb + r32];
    const bf16* Wg = Wsb + (size_t)(l * 8 + g) * 16384 + 8 * h;
    bf16x8_t bfr[20];
#pragma unroll
    for (int tb = 0; tb < 4; ++tb)
#pragma unroll
        for (int ks = 0; ks < 2 * tb + 2; ++ks) bfr[tb * (tb + 1) + ks] = *(const bf16x8_t*)(Wg + (32 * tb + r32) * 128 + 16 * ks);
    { const int row = tid >> 2, part = tid & 3; float s1 = 0.f, s2 = 0.f;
#pragma unroll
      for (int k = 0; k < 8; ++k) { s1 += pst[k].x; s2 += pst[k].y; }
      s1 = xadd<2>(xadd<1>(s1)); s2 = xadd<2>(xadd<1>(s2));
      const float mean = s1 * (1.0f / 2048.0f), var = s2 * (1.0f / 2048.0f) - mean * mean;
      if (part == 0) rs[row] = (f32x2){mean, 1.0f / sqrtf(var + LN_EPS)}; }
    __syncthreads();
#pragma unroll
    for (int i = 0; i < 8; ++i) { const int sp = (lane >> 2) + 16 * i; const v2u x = xv[i]; const f32x2 st = rs[sp];
        const f32x4 v0 = (f8x4(x.x) * (1.0f / SVB8) - st.x) * st.y * g0 + b0;
        const f32x4 v1 = (f8x4(x.y) * (1.0f / SVB8) - st.x) * st.y * g1 + b1;
        v4u o; o.x = pg8::cvt_pk_bf16(v0.x, v0.y); o.y = pg8::cvt_pk_bf16(v0.z, v0.w); o.z = pg8::cvt_pk_bf16(v1.x, v1.y); o.w = pg8::cvt_pk_bf16(v1.z, v1.w);
        *(LAS v4u*)(Lw + sp * 64 + ch * 16) = o; }
    LDS_WAIT(); asm volatile("" ::: "memory");
    bf16x8_t af[8];
    { const LAS char* ap = Lw + (8 * h + ((lane & 15) >> 2)) * 64 + ((lane >> 4) & 1) * 32 + (lane & 3) * 8;
#pragma unroll
      for (int ks = 0; ks < 8; ++ks) af[ks] = cat8(vtr(ap + ks * 1024), vtr(ap + ks * 1024 + 256)); }
#pragma unroll
    for (int tb = 0; tb < 4; ++tb) { const int t = 32 * tb + r32; f32x16 a;
#pragma unroll
        for (int r = 0; r < 16; ++r) a[r] = 0.f;
#pragma unroll
        for (int ks = 0; ks < 2 * tb + 2; ++ks) a = MFMA32(af[ks], bfr[tb * (tb + 1) + ks], a);
        const size_t row = (size_t)(row0 + t);
#pragma unroll
        for (int g4 = 0; g4 < 4; ++g4) { const int c0 = colw + 8 * g4 + 4 * h;
            const f32x4 uz = f8x4(uzv[tb][g4]) * (SB8 / SUZ8);
            *(unsigned*)(AB + row * PB8 + 2048 + c0) = pk4_fp8(uz.x * (a[4 * g4 + 0] + bst[tb]), uz.y * (a[4 * g4 + 1] + bst[tb]), uz.z * (a[4 * g4 + 2] + bst[tb]), uz.w * (a[4 * g4 + 3] + bst[tb])); }
    }
    LDS_WAIT(); asm volatile("" ::: "memory");
}
__device__ __forceinline__ void sgu_sample_unit(Frame& F, int l, int b) {
    const int tid = F.tid, c0 = tid * 4, g = c0 >> 8, row0 = MP + b * 4;
    LAS f32x2* rs = (LAS f32x2*)(F.lds);
    const f32x2* vst = WSP(f32x2, WS_VST); const unsigned char* UZ = WSP(unsigned char, WS_UZ); unsigned char* AB = WSP(unsigned char, WS_AB);
    const bf16* Vbs = WSP(bf16, WS_VBS);
    if (tid < 128) { const int row = tid >> 5, k = tid & 31; const f32x2 p = vst[(size_t)(row0 + row) * 32 + k]; float s1 = p.x, s2 = p.y;
        s1 = xadd_32(s1); s2 = xadd_32(s2);
        const float mean = s1 * (1.0f / 2048.0f), var = s2 * (1.0f / 2048.0f) - mean * mean;
        if (k == 0) rs[row] = (f32x2){mean, 1.0f / sqrtf(var + LN_EPS)}; }
    __syncthreads();
    const f32x4 gn = *(const f32x4*)(inp(F, I_SG) + l * 2048 + c0), bi = *(const f32x4*)(inp(F, I_SB) + l * 2048 + c0);
    f32x4 ln[4];
#pragma unroll
    for (int t = 0; t < 4; ++t) { const v2u w = *(const v2u*)(Vbs + (size_t)(b * 4 + t) * 2048 + c0); const f32x2 st = rs[t];
        ln[t] = ((f32x4){bflo(w.x), bfhi(w.x), bflo(w.y), bfhi(w.y)} - st.x) * st.y * gn + bi;
        *(f32x4*)(F.out + O_SV + ((size_t)(l * 32 + b) * 4 + t) * 2048 + c0) = ln[t]; }
    const float* Wg = inp(F, I_SW) + (size_t)(l * 8 + g) * 16384; const float* bs = inp(F, I_SBS) + (size_t)(l * 8 + g) * 128;
#pragma unroll
    for (int t = 0; t < 4; ++t) { f32x4 a = (f32x4){bs[t], bs[t], bs[t], bs[t]};
#pragma unroll
        for (int s = 0; s <= t; ++s) a += Wg[t * 128 + s] * ln[s];
        const f32x4 uz = f8x4(*(const unsigned*)(UZ + (size_t)(row0 + t) * 2048 + c0)) * (SB8 / SUZ8);
        *(unsigned*)(AB + (size_t)(row0 + t) * PB8 + 2048 + c0) = pk4_fp8(uz.x * a.x, uz.y * a.y, uz.z * a.z, uz.w * a.w); }
    __syncthreads();
}

template <int MODE> __device__ __forceinline__ void skinny_gemm(Frame& F, int l, int unit) {
    const int lane = F.lane, w = F.wave, r16 = lane & 15, kq = lane >> 4, rb = w & 1, cb = w >> 1;
    const int rin = 32 * (unit & 3) + 16 * rb + r16, row = MP + rin, n0 = 64 * (unit >> 2), col = n0 + 16 * cb + 4 * kq;
    LAS char* R0 = (LAS char*)F.lds;
    const int lr = lane >> 5, lc = lane & 31;
    const char* Ag[2]; const char* Bg[4];
#pragma unroll
    for (int i = 0; i < 2; ++i) { const int r = 2 * (2 * w + i) + lr; Ag[i] = (const char*)(MODE == 0 ? WSP(unsigned char, WS_AB) : WSP(unsigned char, WS_MG)) + (size_t)(MP + 32 * (unit & 3) + r) * PB8 + ((lc ^ (r & 15)) & 31) * 16; }
#pragma unroll
    for (int i = 0; i < 4; ++i) { const int r = 2 * (4 * w + i) + lr; Bg[i] = (const char*)(MODE == 0 ? WSP(unsigned char, WS_WP) : WSP(unsigned char, WS_WO)) + (size_t)l * D * PB8 + (size_t)(n0 + r) * PB8 + ((lc ^ (r & 15)) & 31) * 16; }
#define SK_STAGE(blk) do { LAS char* Rd = R0 + ((blk) % 3) * 49152; \
        _Pragma("unroll") for (int i = 0; i < 2; ++i) __builtin_amdgcn_global_load_lds((const unsigned*)(Ag[i] + (blk) * 512), (LAS unsigned*)(Rd + (2 * w + i) * 1024), 16, 0, 0); \
        _Pragma("unroll") for (int i = 0; i < 4; ++i) __builtin_amdgcn_global_load_lds((const unsigned*)(Bg[i] + (blk) * 512), (LAS unsigned*)(Rd + 16384 + (4 * w + i) * 1024), 16, 0, 0); } while (0)
    SK_STAGE(0); SK_STAGE(1);
    f32x4 acc = (f32x4){0.f, 0.f, 0.f, 0.f};
#pragma unroll 1
    for (int blk = 0; blk < 8; ++blk) {
        if (blk + 1 < 8) asm volatile("s_waitcnt vmcnt(6)" ::: "memory");
        else asm volatile("s_waitcnt vmcnt(0)" ::: "memory");
        __builtin_amdgcn_s_barrier(); asm volatile("" ::: "memory");
        if (blk + 2 < 8) SK_STAGE(blk + 2);
        if (MODE == 0 && blk == 4) { const v2u x = *(const v2u*)(WSP(bf16, WS_RR) + (size_t)row * D + col); acc = acc * ((f32x4){bflo(x.x), bfhi(x.x), bflo(x.y), bfhi(x.y)} * (SB8 / SA8)); }
        const LAS char* Ab = R0 + (blk % 3) * 49152 + (16 * rb + r16) * 512; const LAS char* Bb = R0 + (blk % 3) * 49152 + 16384 + (16 * cb + r16) * 512;
        pg8::v4i_t fa[4][2], fb[4][2];
#pragma unroll
        for (int u = 0; u < 4; ++u) { const int c0 = ((8 * u + kq) ^ r16) & 31, c1 = ((8 * u + 4 + kq) ^ r16) & 31;
            fa[u][0] = *(const LAS pg8::v4i_t*)(Ab + c0 * 16); fa[u][1] = *(const LAS pg8::v4i_t*)(Ab + c1 * 16);
            fb[u][0] = *(const LAS pg8::v4i_t*)(Bb + c0 * 16); fb[u][1] = *(const LAS pg8::v4i_t*)(Bb + c1 * 16); }
        __builtin_amdgcn_sched_barrier(0);
#pragma unroll
        for (int u = 0; u < 4; ++u)
            acc = __builtin_amdgcn_mfma_scale_f32_16x16x128_f8f6f4(__builtin_shufflevector(fb[u][0], fb[u][1], 0, 1, 2, 3, 4, 5, 6, 7), __builtin_shufflevector(fa[u][0], fa[u][1], 0, 1, 2, 3, 4, 5, 6, 7), acc, 0, 0, 0, 0x7f7f7f7f, 0, 0x7f7f7f7f);
        asm volatile("s_waitcnt lgkmcnt(0)" ::: "memory");
    }
    __builtin_amdgcn_s_barrier(); asm volatile("" ::: "memory");
#undef SK_STAGE
    if (MODE == 0) {
        const unsigned sg = *(const unsigned*)(WSP(unsigned char, WS_SGB) + (size_t)row * D + col);
        const f32x4 v = acc * (f8x4(sg) * (SMG / (SB8 * SWP * SG8)));
        *(unsigned*)(WSP(unsigned char, WS_MG) + (size_t)row * PB8 + col) = pk4_fp8(v.x, v.y, v.z, v.w);
    } else {
        const float* xr = (l == 0 ? inp(F, I_XS) : WSP(float, WS_X1S)) + (size_t)rin * D + col;
        const float* gr = WSP(float, WS_MOD) + (size_t)(l * NSEQ + 4 + (rin >> 2)) * NMOD + 2 * D + col;
        const f32x4 r = *(const f32x4*)xr * ALPHA + *(const f32x4*)gr * (acc * (1.0f / (SMG * SWO)));
        *(f32x4*)(WSP(float, WS_RS) + (size_t)rin * D + col) = r;
    }
}
__device__ __forceinline__ void ln_sample_row(Frame& F, int l, int rin, float* dst, bool hb) {
    const int row = MP + rin, seq = 4 + (rin >> 2), lane = F.lane;
    const float* rp = WSP(float, WS_RS) + (size_t)rin * D + lane * 4;
    f32x4 v[16]; float s1 = 0.f;
#pragma unroll
    for (int j = 0; j < 16; ++j) { v[j] = *(const f32x4*)(rp + 256 * j); s1 += (v[j].x + v[j].y) + (v[j].z + v[j].w); }
    s1 = xadd_wave(s1);
    const float mean = s1 * (1.0f / 4096.0f); float s2 = 0.f;
#pragma unroll
    for (int j = 0; j < 16; ++j) { v[j] = v[j] - mean; s2 += (v[j].x * v[j].x + v[j].y * v[j].y) + (v[j].z * v[j].z + v[j].w * v[j].w); }
    s2 = xadd_wave(s2);
    const float rstd = 1.0f / sqrtf(s2 * (1.0f / 4096.0f) + LN_EPS);
    const float* lg = inp(F, I_LNG) + l * D + lane * 4; const float* lb = inp(F, I_LNB) + l * D + lane * 4;
    const float* md = WSP(float, WS_MOD) + (size_t)(1 * NSEQ + seq) * NMOD + lane * 4; bf16* Hb = WSP(bf16, WS_HB) + (size_t)row * LDK + lane * 4; unsigned char* Hb8 = WSP(unsigned char, WS_HB8) + (size_t)row * PB8 + lane * 4;
#pragma unroll
    for (int j = 0; j < 16; ++j) { const f32x4 o = v[j] * rstd * *(const f32x4*)(lg + 256 * j) + *(const f32x4*)(lb + 256 * j);
        *(f32x4*)(dst + lane * 4 + 256 * j) = o;
        if (hb) { const f32x4 hv = o * (*(const f32x4*)(md + D + 256 * j) + 1.0f) + *(const f32x4*)(md + 256 * j); v2u p; p.x = pk2(hv.x, hv.y); p.y = pk2(hv.z, hv.w); *(GAS v2u*)(Hb + 256 * j) = p;
            *(GAS unsigned*)(Hb8 + 256 * j) = pk4_fp8(hv.x * SH8, hv.y * SH8, hv.z * SH8, hv.w * SH8); } }
}

__device__ __forceinline__ void ln_rows(Frame& F, int l, int row0, int nrows, int seq, int slice, float* dst  ) {
    const int col = slice * 1024 + F.lane * 4; const bool hb = (l == 0);
    f32x4 gn[4], bi[4], sh[4], sc[4];
    const float* md = WSP(float, WS_MOD) + (size_t)(1 * NSEQ + seq) * NMOD; const float* lg = inp(F, I_LNG) + l * D; const float* lb = inp(F, I_LNB) + l * D;
    const f32x2* rst = WSP(f32x2, WS_RST); const bf16* Rb = l == 0 ? WSP(bf16, WS_RB0) : WSP(bf16, WS_RB1); bf16* Hb = WSP(bf16, WS_HB); unsigned char* Hb8 = WSP(unsigned char, WS_HB8); f32x2* st0 = WSP(f32x2, WS_ST0);
    const bool wb = (row0 & 2047) >= 1792;
#pragma unroll
    for (int j = 0; j < 4; ++j) { gn[j] = *(const f32x4*)(lg + col + 256 * j); bi[j] = *(const f32x4*)(lb + col + 256 * j);
        if (hb) { sh[j] = *(const f32x4*)(md + col + 256 * j); sc[j] = *(const f32x4*)(md + D + col + 256 * j) + 1.0f; } else { sh[j] = (f32x4){0.f, 0.f, 0.f, 0.f}; sc[j] = sh[j]; } }
    for (int r0 = 0; r0 < nrows; r0 += 4) {
      f32x2 pp[4]; v2u wv[4][4];
#pragma unroll
      for (int rr = 0; rr < 4; ++rr) pp[rr] = rst[(size_t)(row0 + r0 + rr) * 64 + F.lane];
#pragma unroll
      for (int rr = 0; rr < 4; ++rr)
#pragma unroll
          for (int j = 0; j < 4; ++j) wv[rr][j] = *(const v2u*)(Rb + (size_t)(row0 + r0 + rr) * D + col + 256 * j);
#pragma unroll
      for (int rr = 0; rr < 4; ++rr) { const int r = r0 + rr;
        float s1 = pp[rr].x, s2 = pp[rr].y;
        s1 = xadd_wave(s1); s2 = xadd_wave(s2);
        const float mean = s1 * (1.0f / 4096.0f), var = s2 * (1.0f / 4096.0f) - mean * mean, rstd = 1.0f / sqrtf(var + LN_EPS);
        if (hb && slice == 0 && F.lane == 0) st0[row0 + r] = (f32x2){mean, rstd};
#pragma unroll
        for (int j = 0; j < 4; ++j) { const v2u w = wv[rr][j];
            const f32x4 v = ((f32x4){bflo(w.x), bfhi(w.x), bflo(w.y), bfhi(w.y)} - mean) * rstd * gn[j] + bi[j];
            if (hb) { const f32x4 hv = v * sc[j] + sh[j]; *(GAS unsigned*)(Hb8 + (size_t)(row0 + r) * PB8 + col + 256 * j) = pk4_fp8(hv.x * SH8, hv.y * SH8, hv.z * SH8, hv.w * SH8);
                if (wb) { v2u o; o.x = pk2(hv.x, hv.y); o.y = pk2(hv.z, hv.w); *(GAS v2u*)(Hb + (size_t)(row0 + r) * LDK + col + 256 * j) = o; } }
            else *(f32x4*)(dst + (size_t)r * D + col + 256 * j) = v; }
      }
    }
}

struct Args { const float* in[19]; float* out; unsigned char* ws; int ph_lo, ph_hi; };
#ifndef PH_MASK
#define PH_MASK 0xfff
#endif
__global__ void __launch_bounds__(NWAVES * 64, 2) mk_fwd(Args args) {
    extern __shared__ __attribute__((aligned(16))) unsigned char lds[];
    Frame F;
    F.lds = (LAS unsigned char*)lds;
    volatile LAS unsigned* MISC = (volatile LAS unsigned*)(F.lds + MISC_OFF);
    F.tid = threadIdx.x; F.lane = F.tid & 63; F.wave = __builtin_amdgcn_readfirstlane(F.tid >> 6); F.bx = blockIdx.x;
    F.ws = args.ws; F.out = args.out;
    gu32* ctl = (gu32*)(F.ws + WS_CTL);
    asm volatile("s_setreg_imm32_b32 hwreg(HW_REG_MODE, 23, 1), 1");
    for (int u = F.tid; u < (LDS_BYTES - LDSCTL_OFF) / 4; u += NWAVES * 64) ((LAS unsigned*)(F.lds + LDSCTL_OFF))[u] = 0u;
    __syncthreads();
    if (F.tid == 0) { volatile LAS unsigned long long* pt = (volatile LAS unsigned long long*)(F.lds + PTAB_OFF);
#pragma unroll
        for (int k = 0; k < 19; ++k) pt[k] = (unsigned long long)args.in[k]; }
    __syncthreads();
#if MK_SPLIT
    const int lo = args.ph_lo, hi = args.ph_hi;
#else
    constexpr int lo = 0, hi = 12;
#endif
    const bool use_bar = (hi - lo) > 1;
    XcdBarrier bar; bar.bar = (unsigned*)(ctl + CW_BAR); bar.x = 0; bar.st = nullptr;
    if (use_bar) bar = xcd_barrier_post((unsigned*)(ctl + CW_BAR), MISC + 8);
#define IN(k) (((PH_MASK >> ((k) > 6 ? (k) - 5 : (k))) & 1) && lo <= (k) && (k) < hi)
#define SEAM(k) do { if (lo <= (k) && (k) + 1 < hi) { REFRESH(); xcd_barrier(bar, F.tid == 0); } } while (0)
#define REFRESH() do { int t_, w_ = wave0, b_ = bx0; asm volatile("v_mbcnt_lo_u32_b32 %0, -1, 0\n\tv_mbcnt_hi_u32_b32 %0, -1, %0" : "=v"(t_), "+s"(w_), "+s"(b_)); F.lane = t_; F.wave = w_; F.bx = b_; F.tid = w_ * 64 + t_; } while (0)
#define GW (F.bx * NWAVES + F.wave)
    const int NGW = F.G * NWAVES; const int wave0 = F.wave, bx0 = F.bx;

    if (IN(0)) {
        asm volatile("; MARK_P0a");
        REFRESH();
        if (F.bx < 192) ada_item(F, F.bx);
        LAS float* scr = (LAS float*)(F.lds + F.wave * 16384);
        int sh = F.bx & 7, left = 8;
        for (;;) {
            const int v = pull8(ctl + CW_WORK0, (I_LAYER + I_WS) / 8, sh, left, F.lane);
            if (v < 0) break;
            copy_chunk(F, v < I_LAYER ? v : I_TR + (v - I_LAYER), scr);
        }
    }
    SEAM(0);
    if (IN(1)) {
        asm volatile("; MARK_P0b");
        REFRESH();
        for (int it = GW; it < 2048 + 128; it += NGW) {
            if (it < 2048) { const int rb = it >> 2, sl = it & 3; h_rows(F, inp(F, I_XP) + (size_t)rb * 16 * D, rb * 16, 16, rb >> 7, sl, 0); }
            else { const int q = it - 2048, sq = q >> 2, sl = q & 3; h_rows(F, inp(F, I_XS) + (size_t)sq * 4 * D, MP + sq * 4, 4, 4 + sq, sl, 0); }
        }
    }
    SEAM(1);
#pragma unroll 1
    for (int l = 0; l < 2; ++l) {
        const int pb = 2 + 5 * l;
        if (IN(pb)) {
            asm volatile("; MARK_GEMM1");
            REFRESH();
            { pg8::Gemm g8{WSP(bf16, WS_HB8), (const bf16*)(WSP(unsigned char, WS_WIN8) + (size_t)l * NIN * PB8), MPAD, NIN, K8};
              OrderF8 S; S.c = F.bx; EpiInT<true> E{F.ws, F.out, l};
              pg8::gemm_phase<K8, LD8, EpiInT<true>, OrderF8, PG8_ALIGN, PG8_SP2, false, true>(F.lds, g8, S, E, F.wave); }
            REFRESH();
            { pg8::Gemm g{WSP(bf16, WS_HB), WSP(bf16, WS_WIN) + (size_t)l * NIN * LDK, MPAD, NIN, D};
              OrderBf S; S.c = F.bx; EpiInT<false> E{F.ws, F.out, l};
              pg8::gemm_phase<D, LDK, EpiInT<false>, OrderBf, PG8_ALIGN, PG8_SP2>(F.lds, g, S, E, F.wave); }
            if (l == 0) {
                REFRESH();
                if (F.tid == 0) (void)__hip_atomic_fetch_add((unsigned*)(ctl + CW_DONE1), 1u, RLX_AGENT);
                if (F.bx >= G1_UNITS - 2048 - G1_NF8W && F.bx < G1_NF8W) steal_copies(F, true, 1, 3);
            } else {
                REFRESH();
                if (F.bx >= G1_UNITS - 2048 - G1_NF8W && F.bx < G1_NF8W) steal_copies(F, false, 2, 1 << 20);
            }
        }
        SEAM(pb);
        if (IN(pb + 1)) {
            asm volatile("; MARK_MIX");
            REFRESH();
            for (int u = F.bx; u < 256; u += F.G) attn_prompt_unit(F, l, u);
            REFRESH();
            { int par = 0; for (int u = F.bx; u < 512; u += F.G) { sgu_prompt_unit(F, l, u, par); par ^= 1; } }
            __syncthreads();
            REFRESH();
            for (int u = F.bx; u < 128; u += F.G) attn_sample_unit(F, l, u);
            REFRESH();
            for (int u = F.bx - 128; u < 32; u += F.G) if (u >= 0) sgu_sample_unit(F, l, u);
        }
        SEAM(pb + 1);
        if (IN(pb + 2)) {
            asm volatile("; MARK_GEMM2");
            REFRESH();
            pg8::Gemm g{WSP(bf16, WS_AB), (const bf16*)(WSP(unsigned char, WS_WP) + (size_t)l * D * PB8), MP, D, K8}; pg8::StaticOrderC<MP, D> S; S.init(F.G, F.bx);
            EpiMerge E{WSP(bf16, WS_RR), WSP(unsigned char, WS_SGB), WSP(unsigned char, WS_MG)};
            if (F.bx & 8) { skinny_gemm<0>(F, l, F.bx); REFRESH(); }
            pg8::gemm_phase<K8, LD8, EpiMerge, pg8::StaticOrderC<MP, D>, PG8_ALIGN, PG8_SP2, false, true>(F.lds, g, S, E, F.wave);
            REFRESH();
            if (!(F.bx & 8)) skinny_gemm<0>(F, l, F.bx);
        }
        SEAM(pb + 2);
        if (IN(pb + 3)) {
            asm volatile("; MARK_GEMM3");
            REFRESH();
            pg8::Gemm g{WSP(bf16, WS_MG), (const bf16*)(WSP(unsigned char, WS_WO) + (size_t)l * D * PB8), MP, D, K8}; pg8::StaticOrderC<MP, D> S; S.init(F.G, F.bx);
            if (F.bx & 8) { skinny_gemm<1>(F, l, F.bx); REFRESH(); }
            if (l == 0) { EpiOutT<0> E{inp(F, I_XP), nullptr, nullptr, nullptr, nullptr, WSP(float, WS_MOD) + 2 * D, WSP(bf16, WS_RB0), WSP(f32x2, WS_RST)};
                pg8::gemm_phase<K8, LD8, EpiOutT<0>, pg8::StaticOrderC<MP, D>, PG8_ALIGN, PG8_SP2, false, true>(F.lds, g, S, E, F.wave); }
            else { EpiOutT<1> E{nullptr, WSP(bf16, WS_RB0), WSP(f32x2, WS_ST0), inp(F, I_LNG), inp(F, I_LNB), WSP(float, WS_MOD) + (size_t)NSEQ * NMOD + 2 * D, WSP(bf16, WS_RB1), WSP(f32x2, WS_RST)};
                pg8::gemm_phase<K8, LD8, EpiOutT<1>, pg8::StaticOrderC<MP, D>, PG8_ALIGN, PG8_SP2, false, true>(F.lds, g, S, E, F.wave); }
            REFRESH();
            if (!(F.bx & 8)) skinny_gemm<1>(F, l, F.bx);
        }
        SEAM(pb + 3);
        if (IN(pb + 4)) {
            asm volatile("; MARK_LN");
            REFRESH();
            float* dp = F.out + O_YP; float* ds = l == 0 ? WSP(float, WS_X1S) : F.out + O_YS;
            for (int it = GW; it < 2048 + 128; it += NGW) {
                if (it < 2048) { const int rb = it >> 2, sl = it & 3; ln_rows(F, l, rb * 16, 16, rb >> 7, sl, dp + (size_t)rb * 16 * D); }
                else { const int rin = it - 2048; ln_sample_row(F, l, rin, ds + (size_t)rin * D, l == 0); }
            }
            if (l == 0) steal_copies(F, false, 1, 1 << 20);
        }
        if (l == 0) SEAM(pb + 4);
    }
#undef IN
#undef SEAM
}

extern "C" void kernel_launch(void* const* d_in, const int* in_sizes, int n_in, void* d_out, int out_size, void* d_ws, size_t ws_size, hipStream_t stream) {
    static int grid = 0;
    if (grid == 0) {
        if (n_in != 19 || out_size != (int)O_END || ws_size < WS_END) { fprintf(stderr, "kernel_launch: unexpected sizes (n_in %d, out %d, ws %zu); nothing launched\n", n_in, out_size, ws_size); grid = -1; return; }
        int dev = 0, cus = 0, per_cu = 0;
        if (hipGetDevice(&dev) != hipSuccess || hipDeviceGetAttribute(&cus, hipDeviceAttributeMultiprocessorCount, dev) != hipSuccess) { grid = -1; return; }
        if (hipFuncSetAttribute((const void*)mk_fwd, hipFuncAttributeMaxDynamicSharedMemorySize, LDS_BYTES) != hipSuccess) { fprintf(stderr, "kernel_launch: hipFuncSetAttribute failed\n"); grid = -1; return; }
        if (hipOccupancyMaxActiveBlocksPerMultiprocessor(&per_cu, (const void*)mk_fwd, NWAVES * 64, LDS_BYTES) != hipSuccess || per_cu < 1)
            fprintf(stderr, "kernel_launch: note: occupancy query reports %d workgroups per CU\n", per_cu);
        (void)hipGetLastError();
        if (cus != Frame::G) { fprintf(stderr, "kernel_launch: built for a %d-CU device, found %d CUs; nothing launched\n", Frame::G, cus); grid = -1; return; }
        grid = cus;
    }
    if (grid < 0) return;
    if (hipMemsetAsync((char*)d_ws + WS_CTL, 0, CTL_ZERO_BYTES, stream) != hipSuccess) return;
    Args a{};
    for (int i = 0; i < 19; ++i) a.in[i] = (const float*)d_in[i];
    a.out = (float*)d_out; a.ws = (unsigned char*)d_ws;
#if MK_SPLIT
    for (int p = 0; p < 12; ++p) { a.ph_lo = p; a.ph_hi = p + 1; hipLaunchKernelGGL(mk_fwd, dim3(grid), dim3(NWAVES * 64), LDS_BYTES, stream, a); }
#else
    a.ph_lo = 0; a.ph_hi = 12;
    hipLaunchKernelGGL(mk_fwd, dim3(grid), dim3(NWAVES * 64), LDS_BYTES, stream, a);
#endif
    const hipError_t le = hipPeekAtLastError();
    if (le != hipSuccess) fprintf(stderr, "kernel_launch: launch failed: %s\n", hipGetErrorName(le));
}
```

```cpp
#include <hip/hip_runtime.h>
#include <cstdio>
#include <cstdint>

namespace pg8 {
#define PG8_LAS __attribute__((address_space(3)))
typedef unsigned short bf16_t;
typedef short bf16x8 __attribute__((ext_vector_type(8)));
typedef float f32x4 __attribute__((ext_vector_type(4)));
typedef unsigned u32x4 __attribute__((ext_vector_type(4)));
typedef unsigned u32x2 __attribute__((ext_vector_type(2)));
typedef int v4i_t __attribute__((ext_vector_type(4)));
constexpr int BM = 256, BK = 64, HALF = 128, HTB = HALF * BK * 2  , STAGE_BYTES = 8 * HTB, NXCD = 8, WGM = 8;

__host__ __device__ __forceinline__ int lds_byte(int r, int c) { const int st = (r >> 4) * 2 + (c >> 5), rr = r & 15, cc = c & 31, ob = rr * 64 + cc * 2; return st * 1024 + (ob ^ (((ob >> 9) & 1) << 5)); }
__host__ __device__ __forceinline__ void stage_rc(int b, int& R, int& C) { const int st = b / 1024, sb = b % 1024, swz = sb ^ (((sb >> 9) & 1) << 5); R = (st >> 1) * 16 + swz / 64; C = (st & 1) * 32 + (swz % 64) / 2; }
__host__ __device__ __forceinline__ int perm32(int rho) { const int n = rho >> 4, i = rho & 15; return 8 * (i >> 2) + 4 * n + (i & 3); }

struct Unit { int pm, pn; };
struct Gemm { const bf16_t* A; const bf16_t* Bt; int M, N, K; };

template <int MC, int NC> struct StaticOrderC {
    static constexpr int nM = MC / BM, nN = NC / BM, nwg = nM * nN;
    int G, c;
    __host__ __device__ void init(int G_, int c_) { G = G_; c = c_; }
    __host__ __device__ static void map(int L, Unit& u) {
        int wgid = L; { constexpr int q = nwg / NXCD, r = nwg % NXCD; const int xcd = wgid % NXCD, off = wgid / NXCD; wgid = (xcd < r ? xcd * (q + 1) : r * (q + 1) + (xcd - r) * q) + off; }
        constexpr int nig = WGM * nN; const int gid = wgid / nig, fm = gid * WGM, gsz = (nM - fm) < WGM ? (nM - fm) : WGM;
        u.pm = fm + ((wgid % nig) % gsz); u.pn = (wgid % nig) / gsz;
    }
    __host__ __device__ bool next(int i, Unit& u) const {
        const int L = i * G + c; if (L >= nwg) return false;
        int wgid = L; { constexpr int q = nwg / NXCD, r = nwg % NXCD; const int xcd = wgid % NXCD, off = wgid / NXCD; wgid = (xcd < r ? xcd * (q + 1) : r * (q + 1) + (xcd - r) * q) + off; }
        constexpr int nig = WGM * nN; const int gid = wgid / nig, fm = gid * WGM, gsz = (nM - fm) < WGM ? (nM - fm) : WGM;
        u.pm = fm + ((wgid % nig) % gsz); u.pn = (wgid % nig) / gsz; return true;
    }
    __device__ __forceinline__ void a_ready(const Unit&) const {}
    __device__ __forceinline__ void done(const Unit&) const {}
};

__device__ __forceinline__ unsigned cvt_pk_bf16(float lo, float hi) { unsigned r; asm volatile("v_cvt_pk_bf16_f32 %0, %1, %2" : "=v"(r) : "v"(lo), "v"(hi)); return r; }

template <int KC, int LD, class Epi, class Sched, bool ALIGN_EPI = false, bool SP2 = false, bool HM = false, bool F8 = false>
__device__ __forceinline__ void gemm_phase(PG8_LAS unsigned char* lds, const Gemm g, const Sched& S, const Epi& E, const int wid_) {
    const int wid = __builtin_amdgcn_readfirstlane(wid_);
    int lane_; asm volatile("v_mbcnt_lo_u32_b32 %0, -1, 0\n\tv_mbcnt_hi_u32_b32 %0, -1, %0" : "=v"(lane_));
    const int lane = lane_, tid = wid * 64 + lane, wr = wid >> 2, wc = wid & 3, fr = lane & 15, fq = lane >> 4;
    constexpr int K = KC, nt = K / BK;
    unsigned voffA[2], voffB[2];
#pragma unroll
    for (int i = 0; i < 2; ++i) { int R, C; stage_rc(tid * 16 + i * 8192, R, C); const int Rb = Epi::PERM ? ((R & ~31) + perm32(R & 31)) : R;
        voffA[i] = (unsigned)(R * LD + C) * 2u; voffB[i] = (unsigned)(Rb * LD + C) * 2u; }
    constexpr unsigned kstep = (unsigned)(BK * 2);
    constexpr unsigned hstep = (unsigned)(HALF * LD * 2);
    constexpr unsigned tstep = 2 * hstep;
    const __amdgpu_buffer_rsrc_t rA = __builtin_amdgcn_make_buffer_rsrc((void*)g.A, 0, 0x7fffffff, 0x00020000), rB = __builtin_amdgcn_make_buffer_rsrc((void*)g.Bt, 0, 0x7fffffff, 0x00020000);
    const unsigned ldsw = (unsigned)wid * 1024u;
    const int aoff = lds_byte(wr * 64 + fr, fq * 8), boff = lds_byte(wc * 32 + fr, fq * 8);
#define PG8_SA(b, h) (((b) * 2 + (h)) * HTB)
#define PG8_SB(b, h) ((4 + (b) * 2 + (h)) * HTB)
#define PG8_STAGE_R(rs, bufoff, goff, voff) do { _Pragma("unroll") for (int _i = 0; _i < 2; ++_i) \
        __builtin_amdgcn_raw_ptr_buffer_load_lds(rs, (PG8_LAS unsigned*)(lds + (bufoff) + ldsw + _i * 8192), 16, (voff)[_i], (int)(goff), 0, 0); } while (0)
#define PG8_STAGE_A(bufoff, goff, voff) PG8_STAGE_R(rA, bufoff, goff, voff)
#define PG8_STAGE_B(bufoff, goff, voff) PG8_STAGE_R(rB, bufoff, goff, voff)
#define PG8_LDA(dst, b, h) do { _Pragma("unroll") for (int m = 0; m < 4; ++m) _Pragma("unroll") for (int k = 0; k < 2; ++k) dst[m][k] = *(const PG8_LAS bf16x8*)(lds + PG8_SA(b, h) + aoff + m * 2048 + k * 1024); } while (0)
#define PG8_LDB(dst, b, h) do { _Pragma("unroll") for (int n = 0; n < 2; ++n) _Pragma("unroll") for (int k = 0; k < 2; ++k) dst[n][k] = *(const PG8_LAS bf16x8*)(lds + PG8_SB(b, h) + boff + n * 2048 + k * 1024); } while (0)
#define PG8_CAT(x0, x1) __builtin_shufflevector(__builtin_bit_cast(v4i_t, x0), __builtin_bit_cast(v4i_t, x1), 0, 1, 2, 3, 4, 5, 6, 7)
#define PG8_MMA(ai, bj, At, Bt) do { __builtin_amdgcn_s_setprio(1); if constexpr (F8) { _Pragma("unroll") for (int m = 0; m < 4; ++m) _Pragma("unroll") for (int n = 0; n < 2; ++n) \
        acc[ai][bj][m][n] = __builtin_amdgcn_mfma_scale_f32_16x16x128_f8f6f4(PG8_CAT(Bt[n][0], Bt[n][1]), PG8_CAT(At[m][0], At[m][1]), acc[ai][bj][m][n], 0, 0, 0, 0x7f7f7f7f, 0, 0x7f7f7f7f); } \
        else { _Pragma("unroll") for (int m = 0; m < 4; ++m) _Pragma("unroll") for (int n = 0; n < 2; ++n) _Pragma("unroll") for (int k = 0; k < 2; ++k) \
        acc[ai][bj][m][n] = __builtin_amdgcn_mfma_f32_16x16x32_bf16(Bt[n][k], At[m][k], acc[ai][bj][m][n], 0, 0, 0); } __builtin_amdgcn_s_setprio(0); } while (0)
#define PG8_WAIT_V(n) asm volatile("s_waitcnt vmcnt(" #n ")" ::: "memory")
#define PG8_WAIT_L(n) asm volatile("s_waitcnt lgkmcnt(" #n ")" ::: "memory")
#define PG8_BAR __builtin_amdgcn_s_barrier()
#define PG8_SCHED __builtin_amdgcn_sched_barrier(0)
    Unit cur, nxt; int ui = 0;
    if (!S.next(0, cur)) return;
    f32x4 acc[2][2][4][2];
#pragma unroll
    for (int a = 0; a < 2; ++a)
#pragma unroll
        for (int b = 0; b < 2; ++b)
#pragma unroll
            for (int m = 0; m < 4; ++m)
#pragma unroll
                for (int n = 0; n < 2; ++n) acc[a][b][m][n] = (f32x4){0.f, 0.f, 0.f, 0.f};
    bf16x8 At[4][2], B0[2][2], B1[2][2];
    constexpr unsigned astep = HM ? hstep : tstep;
    unsigned cA = (unsigned)cur.pm * astep, cB = (unsigned)cur.pn * tstep;
    S.a_ready(cur);
    if constexpr (SP2) {
        PG8_STAGE_B(PG8_SB(0, 0), cB, voffB); PG8_STAGE_B(PG8_SB(0, 1), cB + hstep, voffB); PG8_STAGE_A(PG8_SA(0, 0), cA, voffA); PG8_STAGE_A(PG8_SA(0, 1), cA + hstep, voffA);
        if (wr == 1) PG8_BAR;
        PG8_WAIT_V(2); PG8_BAR;
        PG8_STAGE_B(PG8_SB(1, 0), cB + kstep, voffB); PG8_STAGE_A(PG8_SA(1, 0), cA + kstep, voffA); PG8_STAGE_B(PG8_SB(1, 1), cB + hstep + kstep, voffB);
        PG8_WAIT_V(6); PG8_BAR;
    } else {
        PG8_STAGE_B(PG8_SB(0, 0), cB, voffB); PG8_STAGE_A(PG8_SA(0, 0), cA, voffA); PG8_STAGE_B(PG8_SB(0, 1), cB + hstep, voffB); PG8_STAGE_A(PG8_SA(0, 1), cA + hstep, voffA);
        if (wr == 1) PG8_BAR;
        PG8_WAIT_V(4); PG8_BAR;
        PG8_STAGE_B(PG8_SB(1, 0), cB + kstep, voffB); PG8_STAGE_A(PG8_SA(1, 0), cA + kstep, voffA); PG8_STAGE_B(PG8_SB(1, 1), cB + hstep + kstep, voffB);
        PG8_WAIT_V(6); PG8_BAR;
    }
    for (;;) {
        const bool has_next = S.next(ui + 1, nxt);
        const unsigned nA = has_next ? (unsigned)nxt.pm * astep : cA, nB = has_next ? (unsigned)nxt.pn * tstep : cB;
        for (int t = 0; t < nt; t += 2) {
            const bool last = (t == nt - 2);
            const unsigned a1 = cA + (unsigned)(t + 1) * kstep;
            const unsigned a2 = last ? nA : cA + (unsigned)(t + 2) * kstep, b2 = last ? nB : cB + (unsigned)(t + 2) * kstep;
            const unsigned a3 = a2 + kstep, b3 = b2 + kstep;
            if (last && has_next) S.a_ready(nxt);
            if constexpr (Epi::MIDK) { if (t == (nt >> 1)) E.mid(acc, cur, wr, wc, fr, fq); }
            if constexpr (SP2) {
            PG8_LDB(B0, 0, 0); PG8_LDB(B1, 0, 1); PG8_SCHED; PG8_LDA(At, 0, 0); PG8_STAGE_A(PG8_SA(1, 1), a1 + hstep, voffA);
            PG8_WAIT_V(8); PG8_WAIT_L(0); PG8_BAR; PG8_MMA(0, 0, At, B0); PG8_MMA(0, 1, At, B1); PG8_BAR; PG8_SCHED;
            if constexpr (!HM) PG8_LDA(At, 0, 1); PG8_STAGE_B(PG8_SB(0, 0), b2, voffB); PG8_STAGE_B(PG8_SB(0, 1), b2 + hstep, voffB); PG8_STAGE_A(PG8_SA(0, 0), a2, voffA);
            PG8_WAIT_V(8); PG8_WAIT_L(0); PG8_BAR; if constexpr (!HM) { PG8_MMA(1, 0, At, B0); PG8_MMA(1, 1, At, B1); } PG8_BAR; PG8_SCHED;
            PG8_LDB(B0, 1, 0); PG8_LDB(B1, 1, 1); PG8_SCHED; PG8_LDA(At, 1, 0); PG8_STAGE_A(PG8_SA(0, 1), a2 + hstep, voffA);
            PG8_WAIT_V(8); PG8_WAIT_L(0); PG8_BAR; PG8_MMA(0, 0, At, B0); PG8_MMA(0, 1, At, B1); PG8_BAR; PG8_SCHED;
            if constexpr (!HM) PG8_LDA(At, 1, 1); PG8_STAGE_B(PG8_SB(1, 0), b3, voffB); PG8_STAGE_B(PG8_SB(1, 1), b3 + hstep, voffB); PG8_STAGE_A(PG8_SA(1, 0), a3, voffA);
            PG8_WAIT_V(8); PG8_WAIT_L(0); PG8_BAR; if constexpr (!HM) { PG8_MMA(1, 0, At, B0); PG8_MMA(1, 1, At, B1); } PG8_BAR; PG8_SCHED;
            } else {
            PG8_LDB(B0, 0, 0); PG8_SCHED; PG8_LDA(At, 0, 0); PG8_STAGE_A(PG8_SA(1, 1), a1 + hstep, voffA);
            PG8_WAIT_L(8); PG8_BAR; PG8_WAIT_L(0); PG8_MMA(0, 0, At, B0); PG8_BAR; PG8_SCHED;
            PG8_LDB(B1, 0, 1); PG8_STAGE_B(PG8_SB(0, 0), b2, voffB);
            PG8_BAR; PG8_WAIT_L(0); PG8_MMA(0, 1, At, B1); PG8_BAR;
            PG8_LDA(At, 0, 1); PG8_STAGE_A(PG8_SA(0, 0), a2, voffA);
            PG8_BAR; PG8_WAIT_L(0); PG8_MMA(1, 0, At, B0); PG8_BAR; PG8_SCHED;
            PG8_STAGE_B(PG8_SB(0, 1), b2 + hstep, voffB);
            PG8_WAIT_V(6); PG8_BAR; PG8_MMA(1, 1, At, B1); PG8_BAR;
            PG8_LDB(B0, 1, 0); PG8_SCHED; PG8_LDA(At, 1, 0); PG8_STAGE_A(PG8_SA(0, 1), a2 + hstep, voffA);
            PG8_WAIT_L(8); PG8_BAR; PG8_WAIT_L(0); PG8_MMA(0, 0, At, B0); PG8_BAR; PG8_SCHED;
            PG8_LDB(B1, 1, 1); PG8_STAGE_B(PG8_SB(1, 0), b3, voffB);
            PG8_BAR; PG8_WAIT_L(0); PG8_MMA(0, 1, At, B1); PG8_BAR;
            PG8_LDA(At, 1, 1); PG8_STAGE_A(PG8_SA(1, 0), a3, voffA);
            PG8_BAR; PG8_WAIT_L(0); PG8_MMA(1, 0, At, B0); PG8_BAR; PG8_SCHED;
            PG8_STAGE_B(PG8_SB(1, 1), b3 + hstep, voffB);
            PG8_WAIT_V(6); PG8_BAR; PG8_MMA(1, 1, At, B1); PG8_BAR;
            }
        }
        if constexpr (ALIGN_EPI) { if (wr == 0) PG8_BAR; }
        E(acc, cur, wr, wc, fr, fq); S.done(cur);
        if (!has_next) break;
#pragma unroll
        for (int a = 0; a < 2; ++a)
#pragma unroll
            for (int b = 0; b < 2; ++b)
#pragma unroll
                for (int m = 0; m < 4; ++m)
#pragma unroll
                    for (int n = 0; n < 2; ++n) acc[a][b][m][n] = (f32x4){0.f, 0.f, 0.f, 0.f};
        cur = nxt; cA = nA; cB = nB; ++ui;
        if constexpr (ALIGN_EPI) { if (wr == 1) PG8_BAR; }
    }
    PG8_WAIT_V(0);
    if constexpr (!ALIGN_EPI) { if (wr == 0) PG8_BAR; }
    PG8_BAR;
#undef PG8_SA
#undef PG8_SB
#undef PG8_STAGE_R
#undef PG8_STAGE_A
#undef PG8_STAGE_B
#undef PG8_LDA
#undef PG8_LDB
#undef PG8_MMA
#undef PG8_CAT
#undef PG8_WAIT_V
#undef PG8_WAIT_L
#undef PG8_BAR
#undef PG8_SCHED
}
}

#ifndef PG8_SP2
#define PG8_SP2 true
#endif
#ifndef PG8_ALIGN
#define PG8_ALIGN true
#endif
#ifndef MK_SPLIT
#define MK_SPLIT 0
#endif

constexpr int NWAVES = 8;
constexpr int D = 4096, MP = 8192, MS = 128, MTOT = MP + MS, MPAD = 8448, NIN = 18944, DA = 2048, DKV = 256, DSG = 2048;
constexpr int NSEQ = 36, NMOD = 3 * D, SEQ = 2048, WIN = 128;
constexpr int PB8 = D + 128, LD8 = PB8 / 2, K8 = D / 2;
constexpr float SA8 = 32.f, SB8 = 8.f, SWP = 128.f, SMG = 16.f, SWO = 256.f, SH8 = 8.f, SWI = 128.f,
                SQ8 = 16.f, SZA8 = 8.f, SUZ8 = 4.f, SVB8 = 8.f, SG8 = 256.f;
constexpr int LDK = D + 64;
constexpr float ALPHA = 1.4142135623730951f;
constexpr float LN_EPS = 1e-5f;
constexpr float LOG2E = 1.4426950408889634f;
constexpr float QSCALE = 0.125f * LOG2E;
constexpr size_t O_YP = 0, O_YS = 33554432, O_WK = 34078720, O_WV = 34340864, O_NK = 34603008, O_NV = 34668544, O_SV = 34734080, O_END = 35258368;

constexpr size_t MiB = 1u << 20;
constexpr size_t WS_CTL = 0, CTL_ZERO_BYTES = 32768;
constexpr size_t WS_MOD = 1 * MiB;
constexpr size_t WS_WSB = 5 * MiB;
constexpr size_t WS_VST = 6 * MiB;
constexpr size_t WS_RST = 9 * MiB;
constexpr size_t WS_KB = 14 * MiB;
constexpr size_t WS_VB = 19 * MiB;
constexpr size_t WS_WIN = 24 * MiB;
constexpr size_t WS_WP = 328 * MiB;
constexpr size_t WS_WO = 394 * MiB;
constexpr size_t WS_HB = 460 * MiB;
constexpr size_t WS_QB = 528 * MiB;
constexpr size_t WS_ZA = 561 * MiB;
constexpr size_t WS_UZ = 594 * MiB;
constexpr size_t WS_VBB = 627 * MiB;
constexpr size_t WS_VBS = 644 * MiB;
constexpr size_t WS_RR = 660 * MiB;
constexpr size_t WS_SGB = 726 * MiB;
constexpr size_t WS_AB = 792 * MiB;
constexpr size_t WS_MG = 860 * MiB;
constexpr size_t WS_RBUF = 928 * MiB;
constexpr size_t WS_RB0 = 928 * MiB;
constexpr size_t WS_RB1 = 992 * MiB;
constexpr size_t WS_RS = 1056 * MiB;
constexpr size_t WS_X1S = 1058 * MiB;
constexpr size_t WS_ST0 = 1060 * MiB;
constexpr size_t WS_HB8 = 1192 * MiB;
constexpr size_t WS_WIN8 = 1228 * MiB;
constexpr size_t WS_END = 1384 * MiB;
static_assert(WS_HB8 + (size_t)MPAD * PB8 <= WS_WIN8 && WS_WIN8 + 2ull * NIN * PB8 <= WS_END, "d_ws map (fp8)");
static_assert(WS_WIN + 2ull * NIN * LDK * 2 <= WS_WP && WS_WP + 2ull * D * LDK * 2 <= WS_WO && WS_WO + 2ull * D * LDK * 2 <= WS_HB && WS_HB + (size_t)MPAD * LDK * 2 <= WS_QB && WS_AB + (size_t)MPAD * LDK * 2 <= WS_MG && WS_MG + (size_t)MPAD * LDK * 2 <= WS_RBUF, "d_ws map");
static_assert((4096 + 3456) * 4 <= (int)CTL_ZERO_BYTES, "barrier words inside the zeroed region");
constexpr int CW_TMO = 0, CW_CODE = 1, CW_WORK0 = 512, CW_WORK1 = 1024, CW_ADA1 = 192, CW_DONE1 = 256, CW_WORK2 = 1536, CW_BAR = 4096;

constexpr int RING_BYTES = 131072;
constexpr int LDSCTL_OFF = 155648, MISC_OFF = LDSCTL_OFF + 320, PTAB_OFF = LDSCTL_OFF + 512;
constexpr int LDS_BYTES = 159744;

#define GAS __attribute__((address_space(1)))
#define LAS __attribute__((address_space(3)))
typedef unsigned short bf16;
typedef unsigned v4u __attribute__((ext_vector_type(4)));
typedef unsigned v2u __attribute__((ext_vector_type(2)));
typedef float f32x4 __attribute__((ext_vector_type(4)));
typedef float f32x2 __attribute__((ext_vector_type(2)));
typedef GAS unsigned gu32;
#define RLX_AGENT __ATOMIC_RELAXED, __HIP_MEMORY_SCOPE_AGENT
#define LDS_WAIT() asm volatile("s_waitcnt lgkmcnt(0)" ::: "memory")
#define VM_WAIT() asm volatile("s_waitcnt vmcnt(0)" ::: "memory")
__device__ __forceinline__ unsigned f2bf(float f) { unsigned u = __builtin_bit_cast(unsigned, f); return (u + 0x7fffu + ((u >> 16) & 1u)) >> 16; }
__device__ __forceinline__ unsigned pk2(float lo, float hi) { return f2bf(lo) | (f2bf(hi) << 16); }
__device__ __forceinline__ float bflo(unsigned u) { return __builtin_bit_cast(float, u << 16); }
__device__ __forceinline__ float bfhi(unsigned u) { return __builtin_bit_cast(float, u & 0xffff0000u); }
__device__ __forceinline__ unsigned pk4_fp8(float a, float b, float c, float d) { int w = 0; w = __builtin_amdgcn_cvt_pk_fp8_f32(a, b, w, false); w = __builtin_amdgcn_cvt_pk_fp8_f32(c, d, w, true); return (unsigned)w; }
__device__ __forceinline__ int lane_now() { int l; asm volatile("v_mbcnt_lo_u32_b32 %0, -1, 0\n\tv_mbcnt_hi_u32_b32 %0, -1, %0" : "=v"(l)); return l; }
template <int K> __device__ __forceinline__ float xadd(float v) {
    if constexpr (K < 32) return v + __builtin_bit_cast(float, __builtin_amdgcn_ds_swizzle(__builtin_bit_cast(int, v), (K << 10) | 0x1f));
    else { const unsigned u = __builtin_bit_cast(unsigned, v); auto rr = __builtin_amdgcn_permlane32_swap(u, u, false, false); return __builtin_bit_cast(float, (unsigned)rr[0]) + __builtin_bit_cast(float, (unsigned)rr[1]); }
}
template <int K> __device__ __forceinline__ float xmax(float v) {
    if constexpr (K < 32) return fmaxf(v, __builtin_bit_cast(float, __builtin_amdgcn_ds_swizzle(__builtin_bit_cast(int, v), (K << 10) | 0x1f)));
    else { const unsigned u = __builtin_bit_cast(unsigned, v); auto rr = __builtin_amdgcn_permlane32_swap(u, u, false, false); return fmaxf(__builtin_bit_cast(float, (unsigned)rr[0]), __builtin_bit_cast(float, (unsigned)rr[1])); }
}
__device__ __forceinline__ float xadd_wave(float v) { v = xadd<1>(v); v = xadd<2>(v); v = xadd<4>(v); v = xadd<8>(v); v = xadd<16>(v); return xadd<32>(v); }
__device__ __forceinline__ float xmax_wave(float v) { v = xmax<1>(v); v = xmax<2>(v); v = xmax<4>(v); v = xmax<8>(v); v = xmax<16>(v); return xmax<32>(v); }
__device__ __forceinline__ float xadd_32(float v) { v = xadd<1>(v); v = xadd<2>(v); v = xadd<4>(v); v = xadd<8>(v); return xadd<16>(v); }
__device__ __forceinline__ f32x4 f8x4(unsigned w) { const f32x2 a = __builtin_amdgcn_cvt_pk_f32_fp8((int)w, false), b = __builtin_amdgcn_cvt_pk_f32_fp8((int)w, true); return (f32x4){a.x, a.y, b.x, b.y}; }
__device__ __forceinline__ float f8x1(unsigned char b) { return __builtin_amdgcn_cvt_f32_fp8((int)b, 0); }
__device__ __forceinline__ float sigmoidf_(float x) { return __builtin_amdgcn_rcpf(1.0f + __builtin_amdgcn_exp2f(-x * LOG2E)); }
__device__ __forceinline__ float siluf_(float x) { return x * sigmoidf_(x); }

#define XB_TMO      128
#define XB_XCNT(j)  (256  + 64 * (j))
#define XB_XSUB(j)  (1280 + 64 * (j))
#define XB_XGEN(j)  (2304 + 64 * (j))
#define XB_TOP      3328
#define XB_TOPGEN   3392
#define XCD_BAR_WORDS 3456
#define XB_SPIN_CAP (1u << 18)
__device__ __forceinline__ unsigned xb_ld(unsigned* p)              { return __hip_atomic_load(p, __ATOMIC_RELAXED, __HIP_MEMORY_SCOPE_AGENT); }
__device__ __forceinline__ unsigned xb_add(unsigned* p, unsigned v) { return __hip_atomic_fetch_add(p, v, __ATOMIC_RELAXED, __HIP_MEMORY_SCOPE_AGENT); }
__device__ __forceinline__ unsigned xb_xcc_id() { return (unsigned)__builtin_amdgcn_s_getreg((3 << 11) | 20) & 0xFu; }
#define XB_SPIN(cond, bar) do { unsigned _sp = 0; while (cond) { __builtin_amdgcn_s_sleep(1); \
    if ((++_sp & 255u) == 0u) { if (xb_ld(&(bar)[XB_TMO])) break; if (_sp > XB_SPIN_CAP) { atomicAdd(&(bar)[XB_TMO], 1u); break; } } } } while (0)
struct XcdBarrier { unsigned* bar; unsigned x; volatile LAS unsigned* st; };
__device__ __forceinline__ XcdBarrier xcd_barrier_post(unsigned* bar, volatile LAS unsigned* st) {
    XcdBarrier b; b.bar = bar; b.x = xb_xcc_id(); b.st = st;
    if (threadIdx.x == 0) (void)xb_add(&bar[XB_XCNT(b.x)], 1u);
    return b;
}
__device__ __forceinline__ void xcd_barrier_complete(unsigned* bar, unsigned x, unsigned& nloc, unsigned& nx) {
    const unsigned G = gridDim.x * gridDim.y * gridDim.z;
    unsigned sum, cnt, mine, sp = 0u;
    for (;;) {
        sum = 0u; cnt = 0u; mine = 0u;
#pragma unroll
        for (unsigned j = 0; j < 16; ++j) { const unsigned c = xb_ld(&bar[XB_XCNT(j)]); sum += c; cnt += (c > 0u) ? 1u : 0u; mine = (j == x) ? c : mine; }
        if (sum == G) break;
        __builtin_amdgcn_s_sleep(1);
        if ((++sp & 255u) == 0u) { if (xb_ld(&bar[XB_TMO])) break; if (sp > XB_SPIN_CAP) { atomicAdd(&bar[XB_TMO], 1u); break; } }
    }
    nloc = mine > 0u ? mine : 1u; nx = cnt > 0u ? cnt : 1u;
}
__device__ __forceinline__ void xcd_barrier(const XcdBarrier& b, const bool leader) {
    asm volatile("s_waitcnt vmcnt(0)" ::: "memory");
    __syncthreads();
    if (leader) {
        unsigned* bar = b.bar; unsigned bx_ = b.x;
        asm volatile("" : "+s"(bar), "+s"(bx_));
        __builtin_amdgcn_s_waitcnt(0);
        unsigned nloc = b.st[0], nx = b.st[1];
        if (nloc == 0u) { xcd_barrier_complete(bar, bx_, nloc, nx); b.st[0] = nloc; b.st[1] = nx; }
        const unsigned old = xb_add(&bar[XB_XSUB(bx_)], 1u);
        const unsigned gen = old / nloc;
        if (old + 1u == (gen + 1u) * nloc) {
            __builtin_amdgcn_fence(__ATOMIC_RELEASE, "agent");
            asm volatile("s_waitcnt vmcnt(0)" ::: "memory");
            const unsigned og = xb_add(&bar[XB_TOP], 1u);
            const unsigned tg = og / nx;
            if (og + 1u == (tg + 1u) * nx) xb_add(&bar[XB_TOPGEN], 1u);
            else XB_SPIN(xb_ld(&bar[XB_TOPGEN]) == tg, bar);
            __builtin_amdgcn_fence(__ATOMIC_ACQUIRE, "agent");
            xb_add(&bar[XB_XGEN(bx_)], 1u);
            asm volatile("s_waitcnt vmcnt(0)" ::: "memory");
        } else {
            XB_SPIN(xb_ld(&bar[XB_XGEN(bx_)]) == gen, bar);
            __builtin_amdgcn_fence(__ATOMIC_ACQUIRE, "agent");
            asm volatile("s_waitcnt vmcnt(0)" ::: "memory");
        }
    }
    __syncthreads();
}

struct Frame {
    LAS unsigned char* lds;
    unsigned char* ws;
    float* out;
    int tid, lane, wave, bx;
    static constexpr int G = 256;
};
enum { I_XP = 0, I_XS, I_CK, I_CV, I_CP, I_CS, I_WADA, I_BADA, I_WIN, I_SINK, I_SG, I_SB, I_SW, I_SBS, I_WPA, I_WPB, I_WO, I_LNG, I_LNB };
__device__ __forceinline__ const float* inp(const Frame& F, int k) {
    volatile LAS unsigned* t = (volatile LAS unsigned*)(F.lds + PTAB_OFF) + 2 * k;
    const unsigned lo = __builtin_amdgcn_readfirstlane(t[0]), hi = __builtin_amdgcn_readfirstlane(t[1]);
    return (const float*)(const GAS float*)(((unsigned long long)hi << 32) | lo);
}
#define WSP(T, off) ((T*)(F.ws + (off)))
__device__ __forceinline__ int row_seq(int row) { return row < MP ? (row >> 11) : 4 + ((row - MP) >> 2); }

__device__ __forceinline__ void ada_item(Frame& F, int item) {
    const int l = item / 96, cb = item % 96;
    LAS float* sc = (LAS float*)(F.lds);
    LAS float* red = (LAS float*)(F.lds + 40960);
    const float* W = inp(F, I_WADA) + (size_t)l * D * NMOD + cb * 128;
    const float* cp = inp(F, I_CP); const float* cs = inp(F, I_CS);
    const int half = F.lane >> 5, c4 = (F.lane & 31) * 4;
    f32x4 acc[18];
#pragma unroll
    for (int s = 0; s < 18; ++s) acc[s] = (f32x4){0.f, 0.f, 0.f, 0.f};
    f32x4 w[8];
    const float* Wl = W + (size_t)(F.wave * 16) * NMOD + c4;
#pragma unroll
    for (int j = 0; j < 8; ++j) w[j] = __builtin_nontemporal_load((const f32x4*)(Wl + (size_t)j * NMOD));
    const int sq0 = F.tid >> 7, kk = F.tid & 127;
    float cv[9];
    cv[0] = cp[sq0 * D + kk];
#pragma unroll
    for (int j = 1; j < 9; ++j) cv[j] = cs[(sq0 + 4 * j - 4) * D + kk];
    for (int ch = 0; ch < 32; ++ch) {
        LAS float* scb = sc + (ch & 1) * 5120;
#pragma unroll
        for (int j = 0; j < 9; ++j) { const int s = sq0 + 4 * j; scb[kk * 40 + (s < 18 ? s : s + 2)] = siluf_(cv[j]); }
        { const int cn = (ch + 1 < 32 ? ch + 1 : ch) * 128 + kk;
          cv[0] = cp[sq0 * D + cn];
#pragma unroll
          for (int j = 1; j < 9; ++j) cv[j] = cs[(sq0 + 4 * j - 4) * D + cn]; }
        __syncthreads();
#pragma unroll
        for (int h2 = 0; h2 < 2; ++h2) {
            const float* Wn = Wl + (size_t)((h2 == 0 ? ch * 128 + 8 : (ch + 1 < 32 ? (ch + 1) * 128 : ch * 128))) * NMOD;
            f32x4 ac[5];
            { const LAS f32x4* a4 = (const LAS f32x4*)(scb + (F.wave * 16 + h2 * 8) * 40 + half * 20);
#pragma unroll
              for (int s4 = 0; s4 < 5; ++s4) ac[s4] = a4[s4]; }
#pragma unroll
            for (int j = 0; j < 8; ++j) {
                f32x4 an[5];
                if (j + 1 < 8) { const LAS f32x4* a4 = (const LAS f32x4*)(scb + (F.wave * 16 + h2 * 8 + j + 1) * 40 + half * 20);
#pragma unroll
                    for (int s4 = 0; s4 < 5; ++s4) an[s4] = a4[s4]; }
                const f32x4 wv = w[j];
#pragma unroll
                for (int s4 = 0; s4 < 5; ++s4) { const f32x4 a = ac[s4];
                    acc[4 * s4 + 0] += a.x * wv; acc[4 * s4 + 1] += a.y * wv;
                    if (s4 < 4) { acc[4 * s4 + 2] += a.z * wv; acc[4 * s4 + 3] += a.w * wv; } }
                w[j] = __builtin_nontemporal_load((const f32x4*)(Wn + (size_t)j * NMOD));
                if (j + 1 < 8) {
#pragma unroll
                    for (int s4 = 0; s4 < 5; ++s4) ac[s4] = an[s4]; }
                __builtin_amdgcn_sched_barrier(0);
            }
        }
    }
    float* mod = WSP(float, WS_MOD); const float* bada = inp(F, I_BADA);
#pragma unroll
    for (int p = 0; p < 2; ++p) {
        __syncthreads();
#pragma unroll
        for (int s9 = 0; s9 < 9; ++s9) *(LAS f32x4*)(red + (F.wave * 18 + half * 9 + s9) * 128 + c4) = acc[p * 9 + s9];
        __syncthreads();
        for (int i = F.tid; i < 18 * 128; i += 512) { const int r = i >> 7, c = i & 127; float v = 0.f;
#pragma unroll
            for (int w8 = 0; w8 < 8; ++w8) v += red[(w8 * 18 + r) * 128 + c];
            const int sq = (r < 9) ? p * 9 + r : 18 + p * 9 + (r - 9), col = cb * 128 + c;
            mod[(size_t)(l * NSEQ + sq) * NMOD + col] = v + bada[l * NMOD + col]; }
    }
    __syncthreads();
}

__device__ __forceinline__ void tr_load(const float* src, int Nsrc, int lane, float (&v)[32]) {
    unsigned off = (unsigned)((lane >> 5) * Nsrc + (lane & 31)) * 4u; const unsigned step = (unsigned)Nsrc * 8u;
#pragma unroll
    for (int i = 0; i < 32; ++i) { v[i] = __builtin_nontemporal_load((const float*)((const char*)src + off)); off += step; }
}
__device__ __forceinline__ void tr_store(void* dst, int f8, float scale, LAS float* scr, int lane, const float (&v)[32]) {
#pragma unroll
    for (int i = 0; i < 32; ++i) scr[(2 * i + (lane >> 5)) * 33 + (lane & 31)] = v[i];
    LDS_WAIT(); asm volatile("" ::: "memory");
    const int c = lane & 7;
#pragma unroll
    for (int j = 0; j < 4; ++j) { const int n = (lane >> 3) + 8 * j; const LAS float* s = scr + (8 * c) * 33 + n;
        if (f8) { v2u o; o.x = pk4_fp8(s[0 * 33] * scale, s[1 * 33] * scale, s[2 * 33] * scale, s[3 * 33] * scale); o.y = pk4_fp8(s[4 * 33] * scale, s[5 * 33] * scale, s[6 * 33] * scale, s[7 * 33] * scale);
            *(GAS v2u*)((unsigned char*)dst + (size_t)n * PB8 + 8 * c) = o; }
        else { v4u o; o.x = pg8::cvt_pk_bf16(s[0 * 33], s[1 * 33]); o.y = pg8::cvt_pk_bf16(s[2 * 33], s[3 * 33]); o.z = pg8::cvt_pk_bf16(s[4 * 33], s[5 * 33]); o.w = pg8::cvt_pk_bf16(s[6 * 33], s[7 * 33]);
            *(GAS v4u*)((bf16*)dst + (size_t)n * LDK + 8 * c) = o; } }
    LDS_WAIT(); asm volatile("" ::: "memory");
}
__host__ __device__ __forceinline__ int win_row(int c) {
    if (c < 4608) return c;
    if (c < 6656) { const int j = (c - 4608) >> 7, i = (c - 4608) & 127; return 4608 + 256 * j + i; }
    if (c < 8704) return 8704 + (c - 6656);
    if (c < 10752) { const int j = (c - 8704) >> 7, i = (c - 8704) & 127; return 4608 + 256 * j + 128 + i; }
    if (c < 14848) { const int j = (c - 10752) >> 7, i = (c - 10752) & 127; return 10752 + 256 * j + i; }
    { const int j = (c - 14848) >> 7, i = (c - 14848) & 127; return 10752 + 256 * j + 128 + i; }
}
constexpr int I_IN = 64 * 592, I_PA = 32 * 128, I_O = 64 * 128, I_LAYER = I_IN + 2 * I_PA + I_O, I_TR = 2 * I_LAYER, I_WS = 128, I_ALL = I_TR + I_WS;
static_assert(I_TR % 8 == 0 && I_WS % 8 == 0 && I_IN % 8 == 0, "chunks of 8 items never straddle the item kinds");
__device__ __forceinline__ void tr_desc(Frame& F, int it, const float*& src, int& Nsrc, void*& dst, void*& dst2, int& f8, float& scale) {
    const int l = it / I_LAYER; int r = it % I_LAYER; f8 = 0; scale = 1.f; dst2 = nullptr;
    if (r < I_IN) { const int kb = r / 592, nb = r % 592, wrow = win_row(32 * nb); Nsrc = NIN; f8 = 1; scale = SWI;
        src = inp(F, I_WIN) + (size_t)l * D * NIN + (size_t)(64 * kb) * NIN + 32 * nb; dst = WSP(unsigned char, WS_WIN8) + (size_t)l * NIN * PB8 + (size_t)wrow * PB8 + 64 * kb;
        if ((wrow >= 2048 && wrow < 2560) || (wrow >= 8704 && wrow < 10752)) { f8 = 2; dst2 = WSP(bf16, WS_WIN) + (size_t)l * NIN * LDK + (size_t)wrow * LDK + 64 * kb; }
        return; }
    r -= I_IN; Nsrc = D; f8 = 1; scale = SWP;
    if (r < I_PA) { const int kb = r / 128, nb = r % 128;
        src = inp(F, I_WPA) + (size_t)l * DA * D + (size_t)(64 * kb) * D + 32 * nb; dst = WSP(unsigned char, WS_WP) + (size_t)l * D * PB8 + (size_t)(32 * nb) * PB8 + 64 * kb; return; }
    r -= I_PA;
    if (r < I_PA) { const int kb = r / 128, nb = r % 128;
        src = inp(F, I_WPB) + (size_t)l * DSG * D + (size_t)(64 * kb) * D + 32 * nb; dst = WSP(unsigned char, WS_WP) + (size_t)l * D * PB8 + (size_t)(32 * nb) * PB8 + 2048 + 64 * kb; return; }
    r -= I_PA; scale = SWO;
    { const int kb = r / 128, nb = r % 128;
        src = inp(F, I_WO) + (size_t)l * D * D + (size_t)(64 * kb) * D + 32 * nb; dst = WSP(unsigned char, WS_WO) + (size_t)l * D * PB8 + (size_t)(32 * nb) * PB8 + 64 * kb; }
}
__device__ __forceinline__ void copy_chunk(Frame& F, int base, LAS float* scr) {
    if (base >= I_TR) {
        const float* sw = inp(F, I_SW); bf16* Wsb = WSP(bf16, WS_WSB);
        for (int it = base; it < base + 8; ++it) { const int e0 = (it - I_TR) * 2048 + F.lane * 4;
#pragma unroll
            for (int j = 0; j < 8; ++j) { const int e = e0 + j * 256; const f32x4 v = *(const f32x4*)(sw + e); const int s = e & 127, t = (e >> 7) & 127;
                v2u o; o.x = pk2(s <= t ? v.x : 0.f, s + 1 <= t ? v.y : 0.f); o.y = pk2(s + 2 <= t ? v.z : 0.f, s + 3 <= t ? v.w : 0.f);
                *(GAS v2u*)(Wsb + e) = o; } }
        return;
    }
    float va[32], vb[32]; const float* src; int ns; void *da, *db, *da2, *db2; int fa, fb; float sa, sb;
    tr_desc(F, base, src, ns, da, da2, fa, sa); tr_load(src, ns, F.lane, va);
#pragma unroll 1
    for (int j = 0; j < 8; j += 2) {
        tr_desc(F, base + j + 1, src, ns, db, db2, fb, sb); tr_load(src, ns, F.lane, vb);
        tr_store(da, fa != 0, sa, scr, F.lane, va); if (fa == 2) tr_store(da2, 0, 1.f, scr, F.lane, va);
        if (j + 2 < 8) { tr_desc(F, base + j + 2, src, ns, da, da2, fa, sa); tr_load(src, ns, F.lane, va); }
        tr_store(db, fb != 0, sb, scr, F.lane, vb); if (fb == 2) tr_store(db2, 0, 1.f, scr, F.lane, vb);
    }
}

__device__ __forceinline__ int pull8(gu32* q, int nchunks, int& s, int& left, int lane) {
    while (left > 0) { int k = 0; if (lane == 0) k = (int)__hip_atomic_fetch_add((unsigned*)(q + 64 * s), 1u, RLX_AGENT);
        const int c = 8 * __builtin_amdgcn_readfirstlane(k) + s; if (c < nchunks) return 8 * c;
        s = (s + 1) & 7; --left; }
    return -1; }
__device__ __forceinline__ void steal_copies(Frame& F, bool until_done, int q, int quota) {
    gu32* ctl = (gu32*)(F.ws + WS_CTL); LAS float* scr = (LAS float*)(F.lds + F.wave * 16384);
    gu32* head = ctl + (q == 1 ? CW_WORK1 : CW_WORK2); const int n = q == 1 ? I_IN : I_LAYER - I_IN, base = q == 1 ? I_LAYER : I_LAYER + I_IN;
    int sh = F.bx & 7, left = 8;
    for (int it = 0; it < quota; ++it) {
        if (until_done) { unsigned d = 0; if (F.lane == 0) d = __hip_atomic_load((unsigned*)(ctl + CW_DONE1), RLX_AGENT); if ((unsigned)__builtin_amdgcn_readfirstlane(d) >= (unsigned)Frame::G) break; }
        const int v = pull8(head, n / 8, sh, left, F.lane); if (v < 0) break;
        copy_chunk(F, base + v, scr);
    }
}

__device__ __forceinline__ void h_rows(Frame& F, const float* x, int row0, int nrows, int seq, int slice, int l) {
    const int col = slice * 1024 + F.lane * 4;
    const float* md = WSP(float, WS_MOD) + (size_t)(l * NSEQ + seq) * NMOD; bf16* Hb = WSP(bf16, WS_HB); unsigned char* Hb8 = WSP(unsigned char, WS_HB8);
    const bool wb = row0 >= MP || (row0 & 2047) >= 1792;
    f32x4 sh[4], sc[4];
#pragma unroll
    for (int j = 0; j < 4; ++j) { sh[j] = *(const f32x4*)(md + col + 256 * j); sc[j] = *(const f32x4*)(md + D + col + 256 * j) + 1.0f; }
    for (int r0 = 0; r0 < nrows; r0 += 4) {
        f32x4 xv[4][4];
#pragma unroll
        for (int rr = 0; rr < 4; ++rr)
#pragma unroll
            for (int j = 0; j < 4; ++j) xv[rr][j] = *(const f32x4*)(x + (size_t)(r0 + rr) * D + col + 256 * j);
#pragma unroll
        for (int rr = 0; rr < 4; ++rr) { const int r = r0 + rr;
#pragma unroll
            for (int j = 0; j < 4; ++j) { const f32x4 v = xv[rr][j] * sc[j] + sh[j];
                *(GAS unsigned*)(Hb8 + (size_t)(row0 + r) * PB8 + col + 256 * j) = pk4_fp8(v.x * SH8, v.y * SH8, v.z * SH8, v.w * SH8);
                if (wb) { v2u o; o.x = pk2(v.x, v.y); o.y = pk2(v.z, v.w); *(GAS v2u*)(Hb + (size_t)(row0 + r) * LDK + col + 256 * j) = o; } } }
    }
}

constexpr int G1_NBF = 18, G1_NF8W = 256 - G1_NBF, G1_UNITS = 33 * 74;
struct OrderF8 { int c;
    __device__ __forceinline__ bool next(int i, pg8::Unit& u) const {
        int L;
        if (i < 8) L = i * 256 + c;
        else { if (c >= G1_NF8W) return false; L = 2048 + (i - 8) * G1_NF8W + c; if (L >= G1_UNITS) return false; }
        pg8::StaticOrderC<MPAD, NIN>::map(L, u); return true; }
    __device__ __forceinline__ void a_ready(const pg8::Unit&) const {}
    __device__ __forceinline__ void done(const pg8::Unit&) const {} };
struct OrderBf { int c;
    __device__ __forceinline__ bool next(int i, pg8::Unit& u) const {
        const int j = c - G1_NF8W; if (i != 0 || j < 0) return false;
        if (j < 8) { u.pm = 8 * (j >> 1) + 7; u.pn = 8 + (j & 1); }
        else { const int jj = j - 8; u.pm = 32; u.pn = jj < 2 ? 8 + jj : 34 + (jj - 2); }
        return true; }
    __device__ __forceinline__ void a_ready(const pg8::Unit&) const {}
    __device__ __forceinline__ void done(const pg8::Unit&) const {} };

__host__ __device__ __forceinline__ bool is_bf16_unit(int pm, int pn) { return ((pn == 8 || pn == 9) && ((pm & 7) == 7 || pm == 32)) || (pm == 32 && pn >= 34 && pn < 42); }
template <bool F8> struct EpiInT {
    static constexpr bool PERM = true, MIDK = false;
    unsigned char* ws; float* outl;
    int l;
    __device__ __forceinline__ void mid(pg8::f32x4 (&)[2][2][4][2], const pg8::Unit&, int, int, int, int) const {}
    __device__ __forceinline__ void operator()(const pg8::f32x4 (&acc)[2][2][4][2], const pg8::Unit& u, int wr, int wc, int fr_, int fq_) const {
        if (F8 && is_bf16_unit(u.pm, u.pn)) return;
        constexpr float DS = F8 ? 1.0f / (SH8 * SWI) : 1.0f;
        const int ln_ = lane_now(), fr = ln_ & 15, fq = ln_ >> 4; (void)fr_; (void)fq_;
        const int row0 = u.pm * 256 + wr * 64 + fr, c8 = wc * 32 + 8 * fq, pn = u.pn;
        if (pn < 8 || (pn >= 10 && pn < 18) || (pn >= 34 && pn < 42)) {
            const int kind = pn < 8 ? 0 : (pn < 18 ? 1 : 2);
            unsigned char* base = kind == 0 ? (ws + WS_QB) + pn * 256 : (kind == 1 ? (ws + WS_ZA) + (pn - 10) * 256 : (ws + WS_VBB) + (pn - 34) * 256);
            const float osc = kind == 0 ? QSCALE * SQ8 : (kind == 1 ? SZA8 : SVB8);
            f32x2* vst = (f32x2*)(ws + WS_VST);
#pragma unroll
            for (int ai = 0; ai < 2; ++ai)
#pragma unroll
                for (int m = 0; m < 4; ++m) { const int row = row0 + ai * 128 + m * 16; unsigned char* rowp = base + (size_t)row * 2048 + c8; float s1 = 0.f, s2 = 0.f;
#pragma unroll
                    for (int bj = 0; bj < 2; ++bj) { f32x4 v0 = acc[ai][bj][m][0] * DS, v1 = acc[ai][bj][m][1] * DS;
                        if (kind == 1) { v0 = (f32x4){siluf_(v0.x), siluf_(v0.y), siluf_(v0.z), siluf_(v0.w)}; v1 = (f32x4){siluf_(v1.x), siluf_(v1.y), siluf_(v1.z), siluf_(v1.w)}; }
                        if (kind == 2) { s1 += (v0.x + v0.y) + (v0.z + v0.w) + (v1.x + v1.y) + (v1.z + v1.w);
                                         s2 += (v0.x * v0.x + v0.y * v0.y) + (v0.z * v0.z + v0.w * v0.w) + (v1.x * v1.x + v1.y * v1.y) + (v1.z * v1.z + v1.w * v1.w); }
                        if (!F8 && kind == 2) {
                            v4u w; w.x = pg8::cvt_pk_bf16(v0.x, v0.y); w.y = pg8::cvt_pk_bf16(v0.z, v0.w); w.z = pg8::cvt_pk_bf16(v1.x, v1.y); w.w = pg8::cvt_pk_bf16(v1.z, v1.w);
                            *(v4u*)((bf16*)(ws + WS_VBS) + (size_t)(row - MP) * 2048 + (pn - 34) * 256 + c8 + bj * 128) = w;
                        } else {
                            v0 = v0 * osc; v1 = v1 * osc;
                            v2u w; w.x = pk4_fp8(v0.x, v0.y, v0.z, v0.w); w.y = pk4_fp8(v1.x, v1.y, v1.z, v1.w);
                            *(v2u*)(rowp + bj * 128) = w; } }
                    if (kind == 2) { s1 = xadd<32>(xadd<16>(s1)); s2 = xadd<32>(xadd<16>(s2));
                        if (fq == 0) vst[(size_t)row * 32 + (pn - 34) * 4 + wc] = (f32x2){s1, s2}; }
                }
        } else if (pn < 10) {
            bf16* base = (bf16*)(ws + (pn == 8 ? WS_KB : WS_VB));
            float* ow = outl + (pn == 8 ? O_WK : O_WV) + (size_t)l * 131072; float* on = outl + (pn == 8 ? O_NK : O_NV) + (size_t)l * 32768;
#pragma unroll
            for (int ai = 0; ai < 2; ++ai)
#pragma unroll
                for (int m = 0; m < 4; ++m) { const int row = row0 + ai * 128 + m * 16; bf16* rowp = base + (size_t)row * 256 + c8;
                    const int rin = wr * 64 + m * 16 + fr;
                    float* fo = nullptr;
                    if (!F8) { if (u.pm < 32) { if ((u.pm & 7) == 7 && ai == 1) fo = ow + ((size_t)(u.pm >> 3) * 128 + rin) * 256; } else if (ai == 0) fo = on + (size_t)rin * 256; }
#pragma unroll
                    for (int bj = 0; bj < 2; ++bj) { const f32x4 v0 = acc[ai][bj][m][0] * DS, v1 = acc[ai][bj][m][1] * DS;
                        v4u w; w.x = pg8::cvt_pk_bf16(v0.x, v0.y); w.y = pg8::cvt_pk_bf16(v0.z, v0.w); w.z = pg8::cvt_pk_bf16(v1.x, v1.y); w.w = pg8::cvt_pk_bf16(v1.z, v1.w);
                        *(v4u*)(rowp + bj * 128) = w;
                        if (fo) { *(f32x4*)(fo + bj * 128 + c8) = v0; *(f32x4*)(fo + bj * 128 + c8 + 4) = v1; } }
                }
        } else if (pn < 34) {
            unsigned char* base = (ws + WS_UZ) + (pn - 18) * 128;
#pragma unroll
            for (int ai = 0; ai < 2; ++ai)
#pragma unroll
                for (int m = 0; m < 4; ++m) { const int row = row0 + ai * 128 + m * 16;
                    const f32x4 u0 = acc[ai][0][m][0] * DS, u1 = acc[ai][0][m][1] * DS, z0 = acc[ai][1][m][0] * DS, z1 = acc[ai][1][m][1] * DS;
                    v2u w; w.x = pk4_fp8(u0.x * siluf_(z0.x) * SUZ8, u0.y * siluf_(z0.y) * SUZ8, u0.z * siluf_(z0.z) * SUZ8, u0.w * siluf_(z0.w) * SUZ8);
                    w.y = pk4_fp8(u1.x * siluf_(z1.x) * SUZ8, u1.y * siluf_(z1.y) * SUZ8, u1.z * siluf_(z1.z) * SUZ8, u1.w * siluf_(z1.w) * SUZ8);
                    *(v2u*)(base + (size_t)row * 2048 + c8) = w; }
        } else {
            const int cb = (pn - 42) * 128 + c8; bf16* RR = (bf16*)(ws + WS_RR); unsigned char* SGB = ws + WS_SGB;
#pragma unroll
            for (int ai = 0; ai < 2; ++ai)
#pragma unroll
                for (int m = 0; m < 4; ++m) { const int row = row0 + ai * 128 + m * 16;
                    float ra[8], sb[8];
#pragma unroll
                    for (int n = 0; n < 2; ++n)
#pragma unroll
                        for (int e = 0; e < 4; ++e) {
                            const float xa = __builtin_amdgcn_fmed3f(acc[ai][0][m][n][e] * (-DS * LOG2E), -60.0f, 60.0f), xb = __builtin_amdgcn_fmed3f(acc[ai][1][m][n][e] * (-DS * LOG2E), -60.0f, 60.0f);
                            const float pa = 1.0f + __builtin_amdgcn_exp2f(xa), pb = 1.0f + __builtin_amdgcn_exp2f(xb), r = __builtin_amdgcn_rcpf(pa * pb);
                            sb[n * 4 + e] = fmaxf(r * pa, 1.52587890625e-05f);
                            ra[n * 4 + e] = fminf(pb, 65536.0f) * (r * pb); }
                    v4u w; w.x = pg8::cvt_pk_bf16(ra[0], ra[1]); w.y = pg8::cvt_pk_bf16(ra[2], ra[3]); w.z = pg8::cvt_pk_bf16(ra[4], ra[5]); w.w = pg8::cvt_pk_bf16(ra[6], ra[7]);
                    *(v4u*)(RR + (size_t)row * D + cb) = w;
                    v2u x; x.x = pk4_fp8(sb[0] * SG8, sb[1] * SG8, sb[2] * SG8, sb[3] * SG8); x.y = pk4_fp8(sb[4] * SG8, sb[5] * SG8, sb[6] * SG8, sb[7] * SG8);
                    *(v2u*)(SGB + (size_t)row * D + cb) = x; }
        }
    }
};

struct EpiMerge {
    static constexpr bool PERM = true, MIDK = true;
    const bf16* RR; const unsigned char* SGB; unsigned char* MG;
    __device__ __forceinline__ void mid(pg8::f32x4 (&acc)[2][2][4][2], const pg8::Unit& u, int wr, int wc, int, int) const {
        const int ln_ = lane_now(), fr = ln_ & 15, fq = ln_ >> 4;
        unsigned off0 = ((unsigned)(u.pm * 256 + wr * 64 + fr) * D + (unsigned)(u.pn * 256 + wc * 32 + 8 * fq)) * 2u;
        asm volatile("" : "+v"(off0));
        v4u w[2][4][2];
#pragma unroll
        for (int ai = 0; ai < 2; ++ai)
#pragma unroll
            for (int m = 0; m < 4; ++m)
#pragma unroll
                for (int bj = 0; bj < 2; ++bj) w[ai][m][bj] = *(const v4u*)((const char*)RR + off0 + (unsigned)((ai * 128 + m * 16) * D * 2) + bj * 256);
#pragma unroll
        for (int ai = 0; ai < 2; ++ai) {
#pragma unroll
            for (int m = 0; m < 4; ++m)
#pragma unroll
                for (int bj = 0; bj < 2; ++bj) { const v4u x = w[ai][m][bj];
                    acc[ai][bj][m][0] = acc[ai][bj][m][0] * ((f32x4){bflo(x.x), bfhi(x.x), bflo(x.y), bfhi(x.y)} * (SB8 / SA8));
                    acc[ai][bj][m][1] = acc[ai][bj][m][1] * ((f32x4){bflo(x.z), bfhi(x.z), bflo(x.w), bfhi(x.w)} * (SB8 / SA8)); }
            asm volatile("" ::: "memory");
        }
    }
    __device__ __forceinline__ void operator()(const pg8::f32x4 (&acc)[2][2][4][2], const pg8::Unit& u, int wr, int wc, int, int) const {
        const int ln_ = lane_now(), fr = ln_ & 15, fq = ln_ >> 4;
        unsigned off0 = (unsigned)(u.pm * 256 + wr * 64 + fr) * D + (unsigned)(u.pn * 256 + wc * 32 + 8 * fq);
        asm volatile("" : "+v"(off0));
        const unsigned offm = (unsigned)(u.pm * 256 + wr * 64 + fr) * (unsigned)PB8 + (unsigned)(u.pn * 256 + wc * 32 + 8 * fq);
        v2u sv[2][4][2];
#pragma unroll
        for (int ai = 0; ai < 2; ++ai)
#pragma unroll
            for (int m = 0; m < 4; ++m)
#pragma unroll
                for (int bj = 0; bj < 2; ++bj) sv[ai][m][bj] = *(const v2u*)(SGB + off0 + (unsigned)((ai * 128 + m * 16) * D) + bj * 128);
#pragma unroll
        for (int ai = 0; ai < 2; ++ai) {
#pragma unroll
            for (int m = 0; m < 4; ++m)
#pragma unroll
                for (int bj = 0; bj < 2; ++bj) { const v2u s = sv[ai][m][bj];
                    const f32x4 v0 = acc[ai][bj][m][0] * (f8x4(s.x) * (SMG / (SB8 * SWP * SG8)));
                    const f32x4 v1 = acc[ai][bj][m][1] * (f8x4(s.y) * (SMG / (SB8 * SWP * SG8)));
                    v2u w; w.x = pk4_fp8(v0.x, v0.y, v0.z, v0.w); w.y = pk4_fp8(v1.x, v1.y, v1.z, v1.w);
                    *(v2u*)(MG + offm + (unsigned)((ai * 128 + m * 16) * PB8) + bj * 128) = w; }
            asm volatile("" ::: "memory");
        }
    }
};

template <int L> struct EpiOutT {
    static constexpr bool PERM = false, MIDK = false;
    const float* xp; const bf16* rb0; const f32x2* st0; const float *g0, *b0;
    const float* gate;
    bf16* rb; f32x2* rst;
    __device__ __forceinline__ void mid(pg8::f32x4 (&)[2][2][4][2], const pg8::Unit&, int, int, int, int) const {}
    __device__ __forceinline__ void operator()(const pg8::f32x4 (&acc)[2][2][4][2], const pg8::Unit& u, int wr, int wc, int fr_, int fq_) const {
        const int ln_ = lane_now(), fr = ln_ & 15, fq = ln_ >> 4; (void)fr_; (void)fq_;
        const unsigned col0 = (unsigned)(u.pn * 256 + wc * 32 + 4 * fq);
        const unsigned rowb = (unsigned)(u.pm * 256 + wr * 64 + fr);
        const unsigned eo0 = rowb * D + col0;
        const char* gb = (const char*)(gate + (size_t)(u.pm >> 3) * NMOD) + col0 * 4u;
        f32x4 gv[2][2], g0v[2][2], b0v[2][2];
#pragma unroll
        for (int bj = 0; bj < 2; ++bj)
#pragma unroll
            for (int n = 0; n < 2; ++n) { gv[bj][n] = *(const f32x4*)(gb + (bj * 128 + n * 16) * 4);
                if (L == 1) { g0v[bj][n] = *(const f32x4*)((const char*)g0 + (col0 + bj * 128 + n * 16) * 4u); b0v[bj][n] = *(const f32x4*)((const char*)b0 + (col0 + bj * 128 + n * 16) * 4u); } }
#pragma unroll
        for (int ap = 0; ap < 4; ++ap) { const int ai = ap >> 1, m0 = (ap & 1) * 2;
            f32x4 xv[2][2][2]; v2u xb[2][2][2]; f32x2 st[2];
#pragma unroll
            for (int mm = 0; mm < 2; ++mm) { const unsigned eo = eo0 + (unsigned)((ai * 128 + (m0 + mm) * 16) * D);
                if (L == 1) st[mm] = st0[rowb + (unsigned)(ai * 128 + (m0 + mm) * 16)];
#pragma unroll
                for (int bj = 0; bj < 2; ++bj)
#pragma unroll
                    for (int n = 0; n < 2; ++n) {
                        if (L == 0) xv[mm][bj][n] = *(const f32x4*)((const char*)xp + (eo + bj * 128 + n * 16) * 4u);
                        else xb[mm][bj][n] = *(const v2u*)((const char*)rb0 + (eo + bj * 128 + n * 16) * 2u); } }
#pragma unroll
            for (int mm = 0; mm < 2; ++mm) { const int m = m0 + mm; const unsigned eo = eo0 + (unsigned)((ai * 128 + m * 16) * D); const unsigned row = rowb + (unsigned)(ai * 128 + m * 16);
                float s1 = 0.f, s2 = 0.f;
#pragma unroll
                for (int bj = 0; bj < 2; ++bj)
#pragma unroll
                    for (int n = 0; n < 2; ++n) { f32x4 x;
                        if (L == 0) x = xv[mm][bj][n];
                        else { const v2u w = xb[mm][bj][n]; x = ((f32x4){bflo(w.x), bfhi(w.x), bflo(w.y), bfhi(w.y)} - st[mm].x) * st[mm].y * g0v[bj][n] + b0v[bj][n]; }
                        const f32x4 r = x * ALPHA + gv[bj][n] * (acc[ai][bj][m][n] * (1.0f / (SMG * SWO)));
                        v2u o; o.x = pg8::cvt_pk_bf16(r.x, r.y); o.y = pg8::cvt_pk_bf16(r.z, r.w);
                        *(v2u*)((char*)rb + (eo + bj * 128 + n * 16) * 2u) = o;
                        s1 += (r.x + r.y) + (r.z + r.w); s2 += (r.x * r.x + r.y * r.y) + (r.z * r.z + r.w * r.w); }
                s1 = xadd<32>(xadd<16>(s1)); s2 = xadd<32>(xadd<16>(s2));
                if (fq == 0) rst[(size_t)row * 64 + u.pn * 4 + wc] = (f32x2){s1, s2};
            }
            asm volatile("" ::: "memory");
        }
    }
};

typedef short bf16x8_t __attribute__((ext_vector_type(8)));
typedef short s16x4_t __attribute__((ext_vector_type(4)));
typedef float f32x16 __attribute__((ext_vector_type(16)));
__device__ __forceinline__ s16x4_t vtr(const LAS char* p) { return __builtin_bit_cast(s16x4_t, __builtin_amdgcn_ds_read_tr16_b64_v4i16((LAS s16x4_t*)p)); }
__device__ __forceinline__ bf16x8_t cat8(s16x4_t a, s16x4_t b) { return (bf16x8_t){a[0], a[1], a[2], a[3], b[0], b[1], b[2], b[3]}; }
#define MFMA32(a, b, c) __builtin_amdgcn_mfma_f32_32x32x16_bf16((a), (b), (c), 0, 0, 0)

__device__ __forceinline__ void attn_prompt_unit(Frame& F, int l, int unit) {
    const int kv = unit & 3, n = (unit >> 2) & 15, b = unit >> 6, tid = F.tid, lane = F.lane;
    LAS char* Kl = (LAS char*)F.lds; LAS char* Vl = Kl + 32768;
    const bf16* Kb = WSP(bf16, WS_KB); const bf16* Vb = WSP(bf16, WS_VB); const unsigned char* Qb = WSP(unsigned char, WS_QB); const unsigned char* Za = WSP(unsigned char, WS_ZA); unsigned char* AB = WSP(unsigned char, WS_AB);
    const int rowq0 = b * SEQ + n * 128, rowk0 = rowq0 - 128;
#pragma unroll
    for (int i = 0; i < 4; ++i) { const int idx = tid + 512 * i;
        { const int chunk = idx >> 8, key = idx & 255; v4u v = (v4u){0u, 0u, 0u, 0u};
          if (n > 0 || key >= 128) v = *(const v4u*)(Kb + (size_t)(rowk0 + key) * 256 + kv * 64 + chunk * 8);
          *(LAS v4u*)(Kl + chunk * 4096 + key * 16) = v; }
        { const int dh = idx >> 10, key = (idx >> 2) & 255, c4 = idx & 3; v4u v = (v4u){0u, 0u, 0u, 0u};
          if (n > 0 || key >= 128) v = *(const v4u*)(Vb + (size_t)(rowk0 + key) * 256 + kv * 64 + dh * 32 + c4 * 8);
          *(LAS v4u*)(Vl + dh * 16384 + key * 64 + c4 * 16) = v; } }
    const int h = lane >> 5, r32 = lane & 31, head = kv * 8 + F.wave;
    v2u qn[4];
#pragma unroll
    for (int ks = 0; ks < 4; ++ks) qn[ks] = *(const v2u*)(Qb + (size_t)(rowq0 + r32) * 2048 + head * 64 + 16 * ks + 8 * h);
    __syncthreads();
    const float sink2 = inp(F, I_SINK)[l * 32 + head] * LOG2E;
    const LAS char* kbase = Kl + h * 4096 + r32 * 16;
    const LAS char* vbase = Vl + (4 * h + ((lane & 15) >> 2)) * 64 + ((lane >> 4) & 1) * 32 + (lane & 3) * 8;
#pragma unroll 1
    for (int c = 0; c < 4; ++c) {
        const size_t qrow = (size_t)(rowq0 + 32 * c + r32);
        bf16x8_t qf[4];
#pragma unroll
        for (int ks = 0; ks < 4; ++ks) { const f32x4 a = f8x4(qn[ks].x) * (1.0f / SQ8), b2 = f8x4(qn[ks].y) * (1.0f / SQ8);
            v4u w; w.x = pg8::cvt_pk_bf16(a.x, a.y); w.y = pg8::cvt_pk_bf16(a.z, a.w); w.z = pg8::cvt_pk_bf16(b2.x, b2.y); w.w = pg8::cvt_pk_bf16(b2.z, b2.w);
            qf[ks] = __builtin_bit_cast(bf16x8_t, w); }
        { const size_t qnext = qrow + (c + 1 < 4 ? 32 : 0);
#pragma unroll
            for (int ks = 0; ks < 4; ++ks) qn[ks] = *(const v2u*)(Qb + qnext * 2048 + head * 64 + 16 * ks + 8 * h); }
        unsigned zv[2][4];
#pragma unroll
        for (int dt = 0; dt < 2; ++dt)
#pragma unroll
            for (int g4 = 0; g4 < 4; ++g4) zv[dt][g4] = *(const unsigned*)(Za + qrow * 2048 + head * 64 + 32 * dt + 8 * g4 + 4 * h);
        f32x16 S[5];
#pragma unroll
        for (int k5 = 0; k5 < 5; ++k5)
#pragma unroll
            for (int r = 0; r < 16; ++r) S[k5][r] = 0.f;
        {
          bf16x8_t kf[2][5];
#pragma unroll
          for (int k5 = 0; k5 < 5; ++k5) kf[0][k5] = *(const LAS bf16x8_t*)(kbase + (32 * (c + k5)) * 16);
#pragma unroll
          for (int ks = 0; ks < 4; ++ks) {
              if (ks + 1 < 4) {
#pragma unroll
                  for (int k5 = 0; k5 < 5; ++k5) kf[(ks + 1) & 1][k5] = *(const LAS bf16x8_t*)(kbase + (2 * (ks + 1)) * 4096 + (32 * (c + k5)) * 16); }
              __builtin_amdgcn_sched_barrier(0);
#pragma unroll
              for (int k5 = 0; k5 < 5; ++k5) S[k5] = MFMA32(kf[ks & 1][k5], qf[ks], S[k5]);
              __builtin_amdgcn_sched_barrier(0);
          } }
        float mx = sink2;
#pragma unroll
        for (int k5 = 0; k5 < 5; ++k5) { const bool dead = (n == 0) && (c + k5 < 4);
#pragma unroll
            for (int r = 0; r < 16; ++r) { const int kk = (r & 3) + 8 * (r >> 2) + 4 * h; float v = S[k5][r];
                if (k5 == 0) v = (kk > r32) ? v : -INFINITY;
                if (k5 == 4) v = (kk <= r32) ? v : -INFINITY;
                if (dead) v = -INFINITY;
                S[k5][r] = v; mx = fmaxf(mx, v); } }
        mx = xmax<32>(mx);
        float ls = 0.f;
#pragma unroll
        for (int k5 = 0; k5 < 5; ++k5)
#pragma unroll
            for (int r = 0; r < 16; ++r) { const float p = __builtin_amdgcn_exp2f(S[k5][r] - mx); S[k5][r] = p; ls += p; }
        ls = xadd<32>(ls); ls += __builtin_amdgcn_exp2f(sink2 - mx);
        f32x16 O[2];
#pragma unroll
        for (int r = 0; r < 16; ++r) { O[0][r] = 0.f; O[1][r] = 0.f; }
        {
          s16x4_t vq[2][2][2];
          const LAS char* vp0 = vbase + (32 * c) * 64;
#pragma unroll
          for (int dt = 0; dt < 2; ++dt) { vq[0][dt][0] = vtr(vp0 + dt * 16384); vq[0][dt][1] = vtr(vp0 + dt * 16384 + 512); }
#pragma unroll
          for (int j = 0; j < 10; ++j) { const int k5 = j >> 1, s = j & 1;
              if (j + 1 < 10) { const LAS char* vp = vp0 + (16 * (j + 1)) * 64;
#pragma unroll
                  for (int dt = 0; dt < 2; ++dt) { vq[(j + 1) & 1][dt][0] = vtr(vp + dt * 16384); vq[(j + 1) & 1][dt][1] = vtr(vp + dt * 16384 + 512); } }
              v4u pw; pw.x = pg8::cvt_pk_bf16(S[k5][8 * s + 0], S[k5][8 * s + 1]); pw.y = pg8::cvt_pk_bf16(S[k5][8 * s + 2], S[k5][8 * s + 3]);
              pw.z = pg8::cvt_pk_bf16(S[k5][8 * s + 4], S[k5][8 * s + 5]); pw.w = pg8::cvt_pk_bf16(S[k5][8 * s + 6], S[k5][8 * s + 7]);
              const bf16x8_t pf = __builtin_bit_cast(bf16x8_t, pw);
              __builtin_amdgcn_sched_barrier(0);
#pragma unroll
              for (int dt = 0; dt < 2; ++dt) O[dt] = MFMA32(cat8(vq[j & 1][dt][0], vq[j & 1][dt][1]), pf, O[dt]);
              __builtin_amdgcn_sched_barrier(0);
          } }
        const float inv = SA8 / (SZA8 * ls);
#pragma unroll
        for (int dt = 0; dt < 2; ++dt)
#pragma unroll
            for (int g4 = 0; g4 < 4; ++g4) { const int d0 = head * 64 + 32 * dt + 8 * g4 + 4 * h;
                const f32x4 z = f8x4(zv[dt][g4]);
                *(unsigned*)(AB + qrow * PB8 + d0) = pk4_fp8(O[dt][4 * g4 + 0] * inv * z.x, O[dt][4 * g4 + 1] * inv * z.y, O[dt][4 * g4 + 2] * inv * z.z, O[dt][4 * g4 + 3] * inv * z.w); }
    }
    __syncthreads();
}
__device__ __forceinline__ void attn_sample_unit(Frame& F, int l, int unit) {
    const int kv = unit & 3, b = unit >> 2, h = kv * 8 + F.wave, lane = F.lane, tid = F.tid;
    LAS float* Kf = (LAS float*)F.lds;
    LAS float* Vf = Kf + 8704;
    LAS float* qs = Kf + 17408 + F.wave * 1024;
    LAS float* ps = qs + 256;
    const unsigned char* Qb = WSP(unsigned char, WS_QB); const unsigned char* Za = WSP(unsigned char, WS_ZA); unsigned char* AB = WSP(unsigned char, WS_AB);
    const int row0 = MP + b * 4;
    const float* ck = inp(F, I_CK) + ((size_t)(l * 32 + b) * 128) * 256 + kv * 64;
    const float* cv = inp(F, I_CV) + ((size_t)(l * 32 + b) * 128) * 256 + kv * 64;
    const float* nk = F.out + O_NK + (size_t)(l * 128 + b * 4) * 256 + kv * 64;
    const float* nv = F.out + O_NV + (size_t)(l * 128 + b * 4) * 256 + kv * 64;
    unsigned char zq[4];
#pragma unroll
    for (int t = 0; t < 4; ++t) zq[t] = Za[(size_t)(row0 + t) * 2048 + h * 64 + lane];
    { f32x4 kx[5], vx[5]; unsigned char qv[4];
#pragma unroll
      for (int j = 0; j < 5; ++j) { const int i = tid + 512 * j, ic = i < 132 * 16 ? i : 132 * 16 - 1, key = ic >> 4, d4 = (ic & 15) * 4;
        kx[j] = *(const f32x4*)((key < 128 ? ck + (size_t)key * 256 : nk + (size_t)(key - 128) * 256) + d4);
        vx[j] = *(const f32x4*)((key < 128 ? cv + (size_t)key * 256 : nv + (size_t)(key - 128) * 256) + d4); }
#pragma unroll
      for (int t = 0; t < 4; ++t) qv[t] = Qb[(size_t)(row0 + t) * 2048 + h * 64 + lane];
#pragma unroll
      for (int j = 0; j < 5; ++j) { const int i = tid + 512 * j, key = i >> 4, d4 = (i & 15) * 4;
        if (i < 132 * 16) { LAS float* kd = Kf + key * 65 + d4; kd[0] = kx[j].x; kd[1] = kx[j].y; kd[2] = kx[j].z; kd[3] = kx[j].w;
            *(LAS f32x4*)(Vf + key * 64 + d4) = vx[j]; } }
#pragma unroll
      for (int t = 0; t < 4; ++t) qs[t * 64 + lane] = f8x1(qv[t]) * (1.0f / SQ8); }
    __syncthreads();
    const float sink2 = inp(F, I_SINK)[l * 32 + h] * LOG2E;
    float sc[3][4];
#pragma unroll
    for (int ps_ = 0; ps_ < 3; ++ps_) {
        const int key = ps_ * 64 + lane; const bool inr = key < 132; const LAS float* kr = Kf + (inr ? key : 0) * 65;
        float s[4] = {0.f, 0.f, 0.f, 0.f};
#pragma unroll 4
        for (int d4 = 0; d4 < 16; ++d4) { const float k0 = kr[d4 * 4], k1 = kr[d4 * 4 + 1], k2 = kr[d4 * 4 + 2], k3 = kr[d4 * 4 + 3];
#pragma unroll
            for (int t = 0; t < 4; ++t) { const f32x4 qx = *(const LAS f32x4*)(qs + t * 64 + d4 * 4); s[t] += (qx.x * k0 + qx.y * k1) + (qx.z * k2 + qx.w * k3); } }
#pragma unroll
        for (int t = 0; t < 4; ++t) { const bool ok = inr && (key < 128 ? key > t : (key - 128) <= t); sc[ps_][t] = ok ? s[t] : -INFINITY; }
    }
#pragma unroll
    for (int t = 0; t < 4; ++t) {
        float mx = fmaxf(fmaxf(sc[0][t], sc[1][t]), fmaxf(sc[2][t], sink2));
        mx = xmax_wave(mx);
        float p0 = __builtin_amdgcn_exp2f(sc[0][t] - mx), p1 = __builtin_amdgcn_exp2f(sc[1][t] - mx), p2 = __builtin_amdgcn_exp2f(sc[2][t] - mx);
        float sum = p0 + p1 + p2;
        sum = xadd_wave(sum);
        const float inv = 1.0f / (sum + __builtin_amdgcn_exp2f(sink2 - mx));
        ps[t * 136 + lane] = p0 * inv; ps[t * 136 + 64 + lane] = p1 * inv; if (lane < 8) ps[t * 136 + 128 + lane] = p2 * inv;
    }
    LDS_WAIT(); asm volatile("" ::: "memory");
    float o[4] = {0.f, 0.f, 0.f, 0.f};
#pragma unroll 4
    for (int key = 0; key < 132; ++key) { const float v = Vf[key * 64 + lane];
#pragma unroll
        for (int t = 0; t < 4; ++t) o[t] += ps[t * 136 + key] * v; }
#pragma unroll
    for (int t = 0; t < 4; ++t) { const size_t row = (size_t)(row0 + t); const float z = f8x1(zq[t]) * (1.0f / SZA8);
        AB[row * PB8 + h * 64 + lane] = (unsigned char)(pk4_fp8(o[t] * z * SA8, 0.f, 0.f, 0.f) & 0xffu); }
    __syncthreads();
}
__device__ __forceinline__ void sgu_prompt_unit(Frame& F, int l, int unit, int par) {
    const int g = unit & 7, n = (unit >> 3) & 15, b = unit >> 7, tid = F.tid, lane = F.lane, w = F.wave;
    LAS f32x2* rs = (LAS f32x2*)(F.lds + 65536) + par * 128;
    LAS char* Lw = (LAS char*)F.lds + w * 8192;
    const f32x2* vst = WSP(f32x2, WS_VST); const unsigned char* Vbb = WSP(unsigned char, WS_VBB); const unsigned char* UZ = WSP(unsigned char, WS_UZ); unsigned char* AB = WSP(unsigned char, WS_AB); const bf16* Wsb = WSP(bf16, WS_WSB);
    const int row0 = b * SEQ + n * 128, colw = g * 256 + 32 * w, h = lane >> 5, r32 = lane & 31, ch = lane & 3;
    f32x2 pst[8];
    { const int row = tid >> 2, part = tid & 3;
#pragma unroll
      for (int k = 0; k < 8; ++k) pst[k] = vst[(size_t)(row0 + row) * 32 + part * 8 + k]; }
    v2u xv[8];
#pragma unroll
    for (int i = 0; i < 8; ++i) xv[i] = *(const v2u*)(Vbb + (size_t)(row0 + (lane >> 2) + 16 * i) * 2048 + colw + ch * 8);
    unsigned uzv[4][4];
#pragma unroll
    for (int tb = 0; tb < 4; ++tb)
#pragma unroll
        for (int g4 = 0; g4 < 4; ++g4) uzv[tb][g4] = *(const unsigned*)(UZ + (size_t)(row0 + 32 * tb + r32) * 2048 + colw + 8 * g4 + 4 * h);
    const float* sg = inp(F, I_SG) + l * 2048 + colw + ch * 8; const float* sb = inp(F, I_SB) + l * 2048 + colw + ch * 8;
    const f32x4 g0 = *(const f32x4*)sg, g1 = *(const f32x4*)(sg + 4), b0 = *(const f32x4*)sb, b1 = *(const f32x4*)(sb + 4);
    const float* bs = inp(F, I_SBS) + (size_t)(l * 8 + g) * 128;
    float bst[4];
#pragma unroll
    for (int tb = 0; tb < 4; ++tb) bst[tb] = bs[32 * tb + r32];
    const bf16* Wg = Wsb + (size_t)(l * 8 + g) * 16384 + 8 * h;
    bf16x8_t bfr[20];
#pragma unroll
    for (int tb = 0; tb < 4; ++tb)
#pragma unroll
        for (int ks = 0; ks < 2 * tb + 2; ++ks) bfr[tb * (tb + 1) + ks] = *(const bf16x8_t*)(Wg + (32 * tb + r32) * 128 + 16 * ks);
    { const int row = tid >> 2, part = tid & 3; float s1 = 0.f, s2 = 0.f;
#pragma unroll
      for (int k = 0; k < 8; ++k) { s1 += pst[k].x; s2 += pst[k].y; }
      s1 = xadd<2>(xadd<1>(s1)); s2 = xadd<2>(xadd<1>(s2));
      const float mean = s1 * (1.0f / 2048.0f), var = s2 * (1.0f / 2048.0f) - mean * mean;
      if (part == 0) rs[row] = (f32x2){mean, 1.0f / sqrtf(var + LN_EPS)}; }
    __syncthreads();
#pragma unroll
    for (int i = 0; i < 8; ++i) { const int sp = (lane >> 2) + 16 * i; const v2u x = xv[i]; const f32x2 st = rs[sp];
        const f32x4 v0 = (f8x4(x.x) * (1.0f / SVB8) - st.x) * st.y * g0 + b0;
        const f32x4 v1 = (f8x4(x.y) * (1.0f / SVB8) - st.x) * st.y * g1 + b1;
        v4u o; o.x = pg8::cvt_pk_bf16(v0.x, v0.y); o.y = pg8::cvt_pk_bf16(v0.z, v0.w); o.z = pg8::cvt_pk_bf16(v1.x, v1.y); o.w = pg8::cvt_pk_bf16(v1.z, v1.w);
        *(LAS v4u*)(Lw + sp * 64 + ch * 16) = o; }
    LDS_WAIT(); asm volatile("" ::: "memory");
    bf16x8_t af[8];
    { const LAS char* ap = Lw + (8 * h + ((lane & 15) >> 2)) * 64 + ((lane >> 4) & 1) * 32 + (lane & 3) * 8;
#pragma unroll
      for (int ks = 0; ks < 8; ++ks) af[ks] = cat8(vtr(ap + ks * 1024), vtr(ap + ks * 1024 + 256)); }
#pragma unroll
    for (int tb = 0; tb < 4; ++tb) { const int t = 32 * tb + r32; f32x16 a;
#pragma unroll
        for (int r = 0; r < 16; ++r) a[r] = 0.f;
#pragma unroll
        for (int ks = 0; ks < 2 * tb + 2; ++ks) a = MFMA32(af[ks], bfr[tb * (tb + 1) + ks], a);
        const size_t row = (size_t)(row0 + t);
#pragma unroll
        for (int g4 = 0; g4 < 4; ++g4) { const int c0 = colw + 8 * g4 + 4 * h;
            const f32x4 uz = f8x4(uzv[tb][g4]) * (SB8 / SUZ8);
            *(unsigned*)(AB + row * PB8 + 2048 + c0) = pk4_fp8(uz.x * (a[4 * g4 + 0] + bst[tb]), uz.y * (a[4 * g4 + 1] + bst[tb]), uz.z * (a[4 * g4 + 2] + bst[tb]), uz.w * (a[4 * g4 + 3] + bst[tb])); }
    }
    LDS_WAIT(); asm volatile("" ::: "memory");
}
__device__ __forceinline__ void sgu_sample_unit(Frame& F, int l, int b) {
    const int tid = F.tid, c0 = tid * 4, g = c0 >> 8, row0 = MP + b * 4;
    LAS f32x2* rs = (LAS f32x2*)(F.lds);
    const f32x2* vst = WSP(f32x2, WS_VST); const unsigned char* UZ = WSP(unsigned char, WS_UZ); unsigned char* AB = WSP(unsigned char, WS_AB);
    const bf16* Vbs = WSP(bf16, WS_VBS);
    if (tid < 128) { const int row = tid >> 5, k = tid & 31; const f32x2 p = vst[(size_t)(row0 + row) * 32 + k]; float s1 = p.x, s2 = p.y;
        s1 = xadd_32(s1); s2 = xadd_32(s2);
        const float mean = s1 * (1.0f / 2048.0f), var = s2 * (1.0f / 2048.0f) - mean * mean;
        if (k == 0) rs[row] = (f32x2){mean, 1.0f / sqrtf(var + LN_EPS)}; }
    __syncthreads();
    const f32x4 gn = *(const f32x4*)(inp(F, I_SG) + l * 2048 + c0), bi = *(const f32x4*)(inp(F, I_SB) + l * 2048 + c0);
    f32x4 ln[4];
#pragma unroll
    for (int t = 0; t < 4; ++t) { const v2u w = *(const v2u*)(Vbs + (size_t)(b * 4 + t) * 2048 + c0); const f32x2 st = rs[t];
        ln[t] = ((f32x4){bflo(w.x), bfhi(w.x), bflo(w.y), bfhi(w.y)} - st.x) * st.y * gn + bi;
        *(f32x4*)(F.out + O_SV + ((size_t)(l * 32 + b) * 4 + t) * 2048 + c0) = ln[t]; }
    const float* Wg = inp(F, I_SW) + (size_t)(l * 8 + g) * 16384; const float* bs = inp(F, I_SBS) + (size_t)(l * 8 + g) * 128;
#pragma unroll
    for (int t = 0; t < 4; ++t) { f32x4 a = (f32x4){bs[t], bs[t], bs[t], bs[t]};
#pragma unroll
        for (int s = 0; s <= t; ++s) a += Wg[t * 128 + s] * ln[s];
        const f32x4 uz = f8x4(*(const unsigned*)(UZ + (size_t)(row0 + t) * 2048 + c0)) * (SB8 / SUZ8);
        *(unsigned*)(AB + (size_t)(row0 + t) * PB8 + 2048 + c0) = pk4_fp8(uz.x * a.x, uz.y * a.y, uz.z * a.z, uz.w * a.w); }
    __syncthreads();
}

template <int MODE> __device__ __forceinline__ void skinny_gemm(Frame& F, int l, int unit) {
    const int lane = F.lane, w = F.wave, r16 = lane & 15, kq = lane >> 4, rb = w & 1, cb = w >> 1;
    const int rin = 32 * (unit & 3) + 16 * rb + r16, row = MP + rin, n0 = 64 * (unit >> 2), col = n0 + 16 * cb + 4 * kq;
    LAS char* R0 = (LAS char*)F.lds;
    const int lr = lane >> 5, lc = lane & 31;
    const char* Ag[2]; const char* Bg[4];
#pragma unroll
    for (int i = 0; i < 2; ++i) { const int r = 2 * (2 * w + i) + lr; Ag[i] = (const char*)(MODE == 0 ? WSP(unsigned char, WS_AB) : WSP(unsigned char, WS_MG)) + (size_t)(MP + 32 * (unit & 3) + r) * PB8 + ((lc ^ (r & 15)) & 31) * 16; }
#pragma unroll
    for (int i = 0; i < 4; ++i) { const int r = 2 * (4 * w + i) + lr; Bg[i] = (const char*)(MODE == 0 ? WSP(unsigned char, WS_WP) : WSP(unsigned char, WS_WO)) + (size_t)l * D * PB8 + (size_t)(n0 + r) * PB8 + ((lc ^ (r & 15)) & 31) * 16; }
#define SK_STAGE(blk) do { LAS char* Rd = R0 + ((blk) % 3) * 49152; \
        _Pragma("unroll") for (int i = 0; i < 2; ++i) __builtin_amdgcn_global_load_lds((const unsigned*)(Ag[i] + (blk) * 512), (LAS unsigned*)(Rd + (2 * w + i) * 1024), 16, 0, 0); \
        _Pragma("unroll") for (int i = 0; i < 4; ++i) __builtin_amdgcn_global_load_lds((const unsigned*)(Bg[i] + (blk) * 512), (LAS unsigned*)(Rd + 16384 + (4 * w + i) * 1024), 16, 0, 0); } while (0)
    SK_STAGE(0); SK_STAGE(1);
    f32x4 acc = (f32x4){0.f, 0.f, 0.f, 0.f};
#pragma unroll 1
    for (int blk = 0; blk < 8; ++blk) {
        if (blk + 1 < 8) asm volatile("s_waitcnt vmcnt(6)" ::: "memory");
        else asm volatile("s_waitcnt vmcnt(0)" ::: "memory");
        __builtin_amdgcn_s_barrier(); asm volatile("" ::: "memory");
        if (blk + 2 < 8) SK_STAGE(blk + 2);
        if (MODE == 0 && blk == 4) { const v2u x = *(const v2u*)(WSP(bf16, WS_RR) + (size_t)row * D + col); acc = acc * ((f32x4){bflo(x.x), bfhi(x.x), bflo(x.y), bfhi(x.y)} * (SB8 / SA8)); }
        const LAS char* Ab = R0 + (blk % 3) * 49152 + (16 * rb + r16) * 512; const LAS char* Bb = R0 + (blk % 3) * 49152 + 16384 + (16 * cb + r16) * 512;
        pg8::v4i_t fa[4][2], fb[4][2];
#pragma unroll
        for (int u = 0; u < 4; ++u) { const int c0 = ((8 * u + kq) ^ r16) & 31, c1 = ((8 * u + 4 + kq) ^ r16) & 31;
            fa[u][0] = *(const LAS pg8::v4i_t*)(Ab + c0 * 16); fa[u][1] = *(const LAS pg8::v4i_t*)(Ab + c1 * 16);
            fb[u][0] = *(const LAS pg8::v4i_t*)(Bb + c0 * 16); fb[u][1] = *(const LAS pg8::v4i_t*)(Bb + c1 * 16); }
        __builtin_amdgcn_sched_barrier(0);
#pragma unroll
        for (int u = 0; u < 4; ++u)
            acc = __builtin_amdgcn_mfma_scale_f32_16x16x128_f8f6f4(__builtin_shufflevector(fb[u][0], fb[u][1], 0, 1, 2, 3, 4, 5, 6, 7), __builtin_shufflevector(fa[u][0], fa[u][1], 0, 1, 2, 3, 4, 5, 6, 7), acc, 0, 0, 0, 0x7f7f7f7f, 0, 0x7f7f7f7f);
        asm volatile("s_waitcnt lgkmcnt(0)" ::: "memory");
    }
    __builtin_amdgcn_s_barrier(); asm volatile("" ::: "memory");
#undef SK_STAGE
    if (MODE == 0) {
        const unsigned sg = *(const unsigned*)(WSP(unsigned char, WS_SGB) + (size_t)row * D + col);
        const f32x4 v = acc * (f8x4(sg) * (SMG / (SB8 * SWP * SG8)));
        *(unsigned*)(WSP(unsigned char, WS_MG) + (size_t)row * PB8 + col) = pk4_fp8(v.x, v.y, v.z, v.w);
    } else {
        const float* xr = (l == 0 ? inp(F, I_XS) : WSP(float, WS_X1S)) + (size_t)rin * D + col;
        const float* gr = WSP(float, WS_MOD) + (size_t)(l * NSEQ + 4 + (rin >> 2)) * NMOD + 2 * D + col;
        const f32x4 r = *(const f32x4*)xr * ALPHA + *(const f32x4*)gr * (acc * (1.0f / (SMG * SWO)));
        *(f32x4*)(WSP(float, WS_RS) + (size_t)rin * D + col) = r;
    }
}
__device__ __forceinline__ void ln_sample_row(Frame& F, int l, int rin, float* dst, bool hb) {
    const int row = MP + rin, seq = 4 + (rin >> 2), lane = F.lane;
    const float* rp = WSP(float, WS_RS) + (size_t)rin * D + lane * 4;
    f32x4 v[16]; float s1 = 0.f;
#pragma unroll
    for (int j = 0; j < 16; ++j) { v[j] = *(const f32x4*)(rp + 256 * j); s1 += (v[j].x + v[j].y) + (v[j].z + v[j].w); }
    s1 = xadd_wave(s1);
    const float mean = s1 * (1.0f / 4096.0f); float s2 = 0.f;
#pragma unroll
    for (int j = 0; j < 16; ++j) { v[j] = v[j] - mean; s2 += (v[j].x * v[j].x + v[j].y * v[j].y) + (v[j].z * v[j].z + v[j].w * v[j].w); }
    s2 = xadd_wave(s2);
    const float rstd = 1.0f / sqrtf(s2 * (1.0f / 4096.0f) + LN_EPS);
    const float* lg = inp(F, I_LNG) + l * D + lane * 4; const float* lb = inp(F, I_LNB) + l * D + lane * 4;
    const float* md = WSP(float, WS_MOD) + (size_t)(1 * NSEQ + seq) * NMOD + lane * 4; bf16* Hb = WSP(bf16, WS_HB) + (size_t)row * LDK + lane * 4; unsigned char* Hb8 = WSP(unsigned char, WS_HB8) + (size_t)row * PB8 + lane * 4;
#pragma unroll
    for (int j = 0; j < 16; ++j) { const f32x4 o = v[j] * rstd * *(const f32x4*)(lg + 256 * j) + *(const f32x4*)(lb + 256 * j);
        *(f32x4*)(dst + lane * 4 + 256 * j) = o;
        if (hb) { const f32x4 hv = o * (*(const f32x4*)(md + D + 256 * j) + 1.0f) + *(const f32x4*)(md + 256 * j); v2u p; p.x = pk2(hv.x, hv.y); p.y = pk2(hv.z, hv.w); *(GAS v2u*)(Hb + 256 * j) = p;
            *(GAS unsigned*)(Hb8 + 256 * j) = pk4_fp8(hv.x * SH8, hv.y * SH8, hv.z * SH8, hv.w * SH8); } }
}

__device__ __forceinline__ void ln_rows(Frame& F, int l, int row0, int nrows, int seq, int slice, float* dst  ) {
    const int col = slice * 1024 + F.lane * 4; const bool hb = (l == 0);
    f32x4 gn[4], bi[4], sh[4], sc[4];
    const float* md = WSP(float, WS_MOD) + (size_t)(1 * NSEQ + seq) * NMOD; const float* lg = inp(F, I_LNG) + l * D; const float* lb = inp(F, I_LNB) + l * D;
    const f32x2* rst = WSP(f32x2, WS_RST); const bf16* Rb = l == 0 ? WSP(bf16, WS_RB0) : WSP(bf16, WS_RB1); bf16* Hb = WSP(bf16, WS_HB); unsigned char* Hb8 = WSP(unsigned char, WS_HB8); f32x2* st0 = WSP(f32x2, WS_ST0);
    const bool wb = (row0 & 2047) >= 1792;
#pragma unroll
    for (int j = 0; j < 4; ++j) { gn[j] = *(const f32x4*)(lg + col + 256 * j); bi[j] = *(const f32x4*)(lb + col + 256 * j);
        if (hb) { sh[j] = *(const f32x4*)(md + col + 256 * j); sc[j] = *(const f32x4*)(md + D + col + 256 * j) + 1.0f; } else { sh[j] = (f32x4){0.f, 0.f, 0.f, 0.f}; sc[j] = sh[j]; } }
    for (int r0 = 0; r0 < nrows; r0 += 4) {
      f32x2 pp[4]; v2u wv[4][4];
#pragma unroll
      for (int rr = 0; rr < 4; ++rr) pp[rr] = rst[(size_t)(row0 + r0 + rr) * 64 + F.lane];
#pragma unroll
      for (int rr = 0; rr < 4; ++rr)
#pragma unroll
          for (int j = 0; j < 4; ++j) wv[rr][j] = *(const v2u*)(Rb + (size_t)(row0 + r0 + rr) * D + col + 256 * j);
#pragma unroll
      for (int rr = 0; rr < 4; ++rr) { const int r = r0 + rr;
        float s1 = pp[rr].x, s2 = pp[rr].y;
        s1 = xadd_wave(s1); s2 = xadd_wave(s2);
        const float mean = s1 * (1.0f / 4096.0f), var = s2 * (1.0f / 4096.0f) - mean * mean, rstd = 1.0f / sqrtf(var + LN_EPS);
        if (hb && slice == 0 && F.lane == 0) st0[row0 + r] = (f32x2){mean, rstd};
#pragma unroll
        for (int j = 0; j < 4; ++j) { const v2u w = wv[rr][j];
            const f32x4 v = ((f32x4){bflo(w.x), bfhi(w.x), bflo(w.y), bfhi(w.y)} - mean) * rstd * gn[j] + bi[j];
            if (hb) { const f32x4 hv = v * sc[j] + sh[j]; *(GAS unsigned*)(Hb8 + (size_t)(row0 + r) * PB8 + col + 256 * j) = pk4_fp8(hv.x * SH8, hv.y * SH8, hv.z * SH8, hv.w * SH8);
                if (wb) { v2u o; o.x = pk2(hv.x, hv.y); o.y = pk2(hv.z, hv.w); *(GAS v2u*)(Hb + (size_t)(row0 + r) * LDK + col + 256 * j) = o; } }
            else *(f32x4*)(dst + (size_t)r * D + col + 256 * j) = v; }
      }
    }
}

struct Args { const float* in[19]; float* out; unsigned char* ws; int ph_lo, ph_hi; };
#ifndef PH_MASK
#define PH_MASK 0xfff
#endif
__global__ void __launch_bounds__(NWAVES * 64, 2) mk_fwd(Args args) {
    extern __shared__ __attribute__((aligned(16))) unsigned char lds[];
    Frame F;
    F.lds = (LAS unsigned char*)lds;
    volatile LAS unsigned* MISC = (volatile LAS unsigned*)(F.lds + MISC_OFF);
    F.tid = threadIdx.x; F.lane = F.tid & 63; F.wave = __builtin_amdgcn_readfirstlane(F.tid >> 6); F.bx = blockIdx.x;
    F.ws = args.ws; F.out = args.out;
    gu32* ctl = (gu32*)(F.ws + WS_CTL);
    asm volatile("s_setreg_imm32_b32 hwreg(HW_REG_MODE, 23, 1), 1");
    for (int u = F.tid; u < (LDS_BYTES - LDSCTL_OFF) / 4; u += NWAVES * 64) ((LAS unsigned*)(F.lds + LDSCTL_OFF))[u] = 0u;
    __syncthreads();
    if (F.tid == 0) { volatile LAS unsigned long long* pt = (volatile LAS unsigned long long*)(F.lds + PTAB_OFF);
#pragma unroll
        for (int k = 0; k < 19; ++k) pt[k] = (unsigned long long)args.in[k]; }
    __syncthreads();
#if MK_SPLIT
    const int lo = args.ph_lo, hi = args.ph_hi;
#else
    constexpr int lo = 0, hi = 12;
#endif
    const bool use_bar = (hi - lo) > 1;
    XcdBarrier bar; bar.bar = (unsigned*)(ctl + CW_BAR); bar.x = 0; bar.st = nullptr;
    if (use_bar) bar = xcd_barrier_post((unsigned*)(ctl + CW_BAR), MISC + 8);
#define IN(k) (((PH_MASK >> ((k) > 6 ? (k) - 5 : (k))) & 1) && lo <= (k) && (k) < hi)
#define SEAM(k) do { if (lo <= (k) && (k) + 1 < hi) { REFRESH(); xcd_barrier(bar, F.tid == 0); } } while (0)
#define REFRESH() do { int t_, w_ = wave0, b_ = bx0; asm volatile("v_mbcnt_lo_u32_b32 %0, -1, 0\n\tv_mbcnt_hi_u32_b32 %0, -1, %0" : "=v"(t_), "+s"(w_), "+s"(b_)); F.lane = t_; F.wave = w_; F.bx = b_; F.tid = w_ * 64 + t_; } while (0)
#define GW (F.bx * NWAVES + F.wave)
    const int NGW = F.G * NWAVES; const int wave0 = F.wave, bx0 = F.bx;

    if (IN(0)) {
        asm volatile("; MARK_P0a");
        REFRESH();
        if (F.bx < 192) ada_item(F, F.bx);
        LAS float* scr = (LAS float*)(F.lds + F.wave * 16384);
        int sh = F.bx & 7, left = 8;
        for (;;) {
            const int v = pull8(ctl + CW_WORK0, (I_LAYER + I_WS) / 8, sh, left, F.lane);
            if (v < 0) break;
            copy_chunk(F, v < I_LAYER ? v : I_TR + (v - I_LAYER), scr);
        }
    }
    SEAM(0);
    if (IN(1)) {
        asm volatile("; MARK_P0b");
        REFRESH();
        for (int it = GW; it < 2048 + 128; it += NGW) {
            if (it < 2048) { const int rb = it >> 2, sl = it & 3; h_rows(F, inp(F, I_XP) + (size_t)rb * 16 * D, rb * 16, 16, rb >> 7, sl, 0); }
            else { const int q = it - 2048, sq = q >> 2, sl = q & 3; h_rows(F, inp(F, I_XS) + (size_t)sq * 4 * D, MP + sq * 4, 4, 4 + sq, sl, 0); }
        }
    }
    SEAM(1);
#pragma unroll 1
    for (int l = 0; l < 2; ++l) {
        const int pb = 2 + 5 * l;
        if (IN(pb)) {
            asm volatile("; MARK_GEMM1");
            REFRESH();
            { pg8::Gemm g8{WSP(bf16, WS_HB8), (const bf16*)(WSP(unsigned char, WS_WIN8) + (size_t)l * NIN * PB8), MPAD, NIN, K8};
              OrderF8 S; S.c = F.bx; EpiInT<true> E{F.ws, F.out, l};
              pg8::gemm_phase<K8, LD8, EpiInT<true>, OrderF8, PG8_ALIGN, PG8_SP2, false, true>(F.lds, g8, S, E, F.wave); }
            REFRESH();
            { pg8::Gemm g{WSP(bf16, WS_HB), WSP(bf16, WS_WIN) + (size_t)l * NIN * LDK, MPAD, NIN, D};
              OrderBf S; S.c = F.bx; EpiInT<false> E{F.ws, F.out, l};
              pg8::gemm_phase<D, LDK, EpiInT<false>, OrderBf, PG8_ALIGN, PG8_SP2>(F.lds, g, S, E, F.wave); }
            if (l == 0) {
                REFRESH();
                if (F.tid == 0) (void)__hip_atomic_fetch_add((unsigned*)(ctl + CW_DONE1), 1u, RLX_AGENT);
                if (F.bx >= G1_UNITS - 2048 - G1_NF8W && F.bx < G1_NF8W) steal_copies(F, true, 1, 3);
            } else {
                REFRESH();
                if (F.bx >= G1_UNITS - 2048 - G1_NF8W && F.bx < G1_NF8W) steal_copies(F, false, 2, 1 << 20);
            }
        }
        SEAM(pb);
        if (IN(pb + 1)) {
            asm volatile("; MARK_MIX");
            REFRESH();
            for (int u = F.bx; u < 256; u += F.G) attn_prompt_unit(F, l, u);
            REFRESH();
            { int par = 0; for (int u = F.bx; u < 512; u += F.G) { sgu_prompt_unit(F, l, u, par); par ^= 1; } }
            __syncthreads();
            REFRESH();
            for (int u = F.bx; u < 128; u += F.G) attn_sample_unit(F, l, u);
            REFRESH();
            for (int u = F.bx - 128; u < 32; u += F.G) if (u >= 0) sgu_sample_unit(F, l, u);
        }
        SEAM(pb + 1);
        if (IN(pb + 2)) {
            asm volatile("; MARK_GEMM2");
            REFRESH();
            pg8::Gemm g{WSP(bf16, WS_AB), (const bf16*)(WSP(unsigned char, WS_WP) + (size_t)l * D * PB8), MP, D, K8}; pg8::StaticOrderC<MP, D> S; S.init(F.G, F.bx);
            EpiMerge E{WSP(bf16, WS_RR), WSP(unsigned char, WS_SGB), WSP(unsigned char, WS_MG)};
            if (F.bx & 8) { skinny_gemm<0>(F, l, F.bx); REFRESH(); }
            pg8::gemm_phase<K8, LD8, EpiMerge, pg8::StaticOrderC<MP, D>, PG8_ALIGN, PG8_SP2, false, true>(F.lds, g, S, E, F.wave);
            REFRESH();
            if (!(F.bx & 8)) skinny_gemm<0>(F, l, F.bx);
        }
        SEAM(pb + 2);
        if (IN(pb + 3)) {
            asm volatile("; MARK_GEMM3");
            REFRESH();
            pg8::Gemm g{WSP(bf16, WS_MG), (const bf16*)(WSP(unsigned char, WS_WO) + (size_t)l * D * PB8), MP, D, K8}; pg8::StaticOrderC<MP, D> S; S.init(F.G, F.bx);
            if (F.bx & 8) { skinny_gemm<1>(F, l, F.bx); REFRESH(); }
            if (l == 0) { EpiOutT<0> E{inp(F, I_XP), nullptr, nullptr, nullptr, nullptr, WSP(float, WS_MOD) + 2 * D, WSP(bf16, WS_RB0), WSP(f32x2, WS_RST)};
                pg8::gemm_phase<K8, LD8, EpiOutT<0>, pg8::StaticOrderC<MP, D>, PG8_ALIGN, PG8_SP2, false, true>(F.lds, g, S, E, F.wave); }
            else { EpiOutT<1> E{nullptr, WSP(bf16, WS_RB0), WSP(f32x2, WS_ST0), inp(F, I_LNG), inp(F, I_LNB), WSP(float, WS_MOD) + (size_t)NSEQ * NMOD + 2 * D, WSP(bf16, WS_RB1), WSP(f32x2, WS_RST)};
                pg8::gemm_phase<K8, LD8, EpiOutT<1>, pg8::StaticOrderC<MP, D>, PG8_ALIGN, PG8_SP2, false, true>(F.lds, g, S, E, F.wave); }
            REFRESH();
            if (!(F.bx & 8)) skinny_gemm<1>(F, l, F.bx);
        }
        SEAM(pb + 3);
        if (IN(pb + 4)) {
            asm volatile("; MARK_LN");
            REFRESH();
            float* dp = F.out + O_YP; float* ds = l == 0 ? WSP(float, WS_X1S) : F.out + O_YS;
            for (int it = GW; it < 2048 + 128; it += NGW) {
                if (it < 2048) { const int rb = it >> 2, sl = it & 3; ln_rows(F, l, rb * 16, 16, rb >> 7, sl, dp + (size_t)rb * 16 * D); }
                else { const int rin = it - 2048; ln_sample_row(F, l, rin, ds + (size_t)rin * D, l == 0); }
            }
            if (l == 0) steal_copies(F, false, 1, 1 << 20);
        }
        if (l == 0) SEAM(pb + 4);
    }
#undef IN
#undef SEAM
}

extern "C" void kernel_launch(void* const* d_in, const int* in_sizes, int n_in, void* d_out, int out_size, void* d_ws, size_t ws_size, hipStream_t stream) {
    static int grid = 0;
    if (grid == 0) {
        if (n_in != 19 || out_size != (int)O_END || ws_size < WS_END) { fprintf(stderr, "kernel_launch: unexpected sizes (n_in %d, out %d, ws %zu); nothing launched\n", n_in, out_size, ws_size); grid = -1; return; }
        int dev = 0, cus = 0, per_cu = 0;
        if (hipGetDevice(&dev) != hipSuccess || hipDeviceGetAttribute(&cus, hipDeviceAttributeMultiprocessorCount, dev) != hipSuccess) { grid = -1; return; }
        if (hipFuncSetAttribute((const void*)mk_fwd, hipFuncAttributeMaxDynamicSharedMemorySize, LDS_BYTES) != hipSuccess) { fprintf(stderr, "kernel_launch: hipFuncSetAttribute failed\n"); grid = -1; return; }
        if (hipOccupancyMaxActiveBlocksPerMultiprocessor(&per_cu, (const void*)mk_fwd, NWAVES * 64, LDS_BYTES) != hipSuccess || per_cu < 1)
            fprintf(stderr, "kernel_launch: note: occupancy query reports %d workgroups per CU\n", per_cu);
        (void)hipGetLastError();
        if (cus != Frame::G) { fprintf(stderr, "kernel_launch: built for a %d-CU device, found %d CUs; nothing launched\n", Frame::G, cus); grid = -1; return; }
        grid = cus;
    }
    if (grid < 0) return;
    if (hipMemsetAsync((char*)d_ws + WS_CTL, 0, CTL_ZERO_BYTES, stream) != hipSuccess) return;
    Args a{};
    for (int i = 0; i < 19; ++i) a.in[i] = (const float*)d_in[i];
    a.out = (float*)d_out; a.ws = (unsigned char*)d_ws;
#if MK_SPLIT
    for (int p = 0; p < 12; ++p) { a.ph_lo = p; a.ph_hi = p + 1; hipLaunchKernelGGL(mk_fwd, dim3(grid), dim3(NWAVES * 64), LDS_BYTES, stream, a); }
#else
    a.ph_lo = 0; a.ph_hi = 12;
    hipLaunchKernelGGL(mk_fwd, dim3(grid), dim3(NWAVES * 64), LDS_BYTES, stream, a);
#endif
    const hipError_t le = hipPeekAtLastError();
    if (le != hipSuccess) fprintf(stderr, "kernel_launch: launch failed: %s\n", hipGetErrorName(le));
}
```

```cpp
#include <hip/hip_runtime.h>
#include <cstdio>
#include <cstdint>

namespace pg8 {
#define PG8_LAS __attribute__((address_space(3)))
typedef unsigned short bf16_t;
typedef short bf16x8 __attribute__((ext_vector_type(8)));
typedef float f32x4 __attribute__((ext_vector_type(4)));
typedef unsigned u32x4 __attribute__((ext_vector_type(4)));
typedef unsigned u32x2 __attribute__((ext_vector_type(2)));
typedef int v4i_t __attribute__((ext_vector_type(4)));
constexpr int BM = 256, BK = 64, HALF = 128, HTB = HALF * BK * 2  , STAGE_BYTES = 8 * HTB, NXCD = 8, WGM = 8;

__host__ __device__ __forceinline__ int lds_byte(int r, int c) { const int st = (r >> 4) * 2 + (c >> 5), rr = r & 15, cc = c & 31, ob = rr * 64 + cc * 2; return st * 1024 + (ob ^ (((ob >> 9) & 1) << 5)); }
__host__ __device__ __forceinline__ void stage_rc(int b, int& R, int& C) { const int st = b / 1024, sb = b % 1024, swz = sb ^ (((sb >> 9) & 1) << 5); R = (st >> 1) * 16 + swz / 64; C = (st & 1) * 32 + (swz % 64) / 2; }
__host__ __device__ __forceinline__ int perm32(int rho) { const int n = rho >> 4, i = rho & 15; return 8 * (i >> 2) + 4 * n + (i & 3); }

struct Unit { int pm, pn; };
struct Gemm { const bf16_t* A; const bf16_t* Bt; int M, N, K; };

template <int MC, int NC> struct StaticOrderC {
    static constexpr int nM = MC / BM, nN = NC / BM, nwg = nM * nN;
    int G, c;
    __host__ __device__ void init(int G_, int c_) { G = G_; c = c_; }
    __host__ __device__ static void map(int L, Unit& u) {
        int wgid = L; { constexpr int q = nwg / NXCD, r = nwg % NXCD; const int xcd = wgid % NXCD, off = wgid / NXCD; wgid = (xcd < r ? xcd * (q + 1) : r * (q + 1) + (xcd - r) * q) + off; }
        constexpr int nig = WGM * nN; const int gid = wgid / nig, fm = gid * WGM, gsz = (nM - fm) < WGM ? (nM - fm) : WGM;
        u.pm = fm + ((wgid % nig) % gsz); u.pn = (wgid % nig) / gsz;
    }
    __host__ __device__ bool next(int i, Unit& u) const {
        const int L = i * G + c; if (L >= nwg) return false;
        int wgid = L; { constexpr int q = nwg / NXCD, r = nwg % NXCD; const int xcd = wgid % NXCD, off = wgid / NXCD; wgid = (xcd < r ? xcd * (q + 1) : r * (q + 1) + (xcd - r) * q) + off; }
        constexpr int nig = WGM * nN; const int gid = wgid / nig, fm = gid * WGM, gsz = (nM - fm) < WGM ? (nM - fm) : WGM;
        u.pm = fm + ((wgid % nig) % gsz); u.pn = (wgid % nig) / gsz; return true;
    }
    __device__ __forceinline__ void a_ready(const Unit&) const {}
    __device__ __forceinline__ void done(const Unit&) const {}
};

__device__ __forceinline__ unsigned cvt_pk_bf16(float lo, float hi) { unsigned r; asm volatile("v_cvt_pk_bf16_f32 %0, %1, %2" : "=v"(r) : "v"(lo), "v"(hi)); return r; }

template <int KC, int LD, class Epi, class Sched, bool ALIGN_EPI = false, bool SP2 = false, bool HM = false, bool F8 = false>
__device__ __forceinline__ void gemm_phase(PG8_LAS unsigned char* lds, const Gemm g, const Sched& S, const Epi& E, const int wid_) {
    const int wid = __builtin_amdgcn_readfirstlane(wid_);
    int lane_; asm volatile("v_mbcnt_lo_u32_b32 %0, -1, 0\n\tv_mbcnt_hi_u32_b32 %0, -1, %0" : "=v"(lane_));
    const int lane = lane_, tid = wid * 64 + lane, wr = wid >> 2, wc = wid & 3, fr = lane & 15, fq = lane >> 4;
    constexpr int K = KC, nt = K / BK;
    unsigned voffA[2], voffB[2];
#pragma unroll
    for (int i = 0; i < 2; ++i) { int R, C; stage_rc(tid * 16 + i * 8192, R, C); const int Rb = Epi::PERM ? ((R & ~31) + perm32(R & 31)) : R;
        voffA[i] = (unsigned)(R * LD + C) * 2u; voffB[i] = (unsigned)(Rb * LD + C) * 2u; }
    constexpr unsigned kstep = (unsigned)(BK * 2);
    constexpr unsigned hstep = (unsigned)(HALF * LD * 2);
    constexpr unsigned tstep = 2 * hstep;
    const __amdgpu_buffer_rsrc_t rA = __builtin_amdgcn_make_buffer_rsrc((void*)g.A, 0, 0x7fffffff, 0x00020000), rB = __builtin_amdgcn_make_buffer_rsrc((void*)g.Bt, 0, 0x7fffffff, 0x00020000);
    const unsigned ldsw = (unsigned)wid * 1024u;
    const int aoff = lds_byte(wr * 64 + fr, fq * 8), boff = lds_byte(wc * 32 + fr, fq * 8);
#define PG8_SA(b, h) (((b) * 2 + (h)) * HTB)
#define PG8_SB(b, h) ((4 + (b) * 2 + (h)) * HTB)
#define PG8_STAGE_R(rs, bufoff, goff, voff) do { _Pragma("unroll") for (int _i = 0; _i < 2; ++_i) \
        __builtin_amdgcn_raw_ptr_buffer_load_lds(rs, (PG8_LAS unsigned*)(lds + (bufoff) + ldsw + _i * 8192), 16, (voff)[_i], (int)(goff), 0, 0); } while (0)
#define PG8_STAGE_A(bufoff, goff, voff) PG8_STAGE_R(rA, bufoff, goff, voff)
#define PG8_STAGE_B(bufoff, goff, voff) PG8_STAGE_R(rB, bufoff, goff, voff)
#define PG8_LDA(dst, b, h) do { _Pragma("unroll") for (int m = 0; m < 4; ++m) _Pragma("unroll") for (int k = 0; k < 2; ++k) dst[m][k] = *(const PG8_LAS bf16x8*)(lds + PG8_SA(b, h) + aoff + m * 2048 + k * 1024); } while (0)
#define PG8_LDB(dst, b, h) do { _Pragma("unroll") for (int n = 0; n < 2; ++n) _Pragma("unroll") for (int k = 0; k < 2; ++k) dst[n][k] = *(const PG8_LAS bf16x8*)(lds + PG8_SB(b, h) + boff + n * 2048 + k * 1024); } while (0)
#define PG8_CAT(x0, x1) __builtin_shufflevector(__builtin_bit_cast(v4i_t, x0), __builtin_bit_cast(v4i_t, x1), 0, 1, 2, 3, 4, 5, 6, 7)
#define PG8_MMA(ai, bj, At, Bt) do { __builtin_amdgcn_s_setprio(1); if constexpr (F8) { _Pragma("unroll") for (int m = 0; m < 4; ++m) _Pragma("unroll") for (int n = 0; n < 2; ++n) \
        acc[ai][bj][m][n] = __builtin_amdgcn_mfma_scale_f32_16x16x128_f8f6f4(PG8_CAT(Bt[n][0], Bt[n][1]), PG8_CAT(At[m][0], At[m][1]), acc[ai][bj][m][n], 0, 0, 0, 0x7f7f7f7f, 0, 0x7f7f7f7f); } \
        else { _Pragma("unroll") for (int m = 0; m < 4; ++m) _Pragma("unroll") for (int n = 0; n < 2; ++n) _Pragma("unroll") for (int k = 0; k < 2; ++k) \
        acc[ai][bj][m][n] = __builtin_amdgcn_mfma_f32_16x16x32_bf16(Bt[n][k], At[m][k], acc[ai][bj][m][n], 0, 0, 0); } __builtin_amdgcn_s_setprio(0); } while (0)
#define PG8_WAIT_V(n) asm volatile("s_waitcnt vmcnt(" #n ")" ::: "memory")
#define PG8_WAIT_L(n) asm volatile("s_waitcnt lgkmcnt(" #n ")" ::: "memory")
#define PG8_BAR __builtin_amdgcn_s_barrier()
#define PG8_SCHED __builtin_amdgcn_sched_barrier(0)
    Unit cur, nxt; int ui = 0;
    if (!S.next(0, cur)) return;
    f32x4 acc[2][2][4][2];
#pragma unroll
    for (int a = 0; a < 2; ++a)
#pragma unroll
        for (int b = 0; b < 2; ++b)
#pragma unroll
            for (int m = 0; m < 4; ++m)
#pragma unroll
                for (int n = 0; n < 2; ++n) acc[a][b][m][n] = (f32x4){0.f, 0.f, 0.f, 0.f};
    bf16x8 At[4][2], B0[2][2], B1[2][2];
    constexpr unsigned astep = HM ? hstep : tstep;
    unsigned cA = (unsigned)cur.pm * astep, cB = (unsigned)cur.pn * tstep;
    S.a_ready(cur);
    if constexpr (SP2) {
        PG8_STAGE_B(PG8_SB(0, 0), cB, voffB); PG8_STAGE_B(PG8_SB(0, 1), cB + hstep, voffB); PG8_STAGE_A(PG8_SA(0, 0), cA, voffA); PG8_STAGE_A(PG8_SA(0, 1), cA + hstep, voffA);
        if (wr == 1) PG8_BAR;
        PG8_WAIT_V(2); PG8_BAR;
        PG8_STAGE_B(PG8_SB(1, 0), cB + kstep, voffB); PG8_STAGE_A(PG8_SA(1, 0), cA + kstep, voffA); PG8_STAGE_B(PG8_SB(1, 1), cB + hstep + kstep, voffB);
        PG8_WAIT_V(6); PG8_BAR;
    } else {
        PG8_STAGE_B(PG8_SB(0, 0), cB, voffB); PG8_STAGE_A(PG8_SA(0, 0), cA, voffA); PG8_STAGE_B(PG8_SB(0, 1), cB + hstep, voffB); PG8_STAGE_A(PG8_SA(0, 1), cA + hstep, voffA);
        if (wr == 1) PG8_BAR;
        PG8_WAIT_V(4); PG8_BAR;
        PG8_STAGE_B(PG8_SB(1, 0), cB + kstep, voffB); PG8_STAGE_A(PG8_SA(1, 0), cA + kstep, voffA); PG8_STAGE_B(PG8_SB(1, 1), cB + hstep + kstep, voffB);
        PG8_WAIT_V(6); PG8_BAR;
    }
    for (;;) {
        const bool has_next = S.next(ui + 1, nxt);
        const unsigned nA = has_next ? (unsigned)nxt.pm * astep : cA, nB = has_next ? (unsigned)nxt.pn * tstep : cB;
        for (int t = 0; t < nt; t += 2) {
            const bool last = (t == nt - 2);
            const unsigned a1 = cA + (unsigned)(t + 1) * kstep;
            const unsigned a2 = last ? nA : cA + (unsigned)(t + 2) * kstep, b2 = last ? nB : cB + (unsigned)(t + 2) * kstep;
            const unsigned a3 = a2 + kstep, b3 = b2 + kstep;
            if (last && has_next) S.a_ready(nxt);
            if constexpr (Epi::MIDK) { if (t == (nt >> 1)) E.mid(acc, cur, wr, wc, fr, fq); }
            if constexpr (SP2) {
            PG8_LDB(B0, 0, 0); PG8_LDB(B1, 0, 1); PG8_SCHED; PG8_LDA(At, 0, 0); PG8_STAGE_A(PG8_SA(1, 1), a1 + hstep, voffA);
            PG8_WAIT_V(8); PG8_WAIT_L(0); PG8_BAR; PG8_MMA(0, 0, At, B0); PG8_MMA(0, 1, At, B1); PG8_BAR; PG8_SCHED;
            if constexpr (!HM) PG8_LDA(At, 0, 1); PG8_STAGE_B(PG8_SB(0, 0), b2, voffB); PG8_STAGE_B(PG8_SB(0, 1), b2 + hstep, voffB); PG8_STAGE_A(PG8_SA(0, 0), a2, voffA);
            PG8_WAIT_V(8); PG8_WAIT_L(0); PG8_BAR; if constexpr (!HM) { PG8_MMA(1, 0, At, B0); PG8_MMA(1, 1, At, B1); } PG8_BAR; PG8_SCHED;
            PG8_LDB(B0, 1, 0); PG8_LDB(B1, 1, 1); PG8_SCHED; PG8_LDA(At, 1, 0); PG8_STAGE_A(PG8_SA(0, 1), a2 + hstep, voffA);
            PG8_WAIT_V(8); PG8_WAIT_L(0); PG8_BAR; PG8_MMA(0, 0, At, B0); PG8_MMA(0, 1, At, B1); PG8_BAR; PG8_SCHED;
            if constexpr (!HM) PG8_LDA(At, 1, 1); PG8_STAGE_B(PG8_SB(1, 0), b3, voffB); PG8_STAGE_B(PG8_SB(1, 1), b3 + hstep, voffB); PG8_STAGE_A(PG8_SA(1, 0), a3, voffA);
            PG8_WAIT_V(8); PG8_WAIT_L(0); PG8_BAR; if constexpr (!HM) { PG8_MMA(1, 0, At, B0); PG8_MMA(1, 1, At, B1); } PG8_BAR; PG8_SCHED;
            } else {
            PG8_LDB(B0, 0, 0); PG8_SCHED; PG8_LDA(At, 0, 0); PG8_STAGE_A(PG8_SA(1, 1), a1 + hstep, voffA);
            PG8_WAIT_L(8); PG8_BAR; PG8_WAIT_L(0); PG8_MMA(0, 0, At, B0); PG8_BAR; PG8_SCHED;
            PG8_LDB(B1, 0, 1); PG8_STAGE_B(PG8_SB(0, 0), b2, voffB);
            PG8_BAR; PG8_WAIT_L(0); PG8_MMA(0, 1, At, B1); PG8_BAR;
            PG8_LDA(At, 0, 1); PG8_STAGE_A(PG8_SA(0, 0), a2, voffA);
            PG8_BAR; PG8_WAIT_L(0); PG8_MMA(1, 0, At, B0); PG8_BAR; PG8_SCHED;
            PG8_STAGE_B(PG8_SB(0, 1), b2 + hstep, voffB);
            PG8_WAIT_V(6); PG8_BAR; PG8_MMA(1, 1, At, B1); PG8_BAR;
            PG8_LDB(B0, 1, 0); PG8_SCHED; PG8_LDA(At, 1, 0); PG8_STAGE_A(PG8_SA(0, 1), a2 + hstep, voffA);
            PG8_WAIT_L(8); PG8_BAR; PG8_WAIT_L(0); PG8_MMA(0, 0, At, B0); PG8_BAR; PG8_SCHED;
            PG8_LDB(B1, 1, 1); PG8_STAGE_B(PG8_SB(1, 0), b3, voffB);
            PG8_BAR; PG8_WAIT_L(0); PG8_MMA(0, 1, At, B1); PG8_BAR;
            PG8_LDA(At, 1, 1); PG8_STAGE_A(PG8_SA(1, 0), a3, voffA);
            PG8_BAR; PG8_WAIT_L(0); PG8_MMA(1, 0, At, B0); PG8_BAR; PG8_SCHED;
            PG8_STAGE_B(PG8_SB(1, 1), b3 + hstep, voffB);
            PG8_WAIT_V(6); PG8_BAR; PG8_MMA(1, 1, At, B1); PG8_BAR;
            }
        }
        if constexpr (ALIGN_EPI) { if (wr == 0) PG8_BAR; }
        E(acc, cur, wr, wc, fr, fq); S.done(cur);
        if (!has_next) break;
#pragma unroll
        for (int a = 0; a < 2; ++a)
#pragma unroll
            for (int b = 0; b < 2; ++b)
#pragma unroll
                for (int m = 0; m < 4; ++m)
#pragma unroll
                    for (int n = 0; n < 2; ++n) acc[a][b][m][n] = (f32x4){0.f, 0.f, 0.f, 0.f};
        cur = nxt; cA = nA; cB = nB; ++ui;
        if constexpr (ALIGN_EPI) { if (wr == 1) PG8_BAR; }
    }
    PG8_WAIT_V(0);
    if constexpr (!ALIGN_EPI) { if (wr == 0) PG8_BAR; }
    PG8_BAR;
#undef PG8_SA
#undef PG8_SB
#undef PG8_STAGE_R
#undef PG8_STAGE_A
#undef PG8_STAGE_B
#undef PG8_LDA
#undef PG8_LDB
#undef PG8_MMA
#undef PG8_CAT
#undef PG8_WAIT_V
#undef PG8_WAIT_L
#undef PG8_BAR
#undef PG8_SCHED
}
}

#ifndef PG8_SP2
#define PG8_SP2 true
#endif
#ifndef PG8_ALIGN
#define PG8_ALIGN true
#endif
#ifndef MK_SPLIT
#define MK_SPLIT 0
#endif

constexpr int NWAVES = 8;
constexpr int D = 4096, MP = 8192, MS = 128, MTOT = MP + MS, MPAD = 8448, NIN = 18944, DA = 2048, DKV = 256, DSG = 2048;
constexpr int NSEQ = 36, NMOD = 3 * D, SEQ = 2048, WIN = 128;
constexpr int PB8 = D + 128, LD8 = PB8 / 2, K8 = D / 2;
constexpr float SA8 = 32.f, SB8 = 8.f, SWP = 128.f, SMG = 16.f, SWO = 256.f, SH8 = 8.f, SWI = 128.f,
                SQ8 = 16.f, SZA8 = 8.f, SUZ8 = 4.f, SVB8 = 8.f, SG8 = 256.f;
constexpr int LDK = D + 64;
constexpr float ALPHA = 1.4142135623730951f;
constexpr float LN_EPS = 1e-5f;
constexpr float LOG2E = 1.4426950408889634f;
constexpr float QSCALE = 0.125f * LOG2E;
constexpr size_t O_YP = 0, O_YS = 33554432, O_WK = 34078720, O_WV = 34340864, O_NK = 34603008, O_NV = 34668544, O_SV = 34734080, O_END = 35258368;

constexpr size_t MiB = 1u << 20;
constexpr size_t WS_CTL = 0, CTL_ZERO_BYTES = 32768;
constexpr size_t WS_MOD = 1 * MiB;
constexpr size_t WS_WSB = 5 * MiB;
constexpr size_t WS_VST = 6 * MiB;
constexpr size_t WS_RST = 9 * MiB;
constexpr size_t WS_KB = 14 * MiB;
constexpr size_t WS_VB = 19 * MiB;
constexpr size_t WS_WIN = 24 * MiB;
constexpr size_t WS_WP = 328 * MiB;
constexpr size_t WS_WO = 394 * MiB;
constexpr size_t WS_HB = 460 * MiB;
constexpr size_t WS_QB = 528 * MiB;
constexpr size_t WS_ZA = 561 * MiB;
constexpr size_t WS_UZ = 594 * MiB;
constexpr size_t WS_VBB = 627 * MiB;
constexpr size_t WS_VBS = 644 * MiB;
constexpr size_t WS_RR = 660 * MiB;
constexpr size_t WS_SGB = 726 * MiB;
constexpr size_t WS_AB = 792 * MiB;
constexpr size_t WS_MG = 860 * MiB;
constexpr size_t WS_RBUF = 928 * MiB;
constexpr size_t WS_RB0 = 928 * MiB;
constexpr size_t WS_RB1 = 992 * MiB;
constexpr size_t WS_RS = 1056 * MiB;
constexpr size_t WS_X1S = 1058 * MiB;
constexpr size_t WS_ST0 = 1060 * MiB;
constexpr size_t WS_HB8 = 1192 * MiB;
constexpr size_t WS_WIN8 = 1228 * MiB;
constexpr size_t WS_END = 1384 * MiB;
static_assert(WS_HB8 + (size_t)MPAD * PB8 <= WS_WIN8 && WS_WIN8 + 2ull * NIN * PB8 <= WS_END, "d_ws map (fp8)");
static_assert(WS_WIN + 2ull * NIN * LDK * 2 <= WS_WP && WS_WP + 2ull * D * LDK * 2 <= WS_WO && WS_WO + 2ull * D * LDK * 2 <= WS_HB && WS_HB + (size_t)MPAD * LDK * 2 <= WS_QB && WS_AB + (size_t)MPAD * LDK * 2 <= WS_MG && WS_MG + (size_t)MPAD * LDK * 2 <= WS_RBUF, "d_ws map");
static_assert((4096 + 3456) * 4 <= (int)CTL_ZERO_BYTES, "barrier words inside the zeroed region");
constexpr int CW_TMO = 0, CW_CODE = 1, CW_WORK0 = 512, CW_WORK1 = 1024, CW_ADA1 = 192, CW_DONE1 = 256, CW_WORK2 = 1536, CW_BAR = 4096;

constexpr int RING_BYTES = 131072;
constexpr int LDSCTL_OFF = 155648, MISC_OFF = LDSCTL_OFF + 320, PTAB_OFF = LDSCTL_OFF + 512;
constexpr int LDS_BYTES = 159744;

#define GAS __attribute__((address_space(1)))
#define LAS __attribute__((address_space(3)))
typedef unsigned short bf16;
typedef unsigned v4u __attribute__((ext_vector_type(4)));
typedef unsigned v2u __attribute__((ext_vector_type(2)));
typedef float f32x4 __attribute__((ext_vector_type(4)));
typedef float f32x2 __attribute__((ext_vector_type(2)));
typedef GAS unsigned gu32;
#define RLX_AGENT __ATOMIC_RELAXED, __HIP_MEMORY_SCOPE_AGENT
#define LDS_WAIT() asm volatile("s_waitcnt lgkmcnt(0)" ::: "memory")
#define VM_WAIT() asm volatile("s_waitcnt vmcnt(0)" ::: "memory")
__device__ __forceinline__ unsigned f2bf(float f) { unsigned u = __builtin_bit_cast(unsigned, f); return (u + 0x7fffu + ((u >> 16) & 1u)) >> 16; }
__device__ __forceinline__ unsigned pk2(float lo, float hi) { return f2bf(lo) | (f2bf(hi) << 16); }
__device__ __forceinline__ float bflo(unsigned u) { return __builtin_bit_cast(float, u << 16); }
__device__ __forceinline__ float bfhi(unsigned u) { return __builtin_bit_cast(float, u & 0xffff0000u); }
__device__ __forceinline__ unsigned pk4_fp8(float a, float b, float c, float d) { int w = 0; w = __builtin_amdgcn_cvt_pk_fp8_f32(a, b, w, false); w = __builtin_amdgcn_cvt_pk_fp8_f32(c, d, w, true); return (unsigned)w; }
__device__ __forceinline__ int lane_now() { int l; asm volatile("v_mbcnt_lo_u32_b32 %0, -1, 0\n\tv_mbcnt_hi_u32_b32 %0, -1, %0" : "=v"(l)); return l; }
template <int K> __device__ __forceinline__ float xadd(float v) {
    if constexpr (K < 32) return v + __builtin_bit_cast(float, __builtin_amdgcn_ds_swizzle(__builtin_bit_cast(int, v), (K << 10) | 0x1f));
    else { const unsigned u = __builtin_bit_cast(unsigned, v); auto rr = __builtin_amdgcn_permlane32_swap(u, u, false, false); return __builtin_bit_cast(float, (unsigned)rr[0]) + __builtin_bit_cast(float, (unsigned)rr[1]); }
}
template <int K> __device__ __forceinline__ float xmax(float v) {
    if constexpr (K < 32) return fmaxf(v, __builtin_bit_cast(float, __builtin_amdgcn_ds_swizzle(__builtin_bit_cast(int, v), (K << 10) | 0x1f)));
    else { const unsigned u = __builtin_bit_cast(unsigned, v); auto rr = __builtin_amdgcn_permlane32_swap(u, u, false, false); return fmaxf(__builtin_bit_cast(float, (unsigned)rr[0]), __builtin_bit_cast(float, (unsigned)rr[1])); }
}
__device__ __forceinline__ float xadd_wave(float v) { v = xadd<1>(v); v = xadd<2>(v); v = xadd<4>(v); v = xadd<8>(v); v = xadd<16>(v); return xadd<32>(v); }
__device__ __forceinline__ float xmax_wave(float v) { v = xmax<1>(v); v = xmax<2>(v); v = xmax<4>(v); v = xmax<8>(v); v = xmax<16>(v); return xmax<32>(v); }
__device__ __forceinline__ float xadd_32(float v) { v = xadd<1>(v); v = xadd<2>(v); v = xadd<4>(v); v = xadd<8>(v); return xadd<16>(v); }
__device__ __forceinline__ f32x4 f8x4(unsigned w) { const f32x2 a = __builtin_amdgcn_cvt_pk_f32_fp8((int)w, false), b = __builtin_amdgcn_cvt_pk_f32_fp8((int)w, true); return (f32x4){a.x, a.y, b.x, b.y}; }
__device__ __forceinline__ float f8x1(unsigned char b) { return __builtin_amdgcn_cvt_f32_fp8((int)b, 0); }
__device__ __forceinline__ float sigmoidf_(float x) { return __builtin_amdgcn_rcpf(1.0f + __builtin_amdgcn_exp2f(-x * LOG2E)); }
__device__ __forceinline__ float siluf_(float x) { return x * sigmoidf_(x); }

#define XB_TMO      128
#define XB_XCNT(j)  (256  + 64 * (j))
#define XB_XSUB(j)  (1280 + 64 * (j))
#define XB_XGEN(j)  (2304 + 64 * (j))
#define XB_TOP      3328
#define XB_TOPGEN   3392
#define XCD_BAR_WORDS 3456
#define XB_SPIN_CAP (1u << 18)
__device__ __forceinline__ unsigned xb_ld(unsigned* p)              { return __hip_atomic_load(p, __ATOMIC_RELAXED, __HIP_MEMORY_SCOPE_AGENT); }
__device__ __forceinline__ unsigned xb_add(unsigned* p, unsigned v) { return __hip_atomic_fetch_add(p, v, __ATOMIC_RELAXED, __HIP_MEMORY_SCOPE_AGENT); }
__device__ __forceinline__ unsigned xb_xcc_id() { return (unsigned)__builtin_amdgcn_s_getreg((3 << 11) | 20) & 0xFu; }
#define XB_SPIN(cond, bar) do { unsigned _sp = 0; while (cond) { __builtin_amdgcn_s_sleep(1); \
    if ((++_sp & 255u) == 0u) { if (xb_ld(&(bar)[XB_TMO])) break; if (_sp > XB_SPIN_CAP) { atomicAdd(&(bar)[XB_TMO], 1u); break; } } } } while (0)
struct XcdBarrier { unsigned* bar; unsigned x; volatile LAS unsigned* st; };
__device__ __forceinline__ XcdBarrier xcd_barrier_post(unsigned* bar, volatile LAS unsigned* st) {
    XcdBarrier b; b.bar = bar; b.x = xb_xcc_id(); b.st = st;
    if (threadIdx.x == 0) (void)xb_add(&bar[XB_XCNT(b.x)], 1u);
    return b;
}
__device__ __forceinline__ void xcd_barrier_complete(unsigned* bar, unsigned x, unsigned& nloc, unsigned& nx) {
    const unsigned G = gridDim.x * gridDim.y * gridDim.z;
    unsigned sum, cnt, mine, sp = 0u;
    for (;;) {
        sum = 0u; cnt = 0u; mine = 0u;
#pragma unroll
        for (unsigned j = 0; j < 16; ++j) { const unsigned c = xb_ld(&bar[XB_XCNT(j)]); sum += c; cnt += (c > 0u) ? 1u : 0u; mine = (j == x) ? c : mine; }
        if (sum == G) break;
        __builtin_amdgcn_s_sleep(1);
        if ((++sp & 255u) == 0u) { if (xb_ld(&bar[XB_TMO])) break; if (sp > XB_SPIN_CAP) { atomicAdd(&bar[XB_TMO], 1u); break; } }
    }
    nloc = mine > 0u ? mine : 1u; nx = cnt > 0u ? cnt : 1u;
}
__device__ __forceinline__ void xcd_barrier(const XcdBarrier& b, const bool leader) {
    asm volatile("s_waitcnt vmcnt(0)" ::: "memory");
    __syncthreads();
    if (leader) {
        unsigned* bar = b.bar; unsigned bx_ = b.x;
        asm volatile("" : "+s"(bar), "+s"(bx_));
        __builtin_amdgcn_s_waitcnt(0);
        unsigned nloc = b.st[0], nx = b.st[1];
        if (nloc == 0u) { xcd_barrier_complete(bar, bx_, nloc, nx); b.st[0] = nloc; b.st[1] = nx; }
        const unsigned old = xb_add(&bar[XB_XSUB(bx_)], 1u);
        const unsigned gen = old / nloc;
        if (old + 1u == (gen + 1u) * nloc) {
            __builtin_amdgcn_fence(__ATOMIC_RELEASE, "agent");
            asm volatile("s_waitcnt vmcnt(0)" ::: "memory");
            const unsigned og = xb_add(&bar[XB_TOP], 1u);
            const unsigned tg = og / nx;
            if (og + 1u == (tg + 1u) * nx) xb_add(&bar[XB_TOPGEN], 1u);
            else XB_SPIN(xb_ld(&bar[XB_TOPGEN]) == tg, bar);
            __builtin_amdgcn_fence(__ATOMIC_ACQUIRE, "agent");
            xb_add(&bar[XB_XGEN(bx_)], 1u);
            asm volatile("s_waitcnt vmcnt(0)" ::: "memory");
        } else {
            XB_SPIN(xb_ld(&bar[XB_XGEN(bx_)]) == gen, bar);
            __builtin_amdgcn_fence(__ATOMIC_ACQUIRE, "agent");
            asm volatile("s_waitcnt vmcnt(0)" ::: "memory");
        }
    }
    __syncthreads();
}

struct Frame {
    LAS unsigned char* lds;
    unsigned char* ws;
    float* out;
    int tid, lane, wave, bx;
    static constexpr int G = 256;
};
enum { I_XP = 0, I_XS, I_CK, I_CV, I_CP, I_CS, I_WADA, I_BADA, I_WIN, I_SINK, I_SG, I_SB, I_SW, I_SBS, I_WPA, I_WPB, I_WO, I_LNG, I_LNB };
__device__ __forceinline__ const float* inp(const Frame& F, int k) {
    volatile LAS unsigned* t = (volatile LAS unsigned*)(F.lds + PTAB_OFF) + 2 * k;
    const unsigned lo = __builtin_amdgcn_readfirstlane(t[0]), hi = __builtin_amdgcn_readfirstlane(t[1]);
    return (const float*)(const GAS float*)(((unsigned long long)hi << 32) | lo);
}
#define WSP(T, off) ((T*)(F.ws + (off)))
__device__ __forceinline__ int row_seq(int row) { return row < MP ? (row >> 11) : 4 + ((row - MP) >> 2); }

__device__ __forceinline__ void ada_item(Frame& F, int item) {
    const int l = item / 96, cb = item % 96;
    LAS float* sc = (LAS float*)(F.lds);
    LAS float* red = (LAS float*)(F.lds + 40960);
    const float* W = inp(F, I_WADA) + (size_t)l * D * NMOD + cb * 128;
    const float* cp = inp(F, I_CP); const float* cs = inp(F, I_CS);
    const int half = F.lane >> 5, c4 = (F.lane & 31) * 4;
    f32x4 acc[18];
#pragma unroll
    for (int s = 0; s < 18; ++s) acc[s] = (f32x4){0.f, 0.f, 0.f, 0.f};
    f32x4 w[8];
    const float* Wl = W + (size_t)(F.wave * 16) * NMOD + c4;
#pragma unroll
    for (int j = 0; j < 8; ++j) w[j] = __builtin_nontemporal_load((const f32x4*)(Wl + (size_t)j * NMOD));
    const int sq0 = F.tid >> 7, kk = F.tid & 127;
    float cv[9];
    cv[0] = cp[sq0 * D + kk];
#pragma unroll
    for (int j = 1; j < 9; ++j) cv[j] = cs[(sq0 + 4 * j - 4) * D + kk];
    for (int ch = 0; ch < 32; ++ch) {
        LAS float* scb = sc + (ch & 1) * 5120;
#pragma unroll
        for (int j = 0; j < 9; ++j) { const int s = sq0 + 4 * j; scb[kk * 40 + (s < 18 ? s : s + 2)] = siluf_(cv[j]); }
        { const int cn = (ch + 1 < 32 ? ch + 1 : ch) * 128 + kk;
          cv[0] = cp[sq0 * D + cn];
#pragma unroll
          for (int j = 1; j < 9; ++j) cv[j] = cs[(sq0 + 4 * j - 4) * D + cn]; }
        __syncthreads();
#pragma unroll
        for (int h2 = 0; h2 < 2; ++h2) {
            const float* Wn = Wl + (size_t)((h2 == 0 ? ch * 128 + 8 : (ch + 1 < 32 ? (ch + 1) * 128 : ch * 128))) * NMOD;
            f32x4 ac[5];
            { const LAS f32x4* a4 = (const LAS f32x4*)(scb + (F.wave * 16 + h2 * 8) * 40 + half * 20);
#pragma unroll
              for (int s4 = 0; s4 < 5; ++s4) ac[s4] = a4[s4]; }
#pragma unroll
            for (int j = 0; j < 8; ++j) {
                f32x4 an[5];
                if (j + 1 < 8) { const LAS f32x4* a4 = (const LAS f32x4*)(scb + (F.wave * 16 + h2 * 8 + j + 1) * 40 + half * 20);
#pragma unroll
                    for (int s4 = 0; s4 < 5; ++s4) an[s4] = a4[s4]; }
                const f32x4 wv = w[j];
#pragma unroll
                for (int s4 = 0; s4 < 5; ++s4) { const f32x4 a = ac[s4];
                    acc[4 * s4 + 0] += a.x * wv; acc[4 * s4 + 1] += a.y * wv;
                    if (s4 < 4) { acc[4 * s4 + 2] += a.z * wv; acc[4 * s4 + 3] += a.w * wv; } }
                w[j] = __builtin_nontemporal_load((const f32x4*)(Wn + (size_t)j * NMOD));
                if (j + 1 < 8) {
#pragma unroll
                    for (int s4 = 0; s4 < 5; ++s4) ac[s4] = an[s4]; }
                __builtin_amdgcn_sched_barrier(0);
            }
        }
    }
    float* mod = WSP(float, WS_MOD); const float* bada = inp(F, I_BADA);
#pragma unroll
    for (int p = 0; p < 2; ++p) {
        __syncthreads();
#pragma unroll
        for (int s9 = 0; s9 < 9; ++s9) *(LAS f32x4*)(red + (F.wave * 18 + half * 9 + s9) * 128 + c4) = acc[p * 9 + s9];
        __syncthreads();
        for (int i = F.tid; i < 18 * 128; i += 512) { const int r = i >> 7, c = i & 127; float v = 0.f;
#pragma unroll
            for (int w8 = 0; w8 < 8; ++w8) v += red[(w8 * 18 + r) * 128 + c];
            const int sq = (r < 9) ? p * 9 + r : 18 + p * 9 + (r - 9), col = cb * 128 + c;
            mod[(size_t)(l * NSEQ + sq) * NMOD + col] = v + bada[l * NMOD + col]; }
    }
    __syncthreads();
}

__device__ __forceinline__ void tr_load(const float* src, int Nsrc, int lane, float (&v)[32]) {
    unsigned off = (unsigned)((lane >> 5) * Nsrc + (lane & 31)) * 4u; const unsigned step = (unsigned)Nsrc * 8u;
#pragma unroll
    for (int i = 0; i < 32; ++i) { v[i] = __builtin_nontemporal_load((const float*)((const char*)src + off)); off += step; }
}
__device__ __forceinline__ void tr_store(void* dst, int f8, float scale, LAS float* scr, int lane, const float (&v)[32]) {
#pragma unroll
    for (int i = 0; i < 32; ++i) scr[(2 * i + (lane >> 5)) * 33 + (lane & 31)] = v[i];
    LDS_WAIT(); asm volatile("" ::: "memory");
    const int c = lane & 7;
#pragma unroll
    for (int j = 0; j < 4; ++j) { const int n = (lane >> 3) + 8 * j; const LAS float* s = scr + (8 * c) * 33 + n;
        if (f8) { v2u o; o.x = pk4_fp8(s[0 * 33] * scale, s[1 * 33] * scale, s[2 * 33] * scale, s[3 * 33] * scale); o.y = pk4_fp8(s[4 * 33] * scale, s[5 * 33] * scale, s[6 * 33] * scale, s[7 * 33] * scale);
            *(GAS v2u*)((unsigned char*)dst + (size_t)n * PB8 + 8 * c) = o; }
        else { v4u o; o.x = pg8::cvt_pk_bf16(s[0 * 33], s[1 * 33]); o.y = pg8::cvt_pk_bf16(s[2 * 33], s[3 * 33]); o.z = pg8::cvt_pk_bf16(s[4 * 33], s[5 * 33]); o.w = pg8::cvt_pk_bf16(s[6 * 33], s[7 * 33]);
            *(GAS v4u*)((bf16*)dst + (size_t)n * LDK + 8 * c) = o; } }
    LDS_WAIT(); asm volatile("" ::: "memory");
}
__host__ __device__ __forceinline__ int win_row(int c) {
    if (c < 4608) return c;
    if (c < 6656) { const int j = (c - 4608) >> 7, i = (c - 4608) & 127; return 4608 + 256 * j + i; }
    if (c < 8704) return 8704 + (c - 6656);
    if (c < 10752) { const int j = (c - 8704) >> 7, i = (c - 8704) & 127; return 4608 + 256 * j + 128 + i; }
    if (c < 14848) { const int j = (c - 10752) >> 7, i = (c - 10752) & 127; return 10752 + 256 * j + i; }
    { const int j = (c - 14848) >> 7, i = (c - 14848) & 127; return 10752 + 256 * j + 128 + i; }
}
constexpr int I_IN = 64 * 592, I_PA = 32 * 128, I_O = 64 * 128, I_LAYER = I_IN + 2 * I_PA + I_O, I_TR = 2 * I_LAYER, I_WS = 128, I_ALL = I_TR + I_WS;
static_assert(I_TR % 8 == 0 && I_WS % 8 == 0 && I_IN % 8 == 0, "chunks of 8 items never straddle the item kinds");
__device__ __forceinline__ void tr_desc(Frame& F, int it, const float*& src, int& Nsrc, void*& dst, void*& dst2, int& f8, float& scale) {
    const int l = it / I_LAYER; int r = it % I_LAYER; f8 = 0; scale = 1.f; dst2 = nullptr;
    if (r < I_IN) { const int kb = r / 592, nb = r % 592, wrow = win_row(32 * nb); Nsrc = NIN; f8 = 1; scale = SWI;
        src = inp(F, I_WIN) + (size_t)l * D * NIN + (size_t)(64 * kb) * NIN + 32 * nb; dst = WSP(unsigned char, WS_WIN8) + (size_t)l * NIN * PB8 + (size_t)wrow * PB8 + 64 * kb;
        if ((wrow >= 2048 && wrow < 2560) || (wrow >= 8704 && wrow < 10752)) { f8 = 2; dst2 = WSP(bf16, WS_WIN) + (size_t)l * NIN * LDK + (size_t)wrow * LDK + 64 * kb; }
        return; }
    r -= I_IN; Nsrc = D; f8 = 1; scale = SWP;
    if (r < I_PA) { const int kb = r / 128, nb = r % 128;
        src = inp(F, I_WPA) + (size_t)l * DA * D + (size_t)(64 * kb) * D + 32 * nb; dst = WSP(unsigned char, WS_WP) + (size_t)l * D * PB8 + (size_t)(32 * nb) * PB8 + 64 * kb; return; }
    r -= I_PA;
    if (r < I_PA) { const int kb = r / 128, nb = r % 128;
        src = inp(F, I_WPB) + (size_t)l * DSG * D + (size_t)(64 * kb) * D + 32 * nb; dst = WSP(unsigned char, WS_WP) + (size_t)l * D * PB8 + (size_t)(32 * nb) * PB8 + 2048 + 64 * kb; return; }
    r -= I_PA; scale = SWO;
    { const int kb = r / 128, nb = r % 128;
        src = inp(F, I_WO) + (size_t)l * D * D + (size_t)(64 * kb) * D + 32 * nb; dst = WSP(unsigned char, WS_WO) + (size_t)l * D * PB8 + (size_t)(32 * nb) * PB8 + 64 * kb; }
}
__device__ __forceinline__ void copy_chunk(Frame& F, int base, LAS float* scr) {
    if (base >= I_TR) {
        const float* sw = inp(F, I_SW); bf16* Wsb = WSP(bf16, WS_WSB);
        for (int it = base; it < base + 8; ++it) { const int e0 = (it - I_TR) * 2048 + F.lane * 4;
#pragma unroll
            for (int j = 0; j < 8; ++j) { const int e = e0 + j * 256; const f32x4 v = *(const f32x4*)(sw + e); const int s = e & 127, t = (e >> 7) & 127;
                v2u o; o.x = pk2(s <= t ? v.x : 0.f, s + 1 <= t ? v.y : 0.f); o.y = pk2(s + 2 <= t ? v.z : 0.f, s + 3 <= t ? v.w : 0.f);
                *(GAS v2u*)(Wsb + e) = o; } }
        return;
    }
    float va[32], vb[32]; const float* src; int ns; void *da, *db, *da2, *db2; int fa, fb; float sa, sb;
    tr_desc(F, base, src, ns, da, da2, fa, sa); tr_load(src, ns, F.lane, va);
#pragma unroll 1
    for (int j = 0; j < 8; j += 2) {
        tr_desc(F, base + j + 1, src, ns, db, db2, fb, sb); tr_load(src, ns, F.lane, vb);
        tr_store(da, fa != 0, sa, scr, F.lane, va); if (fa == 2) tr_store(da2, 0, 1.f, scr, F.lane, va);
        if (j + 2 < 8) { tr_desc(F, base + j + 2, src, ns, da, da2, fa, sa); tr_load(src, ns, F.lane, va); }
        tr_store(db, fb != 0, sb, scr, F.lane, vb); if (fb == 2) tr_store(db2, 0, 1.f, scr, F.lane, vb);
    }
}

__device__ __forceinline__ int pull8(gu32* q, int nchunks, int& s, int& left, int lane) {
    while (left > 0) { int k = 0; if (lane == 0) k = (int)__hip_atomic_fetch_add((unsigned*)(q + 64 * s), 1u, RLX_AGENT);
        const int c = 8 * __builtin_amdgcn_readfirstlane(k) + s; if (c < nchunks) return 8 * c;
        s = (s + 1) & 7; --left; }
    return -1; }
__device__ __forceinline__ void steal_copies(Frame& F, bool until_done, int q, int quota) {
    gu32* ctl = (gu32*)(F.ws + WS_CTL); LAS float* scr = (LAS float*)(F.lds + F.wave * 16384);
    gu32* head = ctl + (q == 1 ? CW_WORK1 : CW_WORK2); const int n = q == 1 ? I_IN : I_LAYER - I_IN, base = q == 1 ? I_LAYER : I_LAYER + I_IN;
    int sh = F.bx & 7, left = 8;
    for (int it = 0; it < quota; ++it) {
        if (until_done) { unsigned d = 0; if (F.lane == 0) d = __hip_atomic_load((unsigned*)(ctl + CW_DONE1), RLX_AGENT); if ((unsigned)__builtin_amdgcn_readfirstlane(d) >= (unsigned)Frame::G) break; }
        const int v = pull8(head, n / 8, sh, left, F.lane); if (v < 0) break;
        copy_chunk(F, base + v, scr);
    }
}

__device__ __forceinline__ void h_rows(Frame& F, const float* x, int row0, int nrows, int seq, int slice, int l) {
    const int col = slice * 1024 + F.lane * 4;
    const float* md = WSP(float, WS_MOD) + (size_t)(l * NSEQ + seq) * NMOD; bf16* Hb = WSP(bf16, WS_HB); unsigned char* Hb8 = WSP(unsigned char, WS_HB8);
    const bool wb = row0 >= MP || (row0 & 2047) >= 1792;
    f32x4 sh[4], sc[4];
#pragma unroll
    for (int j = 0; j < 4; ++j) { sh[j] = *(const f32x4*)(md + col + 256 * j); sc[j] = *(const f32x4*)(md + D + col + 256 * j) + 1.0f; }
    for (int r0 = 0; r0 < nrows; r0 += 4) {
        f32x4 xv[4][4];
#pragma unroll
        for (int rr = 0; rr < 4; ++rr)
#pragma unroll
            for (int j = 0; j < 4; ++j) xv[rr][j] = *(const f32x4*)(x + (size_t)(r0 + rr) * D + col + 256 * j);
#pragma unroll
        for (int rr = 0; rr < 4; ++rr) { const int r = r0 + rr;
#pragma unroll
            for (int j = 0; j < 4; ++j) { const f32x4 v = xv[rr][j] * sc[j] + sh[j];
                *(GAS unsigned*)(Hb8 + (size_t)(row0 + r) * PB8 + col + 256 * j) = pk4_fp8(v.x * SH8, v.y * SH8, v.z * SH8, v.w * SH8);
                if (wb) { v2u o; o.x = pk2(v.x, v.y); o.y = pk2(v.z, v.w); *(GAS v2u*)(Hb + (size_t)(row0 + r) * LDK + col + 256 * j) = o; } } }
    }
}

constexpr int G1_NBF = 18, G1_NF8W = 256 - G1_NBF, G1_UNITS = 33 * 74;
struct OrderF8 { int c;
    __device__ __forceinline__ bool next(int i, pg8::Unit& u) const {
        int L;
        if (i < 8) L = i * 256 + c;
        else { if (c >= G1_NF8W) return false; L = 2048 + (i - 8) * G1_NF8W + c; if (L >= G1_UNITS) return false; }
        pg8::StaticOrderC<MPAD, NIN>::map(L, u); return true; }
    __device__ __forceinline__ void a_ready(const pg8::Unit&) const {}
    __device__ __forceinline__ void done(const pg8::Unit&) const {} };
struct OrderBf { int c;
    __device__ __forceinline__ bool next(int i, pg8::Unit& u) const {
        const int j = c - G1_NF8W; if (i != 0 || j < 0) return false;
        if (j < 8) { u.pm = 8 * (j >> 1) + 7; u.pn = 8 + (j & 1); }
        else { const int jj = j - 8; u.pm = 32; u.pn = jj < 2 ? 8 + jj : 34 + (jj - 2); }
        return true; }
    __device__ __forceinline__ void a_ready(const pg8::Unit&) const {}
    __device__ __forceinline__ void done(const pg8::Unit&) const {} };

__host__ __device__ __forceinline__ bool is_bf16_unit(int pm, int pn) { return ((pn == 8 || pn == 9) && ((pm & 7) == 7 || pm == 32)) || (pm == 32 && pn >= 34 && pn < 42); }
template <bool F8> struct EpiInT {
    static constexpr bool PERM = true, MIDK = false;
    unsigned char* ws; float* outl;
    int l;
    __device__ __forceinline__ void mid(pg8::f32x4 (&)[2][2][4][2], const pg8::Unit&, int, int, int, int) const {}
    __device__ __forceinline__ void operator()(const pg8::f32x4 (&acc)[2][2][4][2], const pg8::Unit& u, int wr, int wc, int fr_, int fq_) const {
        if (F8 && is_bf16_unit(u.pm, u.pn)) return;
        constexpr float DS = F8 ? 1.0f / (SH8 * SWI) : 1.0f;
        const int ln_ = lane_now(), fr = ln_ & 15, fq = ln_ >> 4; (void)fr_; (void)fq_;
        const int row0 = u.pm * 256 + wr * 64 + fr, c8 = wc * 32 + 8 * fq, pn = u.pn;
        if (pn < 8 || (pn >= 10 && pn < 18) || (pn >= 34 && pn < 42)) {
            const int kind = pn < 8 ? 0 : (pn < 18 ? 1 : 2);
            unsigned char* base = kind == 0 ? (ws + WS_QB) + pn * 256 : (kind == 1 ? (ws + WS_ZA) + (pn - 10) * 256 : (ws + WS_VBB) + (pn - 34) * 256);
            const float osc = kind == 0 ? QSCALE * SQ8 : (kind == 1 ? SZA8 : SVB8);
            f32x2* vst = (f32x2*)(ws + WS_VST);
#pragma unroll
            for (int ai = 0; ai < 2; ++ai)
#pragma unroll
                for (int m = 0; m < 4; ++m) { const int row = row0 + ai * 128 + m * 16; unsigned char* rowp = base + (size_t)row * 2048 + c8; float s1 = 0.f, s2 = 0.f;
#pragma unroll
                    for (int bj = 0; bj < 2; ++bj) { f32x4 v0 = acc[ai][bj][m][0] * DS, v1 = acc[ai][bj][m][1] * DS;
                        if (kind == 1) { v0 = (f32x4){siluf_(v0.x), siluf_(v0.y), siluf_(v0.z), siluf_(v0.w)}; v1 = (f32x4){siluf_(v1.x), siluf_(v1.y), siluf_(v1.z), siluf_(v1.w)}; }
                        if (kind == 2) { s1 += (v0.x + v0.y) + (v0.z + v0.w) + (v1.x + v1.y) + (v1.z + v1.w);
                                         s2 += (v0.x * v0.x + v0.y * v0.y) + (v0.z * v0.z + v0.w * v0.w) + (v1.x * v1.x + v1.y * v1.y) + (v1.z * v1.z + v1.w * v1.w); }
                        if (!F8 && kind == 2) {
                            v4u w; w.x = pg8::cvt_pk_bf16(v0.x, v0.y); w.y = pg8::cvt_pk_bf16(v0.z, v0.w); w.z = pg8::cvt_pk_bf16(v1.x, v1.y); w.w = pg8::cvt_pk_bf16(v1.z, v1.w);
                            *(v4u*)((bf16*)(ws + WS_VBS) + (size_t)(row - MP) * 2048 + (pn - 34) * 256 + c8 + bj * 128) = w;
                        } else {
                            v0 = v0 * osc; v1 = v1 * osc;
                            v2u w; w.x = pk4_fp8(v0.x, v0.y, v0.z, v0.w); w.y = pk4_fp8(v1.x, v1.y, v1.z, v1.w);
                            *(v2u*)(rowp + bj * 128) = w; } }
                    if (kind == 2) { s1 = xadd<32>(xadd<16>(s1)); s2 = xadd<32>(xadd<16>(s2));
                        if (fq == 0) vst[(size_t)row * 32 + (pn - 34) * 4 + wc] = (f32x2){s1, s2}; }
                }
        } else if (pn < 10) {
            bf16* base = (bf16*)(ws + (pn == 8 ? WS_KB : WS_VB));
            float* ow = outl + (pn == 8 ? O_WK : O_WV) + (size_t)l * 131072; float* on = outl + (pn == 8 ? O_NK : O_NV) + (size_t)l * 32768;
#pragma unroll
            for (int ai = 0; ai < 2; ++ai)
#pragma unroll
                for (int m = 0; m < 4; ++m) { const int row = row0 + ai * 128 + m * 16; bf16* rowp = base + (size_t)row * 256 + c8;
                    const int rin = wr * 64 + m * 16 + fr;
                    float* fo = nullptr;
                    if (!F8) { if (u.pm < 32) { if ((u.pm & 7) == 7 && ai == 1) fo = ow + ((size_t)(u.pm >> 3) * 128 + rin) * 256; } else if (ai == 0) fo = on + (size_t)rin * 256; }
#pragma unroll
                    for (int bj = 0; bj < 2; ++bj) { const f32x4 v0 = acc[ai][bj][m][0] * DS, v1 = acc[ai][bj][m][1] * DS;
                        v4u w; w.x = pg8::cvt_pk_bf16(v0.x, v0.y); w.y = pg8::cvt_pk_bf16(v0.z, v0.w); w.z = pg8::cvt_pk_bf16(v1.x, v1.y); w.w = pg8::cvt_pk_bf16(v1.z, v1.w);
                        *(v4u*)(rowp + bj * 128) = w;
                        if (fo) { *(f32x4*)(fo + bj * 128 + c8) = v0; *(f32x4*)(fo + bj * 128 + c8 + 4) = v1; } }
                }
        } else if (pn < 34) {
            unsigned char* base = (ws + WS_UZ) + (pn - 18) * 128;
#pragma unroll
            for (int ai = 0; ai < 2; ++ai)
#pragma unroll
                for (int m = 0; m < 4; ++m) { const int row = row0 + ai * 128 + m * 16;
                    const f32x4 u0 = acc[ai][0][m][0] * DS, u1 = acc[ai][0][m][1] * DS, z0 = acc[ai][1][m][0] * DS, z1 = acc[ai][1][m][1] * DS;
                    v2u w; w.x = pk4_fp8(u0.x * siluf_(z0.x) * SUZ8, u0.y * siluf_(z0.y) * SUZ8, u0.z * siluf_(z0.z) * SUZ8, u0.w * siluf_(z0.w) * SUZ8);
                    w.y = pk4_fp8(u1.x * siluf_(z1.x) * SUZ8, u1.y * siluf_(z1.y) * SUZ8, u1.z * siluf_(z1.z) * SUZ8, u1.w * siluf_(z1.w) * SUZ8);
                    *(v2u*)(base + (size_t)row * 2048 + c8) = w; }
        } else {
            const int cb = (pn - 42) * 128 + c8; bf16* RR = (bf16*)(ws + WS_RR); unsigned char* SGB = ws + WS_SGB;
#pragma unroll
            for (int ai = 0; ai < 2; ++ai)
#pragma unroll
                for (int m = 0; m < 4; ++m) { const int row = row0 + ai * 128 + m * 16;
                    float ra[8], sb[8];
#pragma unroll
                    for (int n = 0; n < 2; ++n)
#pragma unroll
                        for (int e = 0; e < 4; ++e) {
                            const float xa = __builtin_amdgcn_fmed3f(acc[ai][0][m][n][e] * (-DS * LOG2E), -60.0f, 60.0f), xb = __builtin_amdgcn_fmed3f(acc[ai][1][m][n][e] * (-DS * LOG2E), -60.0f, 60.0f);
                            const float pa = 1.0f + __builtin_amdgcn_exp2f(xa), pb = 1.0f + __builtin_amdgcn_exp2f(xb), r = __builtin_amdgcn_rcpf(pa * pb);
                            sb[n * 4 + e] = fmaxf(r * pa, 1.52587890625e-05f);
                            ra[n * 4 + e] = fminf(pb, 65536.0f) * (r * pb); }
                    v4u w; w.x = pg8::cvt_pk_bf16(ra[0], ra[1]); w.y = pg8::cvt_pk_bf16(ra[2], ra[3]); w.z = pg8::cvt_pk_bf16(ra[4], ra[5]); w.w = pg8::cvt_pk_bf16(ra[6], ra[7]);
                    *(v4u*)(RR + (size_t)row * D + cb) = w;
                    v2u x; x.x = pk4_fp8(sb[0] * SG8, sb[1] * SG8, sb[2] * SG8, sb[3] * SG8); x.y = pk4_fp8(sb[4] * SG8, sb[5] * SG8, sb[6] * SG8, sb[7] * SG8);
                    *(v2u*)(SGB + (size_t)row * D + cb) = x; }
        }
    }
};

struct EpiMerge {
    static constexpr bool PERM = true, MIDK = true;
    const bf16* RR; const unsigned char* SGB; unsigned char* MG;
    __device__ __forceinline__ void mid(pg8::f32x4 (&acc)[2][2][4][2], const pg8::Unit& u, int wr, int wc, int, int) const {
        const int ln_ = lane_now(), fr = ln_ & 15, fq = ln_ >> 4;
        unsigned off0 = ((unsigned)(u.pm * 256 + wr * 64 + fr) * D + (unsigned)(u.pn * 256 + wc * 32 + 8 * fq)) * 2u;
        asm volatile("" : "+v"(off0));
        v4u w[2][4][2];
#pragma unroll
        for (int ai = 0; ai < 2; ++ai)
#pragma unroll
            for (int m = 0; m < 4; ++m)
#pragma unroll
                for (int bj = 0; bj < 2; ++bj) w[ai][m][bj] = *(const v4u*)((const char*)RR + off0 + (unsigned)((ai * 128 + m * 16) * D * 2) + bj * 256);
#pragma unroll
        for (int ai = 0; ai < 2; ++ai) {
#pragma unroll
            for (int m = 0; m < 4; ++m)
#pragma unroll
                for (int bj = 0; bj < 2; ++bj) { const v4u x = w[ai][m][bj];
                    acc[ai][bj][m][0] = acc[ai][bj][m][0] * ((f32x4){bflo(x.x), bfhi(x.x), bflo(x.y), bfhi(x.y)} * (SB8 / SA8));
                    acc[ai][bj][m][1] = acc[ai][bj][m][1] * ((f32x4){bflo(x.z), bfhi(x.z), bflo(x.w), bfhi(x.w)} * (SB8 / SA8)); }
            asm volatile("" ::: "memory");
        }
    }
    __device__ __forceinline__ void operator()(const pg8::f32x4 (&acc)[2][2][4][2], const pg8::Unit& u, int wr, int wc, int, int) const {
        const int ln_ = lane_now(), fr = ln_ & 15, fq = ln_ >> 4;
        unsigned off0 = (unsigned)(u.pm * 256 + wr * 64 + fr) * D + (unsigned)(u.pn * 256 + wc * 32 + 8 * fq);
        asm volatile("" : "+v"(off0));
        const unsigned offm = (unsigned)(u.pm * 256 + wr * 64 + fr) * (unsigned)PB8 + (unsigned)(u.pn * 256 + wc * 32 + 8 * fq);
        v2u sv[2][4][2];
#pragma unroll
        for (int ai = 0; ai < 2; ++ai)
#pragma unroll
            for (int m = 0; m < 4; ++m)
#pragma unroll
                for (int bj = 0; bj < 2; ++bj) sv[ai][m][bj] = *(const v2u*)(SGB + off0 + (unsigned)((ai * 128 + m * 16) * D) + bj * 128);
#pragma unroll
        for (int ai = 0; ai < 2; ++ai) {
#pragma unroll
            for (int m = 0; m < 4; ++m)
#pragma unroll
                for (int bj = 0; bj < 2; ++bj) { const v2u s = sv[ai][m][bj];
                    const f32x4 v0 = acc[ai][bj][m][0] * (f8x4(s.x) * (SMG / (SB8 * SWP * SG8)));
                    const f32x4 v1 = acc[ai][bj][m][1] * (f8x4(s.y) * (SMG / (SB8 * SWP * SG8)));
                    v2u w; w.x = pk4_fp8(v0.x, v0.y, v0.z, v0.w); w.y = pk4_fp8(v1.x, v1.y, v1.z, v1.w);
                    *(v2u*)(MG + offm + (unsigned)((ai * 128 + m * 16) * PB8) + bj * 128) = w; }
            asm volatile("" ::: "memory");
        }
    }
};

template <int L> struct EpiOutT {
    static constexpr bool PERM = false, MIDK = false;
    const float* xp; const bf16* rb0; const f32x2* st0; const float *g0, *b0;
    const float* gate;
    bf16* rb; f32x2* rst;
    __device__ __forceinline__ void mid(pg8::f32x4 (&)[2][2][4][2], const pg8::Unit&, int, int, int, int) const {}
    __device__ __forceinline__ void operator()(const pg8::f32x4 (&acc)[2][2][4][2], const pg8::Unit& u, int wr, int wc, int fr_, int fq_) const {
        const int ln_ = lane_now(), fr = ln_ & 15, fq = ln_ >> 4; (void)fr_; (void)fq_;
        const unsigned col0 = (unsigned)(u.pn * 256 + wc * 32 + 4 * fq);
        const unsigned rowb = (unsigned)(u.pm * 256 + wr * 64 + fr);
        const unsigned eo0 = rowb * D + col0;
        const char* gb = (const char*)(gate + (size_t)(u.pm >> 3) * NMOD) + col0 * 4u;
        f32x4 gv[2][2], g0v[2][2], b0v[2][2];
#pragma unroll
        for (int bj = 0; bj < 2; ++bj)
#pragma unroll
            for (int n = 0; n < 2; ++n) { gv[bj][n] = *(const f32x4*)(gb + (bj * 128 + n * 16) * 4);
                if (L == 1) { g0v[bj][n] = *(const f32x4*)((const char*)g0 + (col0 + bj * 128 + n * 16) * 4u); b0v[bj][n] = *(const f32x4*)((const char*)b0 + (col0 + bj * 128 + n * 16) * 4u); } }
#pragma unroll
        for (int ap = 0; ap < 4; ++ap) { const int ai = ap >> 1, m0 = (ap & 1) * 2;
            f32x4 xv[2][2][2]; v2u xb[2][2][2]; f32x2 st[2];
#pragma unroll
            for (int mm = 0; mm < 2; ++mm) { const unsigned eo = eo0 + (unsigned)((ai * 128 + (m0 + mm) * 16) * D);
                if (L == 1) st[mm] = st0[rowb + (unsigned)(ai * 128 + (m0 + mm) * 16)];
#pragma unroll
                for (int bj = 0; bj < 2; ++bj)
#pragma unroll
                    for (int n = 0; n < 2; ++n) {
                        if (L == 0) xv[mm][bj][n] = *(const f32x4*)((const char*)xp + (eo + bj * 128 + n * 16) * 4u);
                        else xb[mm][bj][n] = *(const v2u*)((const char*)rb0 + (eo + bj * 128 + n * 16) * 2u); } }
#pragma unroll
            for (int mm = 0; mm < 2; ++mm) { const int m = m0 + mm; const unsigned eo = eo0 + (unsigned)((ai * 128 + m * 16) * D); const unsigned row = rowb + (unsigned)(ai * 128 + m * 16);
                float s1 = 0.f, s2 = 0.f;
#pragma unroll
                for (int bj = 0; bj < 2; ++bj)
#pragma unroll
                    for (int n = 0; n < 2; ++n) { f32x4 x;
                        if (L == 0) x = xv[mm][bj][n];
                        else { const v2u w = xb[mm][bj][n]; x = ((f32x4){bflo(w.x), bfhi(w.x), bflo(w.y), bfhi(w.y)} - st[mm].x) * st[mm].y * g0v[bj][n] + b0v[bj][n]; }
                        const f32x4 r = x * ALPHA + gv[bj][n] * (acc[ai][bj][m][n] * (1.0f / (SMG * SWO)));
                        v2u o; o.x = pg8::cvt_pk_bf16(r.x, r.y); o.y = pg8::cvt_pk_bf16(r.z, r.w);
                        *(v2u*)((char*)rb + (eo + bj * 128 + n * 16) * 2u) = o;
                        s1 += (r.x + r.y) + (r.z + r.w); s2 += (r.x * r.x + r.y * r.y) + (r.z * r.z + r.w * r.w); }
                s1 = xadd<32>(xadd<16>(s1)); s2 = xadd<32>(xadd<16>(s2));
                if (fq == 0) rst[(size_t)row * 64 + u.pn * 4 + wc] = (f32x2){s1, s2};
            }
            asm volatile("" ::: "memory");
        }
    }
};

typedef short bf16x8_t __attribute__((ext_vector_type(8)));
typedef short s16x4_t __attribute__((ext_vector_type(4)));
typedef float f32x16 __attribute__((ext_vector_type(16)));
__device__ __forceinline__ s16x4_t vtr(const LAS char* p) { return __builtin_bit_cast(s16x4_t, __builtin_amdgcn_ds_read_tr16_b64_v4i16((LAS s16x4_t*)p)); }
__device__ __forceinline__ bf16x8_t cat8(s16x4_t a, s16x4_t b) { return (bf16x8_t){a[0], a[1], a[2], a[3], b[0], b[1], b[2], b[3]}; }
#define MFMA32(a, b, c) __builtin_amdgcn_mfma_f32_32x32x16_bf16((a), (b), (c), 0, 0, 0)

__device__ __forceinline__ void attn_prompt_unit(Frame& F, int l, int unit) {
    const int kv = unit & 3, n = (unit >> 2) & 15, b = unit >> 6, tid = F.tid, lane = F.lane;
    LAS char* Kl = (LAS char*)F.lds; LAS char* Vl = Kl + 32768;
    const bf16* Kb = WSP(bf16, WS_KB); const bf16* Vb = WSP(bf16, WS_VB); const unsigned char* Qb = WSP(unsigned char, WS_QB); const unsigned char* Za = WSP(unsigned char, WS_ZA); unsigned char* AB = WSP(unsigned char, WS_AB);
    const int rowq0 = b * SEQ + n * 128, rowk0 = rowq0 - 128;
#pragma unroll
    for (int i = 0; i < 4; ++i) { const int idx = tid + 512 * i;
        { const int chunk = idx >> 8, key = idx & 255; v4u v = (v4u){0u, 0u, 0u, 0u};
          if (n > 0 || key >= 128) v = *(const v4u*)(Kb + (size_t)(rowk0 + key) * 256 + kv * 64 + chunk * 8);
          *(LAS v4u*)(Kl + chunk * 4096 + key * 16) = v; }
        { const int dh = idx >> 10, key = (idx >> 2) & 255, c4 = idx & 3; v4u v = (v4u){0u, 0u, 0u, 0u};
          if (n > 0 || key >= 128) v = *(const v4u*)(Vb + (size_t)(rowk0 + key) * 256 + kv * 64 + dh * 32 + c4 * 8);
          *(LAS v4u*)(Vl + dh * 16384 + key * 64 + c4 * 16) = v; } }
    const int h = lane >> 5, r32 = lane & 31, head = kv * 8 + F.wave;
    v2u qn[4];
#pragma unroll
    for (int ks = 0; ks < 4; ++ks) qn[ks] = *(const v2u*)(Qb + (size_t)(rowq0 + r32) * 2048 + head * 64 + 16 * ks + 8 * h);
    __syncthreads();
    const float sink2 = inp(F, I_SINK)[l * 32 + head] * LOG2E;
    const LAS char* kbase = Kl + h * 4096 + r32 * 16;
    const LAS char* vbase = Vl + (4 * h + ((lane & 15) >> 2)) * 64 + ((lane >> 4) & 1) * 32 + (lane & 3) * 8;
#pragma unroll 1
    for (int c = 0; c < 4; ++c) {
        const size_t qrow = (size_t)(rowq0 + 32 * c + r32);
        bf16x8_t qf[4];
#pragma unroll
        for (int ks = 0; ks < 4; ++ks) { const f32x4 a = f8x4(qn[ks].x) * (1.0f / SQ8), b2 = f8x4(qn[ks].y) * (1.0f / SQ8);
            v4u w; w.x = pg8::cvt_pk_bf16(a.x, a.y); w.y = pg8::cvt_pk_bf16(a.z, a.w); w.z = pg8::cvt_pk_bf16(b2.x, b2.y); w.w = pg8::cvt_pk_bf16(b2.z, b2.w);
            qf[ks] = __builtin_bit_cast(bf16x8_t, w); }
        { const size_t qnext = qrow + (c + 1 < 4 ? 32 : 0);
#pragma unroll
            for (int ks = 0; ks < 4; ++ks) qn[ks] = *(const v2u*)(Qb + qnext * 2048 + head * 64 + 16 * ks + 8 * h); }
        unsigned zv[2][4];
#pragma unroll
        for (int dt = 0; dt < 2; ++dt)
#pragma unroll
            for (int g4 = 0; g4 < 4; ++g4) zv[dt][g4] = *(const unsigned*)(Za + qrow * 2048 + head * 64 + 32 * dt + 8 * g4 + 4 * h);
        f32x16 S[5];
#pragma unroll
        for (int k5 = 0; k5 < 5; ++k5)
#pragma unroll
            for (int r = 0; r < 16; ++r) S[k5][r] = 0.f;
        {
          bf16x8_t kf[2][5];
#pragma unroll
          for (int k5 = 0; k5 < 5; ++k5) kf[0][k5] = *(const LAS bf16x8_t*)(kbase + (32 * (c + k5)) * 16);
#pragma unroll
          for (int ks = 0; ks < 4; ++ks) {
              if (ks + 1 < 4) {
#pragma unroll
                  for (int k5 = 0; k5 < 5; ++k5) kf[(ks + 1) & 1][k5] = *(const LAS bf16x8_t*)(kbase + (2 * (ks + 1)) * 4096 + (32 * (c + k5)) * 16); }
              __builtin_amdgcn_sched_barrier(0);
#pragma unroll
              for (int k5 = 0; k5 < 5; ++k5) S[k5] = MFMA32(kf[ks & 1][k5], qf[ks], S[k5]);
              __builtin_amdgcn_sched_barrier(0);
          } }
        float mx = sink2;
#pragma unroll
        for (int k5 = 0; k5 < 5; ++k5) { const bool dead = (n == 0) && (c + k5 < 4);
            float bm = -INFINITY;
#pragma unroll
            for (int r = 0; r < 16; ++r) { const int kk = (r & 3) + 8 * (r >> 2) + 4 * h; float v = S[k5][r];
                if (k5 == 0) v = (kk > r32) ? v : -INFINITY;
                if (k5 == 4) v = (kk <= r32) ? v : -INFINITY;
                S[k5][r] = v; bm = fmaxf(bm, v); }
            mx = fmaxf(mx, dead ? -INFINITY : bm); }
        mx = xmax<32>(mx);
        float ls = 0.f;
#pragma unroll
        for (int k5 = 0; k5 < 5; ++k5) { const float off = ((n == 0) && (c + k5 < 4)) ? INFINITY : mx;
#pragma unroll
            for (int r = 0; r < 16; ++r) { const float p = __builtin_amdgcn_exp2f(S[k5][r] - off); S[k5][r] = p; ls += p; } }
        ls = xadd<32>(ls); ls += __builtin_amdgcn_exp2f(sink2 - mx);
        f32x16 O[2];
#pragma unroll
        for (int r = 0; r < 16; ++r) { O[0][r] = 0.f; O[1][r] = 0.f; }
        {
          s16x4_t vq[2][2][2];
          const LAS char* vp0 = vbase + (32 * c) * 64;
#pragma unroll
          for (int dt = 0; dt < 2; ++dt) { vq[0][dt][0] = vtr(vp0 + dt * 16384); vq[0][dt][1] = vtr(vp0 + dt * 16384 + 512); }
#pragma unroll
          for (int j = 0; j < 10; ++j) { const int k5 = j >> 1, s = j & 1;
              if (j + 1 < 10) { const LAS char* vp = vp0 + (16 * (j + 1)) * 64;
#pragma unroll
                  for (int dt = 0; dt < 2; ++dt) { vq[(j + 1) & 1][dt][0] = vtr(vp + dt * 16384); vq[(j + 1) & 1][dt][1] = vtr(vp + dt * 16384 + 512); } }
              v4u pw; pw.x = pg8::cvt_pk_bf16(S[k5][8 * s + 0], S[k5][8 * s + 1]); pw.y = pg8::cvt_pk_bf16(S[k5][8 * s + 2], S[k5][8 * s + 3]);
              pw.z = pg8::cvt_pk_bf16(S[k5][8 * s + 4], S[k5][8 * s + 5]); pw.w = pg8::cvt_pk_bf16(S[k5][8 * s + 6], S[k5][8 * s + 7]);
              const bf16x8_t pf = __builtin_bit_cast(bf16x8_t, pw);
              __builtin_amdgcn_sched_barrier(0);
#pragma unroll
              for (int dt = 0; dt < 2; ++dt) O[dt] = MFMA32(cat8(vq[j & 1][dt][0], vq[j & 1][dt][1]), pf, O[dt]);
              __builtin_amdgcn_sched_barrier(0);
          } }
        const float inv = SA8 / (SZA8 * ls);
#pragma unroll
        for (int dt = 0; dt < 2; ++dt)
#pragma unroll
            for (int g4 = 0; g4 < 4; ++g4) { const int d0 = head * 64 + 32 * dt + 8 * g4 + 4 * h;
                const f32x4 z = f8x4(zv[dt][g4]);
                *(unsigned*)(AB + qrow * PB8 + d0) = pk4_fp8(O[dt][4 * g4 + 0] * inv * z.x, O[dt][4 * g4 + 1] * inv * z.y, O[dt][4 * g4 + 2] * inv * z.z, O[dt][4 * g4 + 3] * inv * z.w); }
    }
    __syncthreads();
}
__device__ __forceinline__ void attn_sample_unit(Frame& F, int l, int unit) {
    const int kv = unit & 3, b = unit >> 2, h = kv * 8 + F.wave, lane = F.lane, tid = F.tid;
    LAS float* Kf = (LAS float*)F.lds;
    LAS float* Vf = Kf + 8704;
    LAS float* qs = Kf + 17408 + F.wave * 1024;
    LAS float* ps = qs + 256;
    const unsigned char* Qb = WSP(unsigned char, WS_QB); const unsigned char* Za = WSP(unsigned char, WS_ZA); unsigned char* AB = WSP(unsigned char, WS_AB);
    const int row0 = MP + b * 4;
    const float* ck = inp(F, I_CK) + ((size_t)(l * 32 + b) * 128) * 256 + kv * 64;
    const float* cv = inp(F, I_CV) + ((size_t)(l * 32 + b) * 128) * 256 + kv * 64;
    const float* nk = F.out + O_NK + (size_t)(l * 128 + b * 4) * 256 + kv * 64;
    const float* nv = F.out + O_NV + (size_t)(l * 128 + b * 4) * 256 + kv * 64;
    unsigned char zq[4];
#pragma unroll
    for (int t = 0; t < 4; ++t) zq[t] = Za[(size_t)(row0 + t) * 2048 + h * 64 + lane];
    { f32x4 kx[5], vx[5]; unsigned char qv[4];
#pragma unroll
      for (int j = 0; j < 5; ++j) { const int i = tid + 512 * j, ic = i < 132 * 16 ? i : 132 * 16 - 1, key = ic >> 4, d4 = (ic & 15) * 4;
        kx[j] = *(const f32x4*)((key < 128 ? ck + (size_t)key * 256 : nk + (size_t)(key - 128) * 256) + d4);
        vx[j] = *(const f32x4*)((key < 128 ? cv + (size_t)key * 256 : nv + (size_t)(key - 128) * 256) + d4); }
#pragma unroll
      for (int t = 0; t < 4; ++t) qv[t] = Qb[(size_t)(row0 + t) * 2048 + h * 64 + lane];
#pragma unroll
      for (int j = 0; j < 5; ++j) { const int i = tid + 512 * j, key = i >> 4, d4 = (i & 15) * 4;
        if (i < 132 * 16) { LAS float* kd = Kf + key * 65 + d4; kd[0] = kx[j].x; kd[1] = kx[j].y; kd[2] = kx[j].z; kd[3] = kx[j].w;
            *(LAS f32x4*)(Vf + key * 64 + d4) = vx[j]; } }
#pragma unroll
      for (int t = 0; t < 4; ++t) qs[t * 64 + lane] = f8x1(qv[t]) * (1.0f / SQ8); }
    __syncthreads();
    const float sink2 = inp(F, I_SINK)[l * 32 + h] * LOG2E;
    float sc[3][4];
#pragma unroll
    for (int ps_ = 0; ps_ < 3; ++ps_) {
        const int key = ps_ * 64 + lane; const bool inr = key < 132; const LAS float* kr = Kf + (inr ? key : 0) * 65;
        float s[4] = {0.f, 0.f, 0.f, 0.f};
#pragma unroll 4
        for (int d4 = 0; d4 < 16; ++d4) { const float k0 = kr[d4 * 4], k1 = kr[d4 * 4 + 1], k2 = kr[d4 * 4 + 2], k3 = kr[d4 * 4 + 3];
#pragma unroll
            for (int t = 0; t < 4; ++t) { const f32x4 qx = *(const LAS f32x4*)(qs + t * 64 + d4 * 4); s[t] += (qx.x * k0 + qx.y * k1) + (qx.z * k2 + qx.w * k3); } }
#pragma unroll
        for (int t = 0; t < 4; ++t) { const bool ok = inr && (key < 128 ? key > t : (key - 128) <= t); sc[ps_][t] = ok ? s[t] : -INFINITY; }
    }
#pragma unroll
    for (int t = 0; t < 4; ++t) {
        float mx = fmaxf(fmaxf(sc[0][t], sc[1][t]), fmaxf(sc[2][t], sink2));
        mx = xmax_wave(mx);
        float p0 = __builtin_amdgcn_exp2f(sc[0][t] - mx), p1 = __builtin_amdgcn_exp2f(sc[1][t] - mx), p2 = __builtin_amdgcn_exp2f(sc[2][t] - mx);
        float sum = p0 + p1 + p2;
        sum = xadd_wave(sum);
        const float inv = 1.0f / (sum + __builtin_amdgcn_exp2f(sink2 - mx));
        ps[t * 136 + lane] = p0 * inv; ps[t * 136 + 64 + lane] = p1 * inv; if (lane < 8) ps[t * 136 + 128 + lane] = p2 * inv;
    }
    LDS_WAIT(); asm volatile("" ::: "memory");
    float o[4] = {0.f, 0.f, 0.f, 0.f};
#pragma unroll 4
    for (int key = 0; key < 132; ++key) { const float v = Vf[key * 64 + lane];
#pragma unroll
        for (int t = 0; t < 4; ++t) o[t] += ps[t * 136 + key] * v; }
#pragma unroll
    for (int t = 0; t < 4; ++t) { const size_t row = (size_t)(row0 + t); const float z = f8x1(zq[t]) * (1.0f / SZA8);
        AB[row * PB8 + h * 64 + lane] = (unsigned char)(pk4_fp8(o[t] * z * SA8, 0.f, 0.f, 0.f) & 0xffu); }
    __syncthreads();
}
__device__ __forceinline__ void sgu_prompt_unit(Frame& F, int l, int unit, int par) {
    const int g = unit & 7, n = (unit >> 3) & 15, b = unit >> 7, tid = F.tid, lane = F.lane, w = F.wave;
    LAS f32x2* rs = (LAS f32x2*)(F.lds + 65536) + par * 128;
    LAS char* Lw = (LAS char*)F.lds + w * 8192;
    const f32x2* vst = WSP(f32x2, WS_VST); const unsigned char* Vbb = WSP(unsigned char, WS_VBB); const unsigned char* UZ = WSP(unsigned char, WS_UZ); unsigned char* AB = WSP(unsigned char, WS_AB); const bf16* Wsb = WSP(bf16, WS_WSB);
    const int row0 = b * SEQ + n * 128, colw = g * 256 + 32 * w, h = lane >> 5, r32 = lane & 31, ch = lane & 3;
    f32x2 pst[8];
    { const int row = tid >> 2, part = tid & 3;
#pragma unroll
      for (int k = 0; k < 8; ++k) pst[k] = vst[(size_t)(row0 + row) * 32 + part * 8 + k]; }
    v2u xv[8];
#pragma unroll
    for (int i = 0; i < 8; ++i) xv[i] = *(const v2u*)(Vbb + (size_t)(row0 + (lane >> 2) + 16 * i) * 2048 + colw + ch * 8);
    unsigned uzv[4][4];
#pragma unroll
    for (int tb = 0; tb < 4; ++tb)
#pragma unroll
        for (int g4 = 0; g4 < 4; ++g4) uzv[tb][g4] = *(const unsigned*)(UZ + (size_t)(row0 + 32 * tb + r32) * 2048 + colw + 8 * g4 + 4 * h);
    const float* sg = inp(F, I_SG) + l * 2048 + colw + ch * 8; const float* sb = inp(F, I_SB) + l * 2048 + colw + ch * 8;
    const f32x4 g0 = *(const f32x4*)sg, g1 = *(const f32x4*)(sg + 4), b0 = *(const f32x4*)sb, b1 = *(const f32x4*)(sb + 4);
    const float* bs = inp(F, I_SBS) + (size_t)(l * 8 + g) * 128;
    float bst[4];
#pragma unroll
    for (int tb = 0; tb < 4; ++tb) bst[tb] = bs[32 * tb + r32];
    const bf16* Wg = Wsb + (size_t)(l * 8 + g) * 16384 + 8 * h;
    bf16x8_t bfr[20];
#pragma unroll
    for (int tb = 0; tb < 4; ++tb)
#pragma unroll
        for (int ks = 0; ks < 2 * tb + 2; ++ks) bfr[tb * (tb + 1) + ks] = *(const bf16x8_t*)(Wg + (32 * tb + r32) * 128 + 16 * ks);
    { const int row = tid >> 2, part = tid & 3; float s1 = 0.f, s2 = 0.f;
#pragma unroll
      for (int k = 0; k < 8; ++k) { s1 += pst[k].x; s2 += pst[k].y; }
      s1 = xadd<2>(xadd<1>(s1)); s2 = xadd<2>(xadd<1>(s2));
      const float mean = s1 * (1.0f / 2048.0f), var = s2 * (1.0f / 2048.0f) - mean * mean;
      if (part == 0) rs[row] = (f32x2){mean, 1.0f / sqrtf(var + LN_EPS)}; }
    __syncthreads();
    f32x2 stv[8];
#pragma unroll
    for (int i = 0; i < 8; ++i) stv[i] = rs[(lane >> 2) + 16 * i];
#pragma unroll
    for (int i = 0; i < 8; ++i) { const int sp = (lane >> 2) + 16 * i; const v2u x = xv[i]; const f32x2 st = stv[i];
        const f32x4 v0 = (f8x4(x.x) * (1.0f / SVB8) - st.x) * st.y * g0 + b0;
        const f32x4 v1 = (f8x4(x.y) * (1.0f / SVB8) - st.x) * st.y * g1 + b1;
        v4u o; o.x = pg8::cvt_pk_bf16(v0.x, v0.y); o.y = pg8::cvt_pk_bf16(v0.z, v0.w); o.z = pg8::cvt_pk_bf16(v1.x, v1.y); o.w = pg8::cvt_pk_bf16(v1.z, v1.w);
        *(LAS v4u*)(Lw + sp * 64 + ch * 16) = o; }
    LDS_WAIT(); asm volatile("" ::: "memory");
    bf16x8_t af[8];
    { const LAS char* ap = Lw + (8 * h + ((lane & 15) >> 2)) * 64 + ((lane >> 4) & 1) * 32 + (lane & 3) * 8;
#pragma unroll
      for (int ks = 0; ks < 8; ++ks) af[ks] = cat8(vtr(ap + ks * 1024), vtr(ap + ks * 1024 + 256)); }
#pragma unroll
    for (int tb = 0; tb < 4; ++tb) { const int t = 32 * tb + r32; f32x16 a;
#pragma unroll
        for (int r = 0; r < 16; ++r) a[r] = 0.f;
#pragma unroll
        for (int ks = 0; ks < 2 * tb + 2; ++ks) a = MFMA32(af[ks], bfr[tb * (tb + 1) + ks], a);
        const size_t row = (size_t)(row0 + t);
#pragma unroll
        for (int g4 = 0; g4 < 4; ++g4) { const int c0 = colw + 8 * g4 + 4 * h;
            const f32x4 uz = f8x4(uzv[tb][g4]) * (SB8 / SUZ8);
            *(unsigned*)(AB + row * PB8 + 2048 + c0) = pk4_fp8(uz.x * (a[4 * g4 + 0] + bst[tb]), uz.y * (a[4 * g4 + 1] + bst[tb]), uz.z * (a[4 * g4 + 2] + bst[tb]), uz.w * (a[4 * g4 + 3] + bst[tb])); }
    }
    LDS_WAIT(); asm volatile("" ::: "memory");
}
__device__ __forceinline__ void sgu_sample_unit(Frame& F, int l, int b) {
    const int tid = F.tid, c0 = tid * 4, g = c0 >> 8, row0 = MP + b * 4;
    LAS f32x2* rs = (LAS f32x2*)(F.lds);
    const f32x2* vst = WSP(f32x2, WS_VST); const unsigned char* UZ = WSP(unsigned char, WS_UZ); unsigned char* AB = WSP(unsigned char, WS_AB);
    const bf16* Vbs = WSP(bf16, WS_VBS);
    if (tid < 128) { const int row = tid >> 5, k = tid & 31; const f32x2 p = vst[(size_t)(row0 + row) * 32 + k]; float s1 = p.x, s2 = p.y;
        s1 = xadd_32(s1); s2 = xadd_32(s2);
        const float mean = s1 * (1.0f / 2048.0f), var = s2 * (1.0f / 2048.0f) - mean * mean;
        if (k == 0) rs[row] = (f32x2){mean, 1.0f / sqrtf(var + LN_EPS)}; }
    __syncthreads();
    const f32x4 gn = *(const f32x4*)(inp(F, I_SG) + l * 2048 + c0), bi = *(const f32x4*)(inp(F, I_SB) + l * 2048 + c0);
    f32x4 ln[4];
#pragma unroll
    for (int t = 0; t < 4; ++t) { const v2u w = *(const v2u*)(Vbs + (size_t)(b * 4 + t) * 2048 + c0); const f32x2 st = rs[t];
        ln[t] = ((f32x4){bflo(w.x), bfhi(w.x), bflo(w.y), bfhi(w.y)} - st.x) * st.y * gn + bi;
        *(f32x4*)(F.out + O_SV + ((size_t)(l * 32 + b) * 4 + t) * 2048 + c0) = ln[t]; }
    const float* Wg = inp(F, I_SW) + (size_t)(l * 8 + g) * 16384; const float* bs = inp(F, I_SBS) + (size_t)(l * 8 + g) * 128;
#pragma unroll
    for (int t = 0; t < 4; ++t) { f32x4 a = (f32x4){bs[t], bs[t], bs[t], bs[t]};
#pragma unroll
        for (int s = 0; s <= t; ++s) a += Wg[t * 128 + s] * ln[s];
        const f32x4 uz = f8x4(*(const unsigned*)(UZ + (size_t)(row0 + t) * 2048 + c0)) * (SB8 / SUZ8);
        *(unsigned*)(AB + (size_t)(row0 + t) * PB8 + 2048 + c0) = pk4_fp8(uz.x * a.x, uz.y * a.y, uz.z * a.z, uz.w * a.w); }
    __syncthreads();
}

template <int MODE> __device__ __forceinline__ void skinny_gemm(Frame& F, int l, int unit) {
    const int lane = F.lane, w = F.wave, r16 = lane & 15, kq = lane >> 4, rb = w & 1, cb = w >> 1;
    const int rin = 32 * (unit & 3) + 16 * rb + r16, row = MP + rin, n0 = 64 * (unit >> 2), col = n0 + 16 * cb + 4 * kq;
    LAS char* R0 = (LAS char*)F.lds;
    const int lr = lane >> 5, lc = lane & 31;
    const char* Ag[2]; const char* Bg[4];
#pragma unroll
    for (int i = 0; i < 2; ++i) { const int r = 2 * (2 * w + i) + lr; Ag[i] = (const char*)(MODE == 0 ? WSP(unsigned char, WS_AB) : WSP(unsigned char, WS_MG)) + (size_t)(MP + 32 * (unit & 3) + r) * PB8 + ((lc ^ (r & 15)) & 31) * 16; }
#pragma unroll
    for (int i = 0; i < 4; ++i) { const int r = 2 * (4 * w + i) + lr; Bg[i] = (const char*)(MODE == 0 ? WSP(unsigned char, WS_WP) : WSP(unsigned char, WS_WO)) + (size_t)l * D * PB8 + (size_t)(n0 + r) * PB8 + ((lc ^ (r & 15)) & 31) * 16; }
#define SK_STAGE(blk) do { LAS char* Rd = R0 + ((blk) % 3) * 49152; \
        _Pragma("unroll") for (int i = 0; i < 2; ++i) __builtin_amdgcn_global_load_lds((const unsigned*)(Ag[i] + (blk) * 512), (LAS unsigned*)(Rd + (2 * w + i) * 1024), 16, 0, 0); \
        _Pragma("unroll") for (int i = 0; i < 4; ++i) __builtin_amdgcn_global_load_lds((const unsigned*)(Bg[i] + (blk) * 512), (LAS unsigned*)(Rd + 16384 + (4 * w + i) * 1024), 16, 0, 0); } while (0)
    SK_STAGE(0); SK_STAGE(1);
    f32x4 acc = (f32x4){0.f, 0.f, 0.f, 0.f};
#pragma unroll 1
    for (int blk = 0; blk < 8; ++blk) {
        if (blk + 1 < 8) asm volatile("s_waitcnt vmcnt(6)" ::: "memory");
        else asm volatile("s_waitcnt vmcnt(0)" ::: "memory");
        __builtin_amdgcn_s_barrier(); asm volatile("" ::: "memory");
        if (blk + 2 < 8) SK_STAGE(blk + 2);
        if (MODE == 0 && blk == 4) { const v2u x = *(const v2u*)(WSP(bf16, WS_RR) + (size_t)row * D + col); acc = acc * ((f32x4){bflo(x.x), bfhi(x.x), bflo(x.y), bfhi(x.y)} * (SB8 / SA8)); }
        const LAS char* Ab = R0 + (blk % 3) * 49152 + (16 * rb + r16) * 512; const LAS char* Bb = R0 + (blk % 3) * 49152 + 16384 + (16 * cb + r16) * 512;
        pg8::v4i_t fa[4][2], fb[4][2];
#pragma unroll
        for (int u = 0; u < 4; ++u) { const int c0 = ((8 * u + kq) ^ r16) & 31, c1 = ((8 * u + 4 + kq) ^ r16) & 31;
            fa[u][0] = *(const LAS pg8::v4i_t*)(Ab + c0 * 16); fa[u][1] = *(const LAS pg8::v4i_t*)(Ab + c1 * 16);
            fb[u][0] = *(const LAS pg8::v4i_t*)(Bb + c0 * 16); fb[u][1] = *(const LAS pg8::v4i_t*)(Bb + c1 * 16); }
        __builtin_amdgcn_sched_barrier(0);
#pragma unroll
        for (int u = 0; u < 4; ++u)
            acc = __builtin_amdgcn_mfma_scale_f32_16x16x128_f8f6f4(__builtin_shufflevector(fb[u][0], fb[u][1], 0, 1, 2, 3, 4, 5, 6, 7), __builtin_shufflevector(fa[u][0], fa[u][1], 0, 1, 2, 3, 4, 5, 6, 7), acc, 0, 0, 0, 0x7f7f7f7f, 0, 0x7f7f7f7f);
        asm volatile("s_waitcnt lgkmcnt(0)" ::: "memory");
    }
    __builtin_amdgcn_s_barrier(); asm volatile("" ::: "memory");
#undef SK_STAGE
    if (MODE == 0) {
        const unsigned sg = *(const unsigned*)(WSP(unsigned char, WS_SGB) + (size_t)row * D + col);
        const f32x4 v = acc * (f8x4(sg) * (SMG / (SB8 * SWP * SG8)));
        *(unsigned*)(WSP(unsigned char, WS_MG) + (size_t)row * PB8 + col) = pk4_fp8(v.x, v.y, v.z, v.w);
    } else {
        const float* xr = (l == 0 ? inp(F, I_XS) : WSP(float, WS_X1S)) + (size_t)rin * D + col;
        const float* gr = WSP(float, WS_MOD) + (size_t)(l * NSEQ + 4 + (rin >> 2)) * NMOD + 2 * D + col;
        const f32x4 r = *(const f32x4*)xr * ALPHA + *(const f32x4*)gr * (acc * (1.0f / (SMG * SWO)));
        *(f32x4*)(WSP(float, WS_RS) + (size_t)rin * D + col) = r;
    }
}
__device__ __forceinline__ void ln_sample_row(Frame& F, int l, int rin, float* dst, bool hb) {
    const int row = MP + rin, seq = 4 + (rin >> 2), lane = F.lane;
    const float* rp = WSP(float, WS_RS) + (size_t)rin * D + lane * 4;
    f32x4 v[16]; float s1 = 0.f;
#pragma unroll
    for (int j = 0; j < 16; ++j) { v[j] = *(const f32x4*)(rp + 256 * j); s1 += (v[j].x + v[j].y) + (v[j].z + v[j].w); }
    s1 = xadd_wave(s1);
    const float mean = s1 * (1.0f / 4096.0f); float s2 = 0.f;
#pragma unroll
    for (int j = 0; j < 16; ++j) { v[j] = v[j] - mean; s2 += (v[j].x * v[j].x + v[j].y * v[j].y) + (v[j].z * v[j].z + v[j].w * v[j].w); }
    s2 = xadd_wave(s2);
    const float rstd = 1.0f / sqrtf(s2 * (1.0f / 4096.0f) + LN_EPS);
    const float* lg = inp(F, I_LNG) + l * D + lane * 4; const float* lb = inp(F, I_LNB) + l * D + lane * 4;
    const float* md = WSP(float, WS_MOD) + (size_t)(1 * NSEQ + seq) * NMOD + lane * 4; bf16* Hb = WSP(bf16, WS_HB) + (size_t)row * LDK + lane * 4; unsigned char* Hb8 = WSP(unsigned char, WS_HB8) + (size_t)row * PB8 + lane * 4;
#pragma unroll
    for (int j = 0; j < 16; ++j) { const f32x4 o = v[j] * rstd * *(const f32x4*)(lg + 256 * j) + *(const f32x4*)(lb + 256 * j);
        *(f32x4*)(dst + lane * 4 + 256 * j) = o;
        if (hb) { const f32x4 hv = o * (*(const f32x4*)(md + D + 256 * j) + 1.0f) + *(const f32x4*)(md + 256 * j); v2u p; p.x = pk2(hv.x, hv.y); p.y = pk2(hv.z, hv.w); *(GAS v2u*)(Hb + 256 * j) = p;
            *(GAS unsigned*)(Hb8 + 256 * j) = pk4_fp8(hv.x * SH8, hv.y * SH8, hv.z * SH8, hv.w * SH8); } }
}

__device__ __forceinline__ void ln_rows(Frame& F, int l, int row0, int nrows, int seq, int slice, float* dst  ) {
    const int col = slice * 1024 + F.lane * 4; const bool hb = (l == 0);
    f32x4 gn[4], bi[4], sh[4], sc[4];
    const float* md = WSP(float, WS_MOD) + (size_t)(1 * NSEQ + seq) * NMOD; const float* lg = inp(F, I_LNG) + l * D; const float* lb = inp(F, I_LNB) + l * D;
    const f32x2* rst = WSP(f32x2, WS_RST); const bf16* Rb = l == 0 ? WSP(bf16, WS_RB0) : WSP(bf16, WS_RB1); bf16* Hb = WSP(bf16, WS_HB); unsigned char* Hb8 = WSP(unsigned char, WS_HB8); f32x2* st0 = WSP(f32x2, WS_ST0);
    const bool wb = (row0 & 2047) >= 1792;
#pragma unroll
    for (int j = 0; j < 4; ++j) { gn[j] = *(const f32x4*)(lg + col + 256 * j); bi[j] = *(const f32x4*)(lb + col + 256 * j);
        if (hb) { sh[j] = *(const f32x4*)(md + col + 256 * j); sc[j] = *(const f32x4*)(md + D + col + 256 * j) + 1.0f; } else { sh[j] = (f32x4){0.f, 0.f, 0.f, 0.f}; sc[j] = sh[j]; } }
    for (int r0 = 0; r0 < nrows; r0 += 4) {
      f32x2 pp[4]; v2u wv[4][4];
#pragma unroll
      for (int rr = 0; rr < 4; ++rr) pp[rr] = rst[(size_t)(row0 + r0 + rr) * 64 + F.lane];
#pragma unroll
      for (int rr = 0; rr < 4; ++rr)
#pragma unroll
          for (int j = 0; j < 4; ++j) wv[rr][j] = *(const v2u*)(Rb + (size_t)(row0 + r0 + rr) * D + col + 256 * j);
#pragma unroll
      for (int rr = 0; rr < 4; ++rr) { const int r = r0 + rr;
        float s1 = pp[rr].x, s2 = pp[rr].y;
        s1 = xadd_wave(s1); s2 = xadd_wave(s2);
        const float mean = s1 * (1.0f / 4096.0f), var = s2 * (1.0f / 4096.0f) - mean * mean, rstd = 1.0f / sqrtf(var + LN_EPS);
        if (hb && slice == 0 && F.lane == 0) st0[row0 + r] = (f32x2){mean, rstd};
#pragma unroll
        for (int j = 0; j < 4; ++j) { const v2u w = wv[rr][j];
            const f32x4 v = ((f32x4){bflo(w.x), bfhi(w.x), bflo(w.y), bfhi(w.y)} - mean) * rstd * gn[j] + bi[j];
            if (hb) { const f32x4 hv = v * sc[j] + sh[j]; *(GAS unsigned*)(Hb8 + (size_t)(row0 + r) * PB8 + col + 256 * j) = pk4_fp8(hv.x * SH8, hv.y * SH8, hv.z * SH8, hv.w * SH8);
                if (wb) { v2u o; o.x = pk2(hv.x, hv.y); o.y = pk2(hv.z, hv.w); *(GAS v2u*)(Hb + (size_t)(row0 + r) * LDK + col + 256 * j) = o; } }
            else *(f32x4*)(dst + (size_t)r * D + col + 256 * j) = v; }
      }
    }
}

struct Args { const float* in[19]; float* out; unsigned char* ws; int ph_lo, ph_hi; };
#ifndef PH_MASK
#define PH_MASK 0xfff
#endif
__global__ void __launch_bounds__(NWAVES * 64, 2) mk_fwd(Args args) {
    extern __shared__ __attribute__((aligned(16))) unsigned char lds[];
    Frame F;
    F.lds = (LAS unsigned char*)lds;
    volatile LAS unsigned* MISC = (volatile LAS unsigned*)(F.lds + MISC_OFF);
    F.tid = threadIdx.x; F.lane = F.tid & 63; F.wave = __builtin_amdgcn_readfirstlane(F.tid >> 6); F.bx = blockIdx.x;
    F.ws = args.ws; F.out = args.out;
    gu32* ctl = (gu32*)(F.ws + WS_CTL);
    asm volatile("s_setreg_imm32_b32 hwreg(HW_REG_MODE, 23, 1), 1");
    for (int u = F.tid; u < (LDS_BYTES - LDSCTL_OFF) / 4; u += NWAVES * 64) ((LAS unsigned*)(F.lds + LDSCTL_OFF))[u] = 0u;
    __syncthreads();
    if (F.tid == 0) { volatile LAS unsigned long long* pt = (volatile LAS unsigned long long*)(F.lds + PTAB_OFF);
#pragma unroll
        for (int k = 0; k < 19; ++k) pt[k] = (unsigned long long)args.in[k]; }
    __syncthreads();
#if MK_SPLIT
    const int lo = args.ph_lo, hi = args.ph_hi;
#else
    constexpr int lo = 0, hi = 12;
#endif
    const bool use_bar = (hi - lo) > 1;
    XcdBarrier bar; bar.bar = (unsigned*)(ctl + CW_BAR); bar.x = 0; bar.st = nullptr;
    if (use_bar) bar = xcd_barrier_post((unsigned*)(ctl + CW_BAR), MISC + 8);
#define IN(k) (((PH_MASK >> ((k) > 6 ? (k) - 5 : (k))) & 1) && lo <= (k) && (k) < hi)
#define SEAM(k) do { if (lo <= (k) && (k) + 1 < hi) { REFRESH(); xcd_barrier(bar, F.tid == 0); } } while (0)
#define REFRESH() do { int t_, w_ = wave0, b_ = bx0; asm volatile("v_mbcnt_lo_u32_b32 %0, -1, 0\n\tv_mbcnt_hi_u32_b32 %0, -1, %0" : "=v"(t_), "+s"(w_), "+s"(b_)); F.lane = t_; F.wave = w_; F.bx = b_; F.tid = w_ * 64 + t_; } while (0)
#define GW (F.bx * NWAVES + F.wave)
    const int NGW = F.G * NWAVES; const int wave0 = F.wave, bx0 = F.bx;

    if (IN(0)) {
        asm volatile("; MARK_P0a");
        REFRESH();
        if (F.bx < 192) ada_item(F, F.bx);
        LAS float* scr = (LAS float*)(F.lds + F.wave * 16384);
        int sh = F.bx & 7, left = 8;
        for (;;) {
            const int v = pull8(ctl + CW_WORK0, (I_LAYER + I_WS) / 8, sh, left, F.lane);
            if (v < 0) break;
            copy_chunk(F, v < I_LAYER ? v : I_TR + (v - I_LAYER), scr);
        }
    }
    SEAM(0);
    if (IN(1)) {
        asm volatile("; MARK_P0b");
        REFRESH();
        for (int it = GW; it < 2048 + 128; it += NGW) {
            if (it < 2048) { const int rb = it >> 2, sl = it & 3; h_rows(F, inp(F, I_XP) + (size_t)rb * 16 * D, rb * 16, 16, rb >> 7, sl, 0); }
            else { const int q = it - 2048, sq = q >> 2, sl = q & 3; h_rows(F, inp(F, I_XS) + (size_t)sq * 4 * D, MP + sq * 4, 4, 4 + sq, sl, 0); }
        }
    }
    SEAM(1);
#pragma unroll 1
    for (int l = 0; l < 2; ++l) {
        const int pb = 2 + 5 * l;
        if (IN(pb)) {
            asm volatile("; MARK_GEMM1");
            REFRESH();
            { pg8::Gemm g8{WSP(bf16, WS_HB8), (const bf16*)(WSP(unsigned char, WS_WIN8) + (size_t)l * NIN * PB8), MPAD, NIN, K8};
              OrderF8 S; S.c = F.bx; EpiInT<true> E{F.ws, F.out, l};
              pg8::gemm_phase<K8, LD8, EpiInT<true>, OrderF8, PG8_ALIGN, PG8_SP2, false, true>(F.lds, g8, S, E, F.wave); }
            REFRESH();
            { pg8::Gemm g{WSP(bf16, WS_HB), WSP(bf16, WS_WIN) + (size_t)l * NIN * LDK, MPAD, NIN, D};
              OrderBf S; S.c = F.bx; EpiInT<false> E{F.ws, F.out, l};
              pg8::gemm_phase<D, LDK, EpiInT<false>, OrderBf, PG8_ALIGN, PG8_SP2>(F.lds, g, S, E, F.wave); }
            if (l == 0) {
                REFRESH();
                if (F.tid == 0) (void)__hip_atomic_fetch_add((unsigned*)(ctl + CW_DONE1), 1u, RLX_AGENT);
                if (F.bx >= G1_UNITS - 2048 - G1_NF8W && F.bx < G1_NF8W) steal_copies(F, true, 1, 3);
            } else {
                REFRESH();
                if (F.bx >= G1_UNITS - 2048 - G1_NF8W && F.bx < G1_NF8W) steal_copies(F, false, 2, 1 << 20);
            }
        }
        SEAM(pb);
        if (IN(pb + 1)) {
            asm volatile("; MARK_MIX");
            REFRESH();
            for (int u = F.bx; u < 256; u += F.G) attn_prompt_unit(F, l, u);
            REFRESH();
            { int par = 0; for (int u = F.bx; u < 512; u += F.G) { sgu_prompt_unit(F, l, u, par); par ^= 1; } }
            __syncthreads();
            REFRESH();
            for (int u = F.bx; u < 128; u += F.G) attn_sample_unit(F, l, u);
            REFRESH();
            for (int u = F.bx - 128; u < 32; u += F.G) if (u >= 0) sgu_sample_unit(F, l, u);
        }
        SEAM(pb + 1);
        if (IN(pb + 2)) {
            asm volatile("; MARK_GEMM2");
            REFRESH();
            pg8::Gemm g{WSP(bf16, WS_AB), (const bf16*)(WSP(unsigned char, WS_WP) + (size_t)l * D * PB8), MP, D, K8}; pg8::StaticOrderC<MP, D> S; S.init(F.G, F.bx);
            EpiMerge E{WSP(bf16, WS_RR), WSP(unsigned char, WS_SGB), WSP(unsigned char, WS_MG)};
            if (F.bx & 8) { skinny_gemm<0>(F, l, F.bx); REFRESH(); }
            pg8::gemm_phase<K8, LD8, EpiMerge, pg8::StaticOrderC<MP, D>, PG8_ALIGN, PG8_SP2, false, true>(F.lds, g, S, E, F.wave);
            REFRESH();
            if (!(F.bx & 8)) skinny_gemm<0>(F, l, F.bx);
        }
        SEAM(pb + 2);
        if (IN(pb + 3)) {
            asm volatile("; MARK_GEMM3");
            REFRESH();
            pg8::Gemm g{WSP(bf16, WS_MG), (const bf16*)(WSP(unsigned char, WS_WO) + (size_t)l * D * PB8), MP, D, K8}; pg8::StaticOrderC<MP, D> S; S.init(F.G, F.bx);
            if (F.bx & 8) { skinny_gemm<1>(F, l, F.bx); REFRESH(); }
            if (l == 0) { EpiOutT<0> E{inp(F, I_XP), nullptr, nullptr, nullptr, nullptr, WSP(float, WS_MOD) + 2 * D, WSP(bf16, WS_RB0), WSP(f32x2, WS_RST)};
                pg8::gemm_phase<K8, LD8, EpiOutT<0>, pg8::StaticOrderC<MP, D>, PG8_ALIGN, PG8_SP2, false, true>(F.lds, g, S, E, F.wave); }
            else { EpiOutT<1> E{nullptr, WSP(bf16, WS_RB0), WSP(f32x2, WS_ST0), inp(F, I_LNG), inp(F, I_LNB), WSP(float, WS_MOD) + (size_t)NSEQ * NMOD + 2 * D, WSP(bf16, WS_RB1), WSP(f32x2, WS_RST)};
                pg8::gemm_phase<K8, LD8, EpiOutT<1>, pg8::StaticOrderC<MP, D>, PG8_ALIGN, PG8_SP2, false, true>(F.lds, g, S, E, F.wave); }
            REFRESH();
            if (!(F.bx & 8)) skinny_gemm<1>(F, l, F.bx);
        }
        SEAM(pb + 3);
        if (IN(pb + 4)) {
            asm volatile("; MARK_LN");
            REFRESH();
            float* dp = F.out + O_YP; float* ds = l == 0 ? WSP(float, WS_X1S) : F.out + O_YS;
            for (int it = GW; it < 2048 + 128; it += NGW) {
                if (it < 2048) { const int rb = it >> 2, sl = it & 3; ln_rows(F, l, rb * 16, 16, rb >> 7, sl, dp + (size_t)rb * 16 * D); }
                else { const int rin = it - 2048; ln_sample_row(F, l, rin, ds + (size_t)rin * D, l == 0); }
            }
            if (l == 0) steal_copies(F, false, 1, 1 << 20);
        }
        if (l == 0) SEAM(pb + 4);
    }
#undef IN
#undef SEAM
}

extern "C" void kernel_launch(void* const* d_in, const int* in_sizes, int n_in, void* d_out, int out_size, void* d_ws, size_t ws_size, hipStream_t stream) {
    static int grid = 0;
    if (grid == 0) {
        if (n_in != 19 || out_size != (int)O_END || ws_size < WS_END) { fprintf(stderr, "kernel_launch: unexpected sizes (n_in %d, out %d, ws %zu); nothing launched\n", n_in, out_size, ws_size); grid = -1; return; }
        int dev = 0, cus = 0, per_cu = 0;
        if (hipGetDevice(&dev) != hipSuccess || hipDeviceGetAttribute(&cus, hipDeviceAttributeMultiprocessorCount, dev) != hipSuccess) { grid = -1; return; }
        if (hipFuncSetAttribute((const void*)mk_fwd, hipFuncAttributeMaxDynamicSharedMemorySize, LDS_BYTES) != hipSuccess) { fprintf(stderr, "kernel_launch: hipFuncSetAttribute failed\n"); grid = -1; return; }
        if (hipOccupancyMaxActiveBlocksPerMultiprocessor(&per_cu, (const void*)mk_fwd, NWAVES * 64, LDS_BYTES) != hipSuccess || per_cu < 1)
            fprintf(stderr, "kernel_launch: note: occupancy query reports %d workgroups per CU\n", per_cu);
        (void)hipGetLastError();
        if (cus != Frame::G) { fprintf(stderr, "kernel_launch: built for a %d-CU device, found %d CUs; nothing launched\n", Frame::G, cus); grid = -1; return; }
        grid = cus;
    }
    if (grid < 0) return;
    if (hipMemsetAsync((char*)d_ws + WS_CTL, 0, CTL_ZERO_BYTES, stream) != hipSuccess) return;
    Args a{};
    for (int i = 0; i < 19; ++i) a.in[i] = (const float*)d_in[i];
    a.out = (float*)d_out; a.ws = (unsigned char*)d_ws;
#if MK_SPLIT
    for (int p = 0; p < 12; ++p) { a.ph_lo = p; a.ph_hi = p + 1; hipLaunchKernelGGL(mk_fwd, dim3(grid), dim3(NWAVES * 64), LDS_BYTES, stream, a); }
#else
    a.ph_lo = 0; a.ph_hi = 12;
    hipLaunchKernelGGL(mk_fwd, dim3(grid), dim3(NWAVES * 64), LDS_BYTES, stream, a);
#endif
    const hipError_t le = hipPeekAtLastError();
    if (le != hipSuccess) fprintf(stderr, "kernel_launch: launch failed: %s\n", hipGetErrorName(le));
}
```

```cpp
#include <hip/hip_runtime.h>
#include <cstdio>
#include <cstdint>

namespace pg8 {
#define PG8_LAS __attribute__((address_space(3)))
typedef unsigned short bf16_t;
typedef short bf16x8 __attribute__((ext_vector_type(8)));
typedef float f32x4 __attribute__((ext_vector_type(4)));
typedef unsigned u32x4 __attribute__((ext_vector_type(4)));
typedef unsigned u32x2 __attribute__((ext_vector_type(2)));
typedef int v4i_t __attribute__((ext_vector_type(4)));
constexpr int BM = 256, BK = 64, HALF = 128, HTB = HALF * BK * 2  , STAGE_BYTES = 8 * HTB, NXCD = 8, WGM = 8;

__host__ __device__ __forceinline__ int lds_byte(int r, int c) { const int st = (r >> 4) * 2 + (c >> 5), rr = r & 15, cc = c & 31, ob = rr * 64 + cc * 2; return st * 1024 + (ob ^ (((ob >> 9) & 1) << 5)); }
__host__ __device__ __forceinline__ void stage_rc(int b, int& R, int& C) { const int st = b / 1024, sb = b % 1024, swz = sb ^ (((sb >> 9) & 1) << 5); R = (st >> 1) * 16 + swz / 64; C = (st & 1) * 32 + (swz % 64) / 2; }
__host__ __device__ __forceinline__ int perm32(int rho) { const int n = rho >> 4, i = rho & 15; return 8 * (i >> 2) + 4 * n + (i & 3); }

struct Unit { int pm, pn; };
struct Gemm { const bf16_t* A; const bf16_t* Bt; int M, N, K; };

template <int MC, int NC> struct StaticOrderC {
    static constexpr int nM = MC / BM, nN = NC / BM, nwg = nM * nN;
    int G, c;
    __host__ __device__ void init(int G_, int c_) { G = G_; c = c_; }
    __host__ __device__ static void map(int L, Unit& u) {
        int wgid = L; { constexpr int q = nwg / NXCD, r = nwg % NXCD; const int xcd = wgid % NXCD, off = wgid / NXCD; wgid = (xcd < r ? xcd * (q + 1) : r * (q + 1) + (xcd - r) * q) + off; }
        constexpr int nig = WGM * nN; const int gid = wgid / nig, fm = gid * WGM, gsz = (nM - fm) < WGM ? (nM - fm) : WGM;
        u.pm = fm + ((wgid % nig) % gsz); u.pn = (wgid % nig) / gsz;
    }
    __host__ __device__ bool next(int i, Unit& u) const {
        const int L = i * G + c; if (L >= nwg) return false;
        int wgid = L; { constexpr int q = nwg / NXCD, r = nwg % NXCD; const int xcd = wgid % NXCD, off = wgid / NXCD; wgid = (xcd < r ? xcd * (q + 1) : r * (q + 1) + (xcd - r) * q) + off; }
        constexpr int nig = WGM * nN; const int gid = wgid / nig, fm = gid * WGM, gsz = (nM - fm) < WGM ? (nM - fm) : WGM;
        u.pm = fm + ((wgid % nig) % gsz); u.pn = (wgid % nig) / gsz; return true;
    }
    __device__ __forceinline__ void a_ready(const Unit&) const {}
    __device__ __forceinline__ void done(const Unit&) const {}
};

__device__ __forceinline__ unsigned cvt_pk_bf16(float lo, float hi) { unsigned r; asm volatile("v_cvt_pk_bf16_f32 %0, %1, %2" : "=v"(r) : "v"(lo), "v"(hi)); return r; }

template <int KC, int LD, class Epi, class Sched, bool ALIGN_EPI = false, bool SP2 = false, bool HM = false, bool F8 = false>
__device__ __forceinline__ void gemm_phase(PG8_LAS unsigned char* lds, const Gemm g, const Sched& S, const Epi& E, const int wid_) {
    const int wid = __builtin_amdgcn_readfirstlane(wid_);
    int lane_; asm volatile("v_mbcnt_lo_u32_b32 %0, -1, 0\n\tv_mbcnt_hi_u32_b32 %0, -1, %0" : "=v"(lane_));
    const int lane = lane_, tid = wid * 64 + lane, wr = wid >> 2, wc = wid & 3, fr = lane & 15, fq = lane >> 4;
    constexpr int K = KC, nt = K / BK;
    unsigned voffA[2], voffB[2];
#pragma unroll
    for (int i = 0; i < 2; ++i) { int R, C; stage_rc(tid * 16 + i * 8192, R, C); const int Rb = Epi::PERM ? ((R & ~31) + perm32(R & 31)) : R;
        voffA[i] = (unsigned)(R * LD + C) * 2u; voffB[i] = (unsigned)(Rb * LD + C) * 2u; }
    constexpr unsigned kstep = (unsigned)(BK * 2);
    constexpr unsigned hstep = (unsigned)(HALF * LD * 2);
    constexpr unsigned tstep = 2 * hstep;
    const __amdgpu_buffer_rsrc_t rA = __builtin_amdgcn_make_buffer_rsrc((void*)g.A, 0, 0x7fffffff, 0x00020000), rB = __builtin_amdgcn_make_buffer_rsrc((void*)g.Bt, 0, 0x7fffffff, 0x00020000);
    const unsigned ldsw = (unsigned)wid * 1024u;
    const int aoff = lds_byte(wr * 64 + fr, fq * 8), boff = lds_byte(wc * 32 + fr, fq * 8);
#define PG8_SA(b, h) (((b) * 2 + (h)) * HTB)
#define PG8_SB(b, h) ((4 + (b) * 2 + (h)) * HTB)
#define PG8_STAGE_R(rs, bufoff, goff, voff) do { _Pragma("unroll") for (int _i = 0; _i < 2; ++_i) \
        __builtin_amdgcn_raw_ptr_buffer_load_lds(rs, (PG8_LAS unsigned*)(lds + (bufoff) + ldsw + _i * 8192), 16, (voff)[_i], (int)(goff), 0, 0); } while (0)
#define PG8_STAGE_A(bufoff, goff, voff) PG8_STAGE_R(rA, bufoff, goff, voff)
#define PG8_STAGE_B(bufoff, goff, voff) PG8_STAGE_R(rB, bufoff, goff, voff)
#define PG8_LDA(dst, b, h) do { _Pragma("unroll") for (int m = 0; m < 4; ++m) _Pragma("unroll") for (int k = 0; k < 2; ++k) dst[m][k] = *(const PG8_LAS bf16x8*)(lds + PG8_SA(b, h) + aoff + m * 2048 + k * 1024); } while (0)
#define PG8_LDB(dst, b, h) do { _Pragma("unroll") for (int n = 0; n < 2; ++n) _Pragma("unroll") for (int k = 0; k < 2; ++k) dst[n][k] = *(const PG8_LAS bf16x8*)(lds + PG8_SB(b, h) + boff + n * 2048 + k * 1024); } while (0)
#define PG8_CAT(x0, x1) __builtin_shufflevector(__builtin_bit_cast(v4i_t, x0), __builtin_bit_cast(v4i_t, x1), 0, 1, 2, 3, 4, 5, 6, 7)
#define PG8_MMA(ai, bj, At, Bt) do { __builtin_amdgcn_s_setprio(1); if constexpr (F8) { _Pragma("unroll") for (int m = 0; m < 4; ++m) _Pragma("unroll") for (int n = 0; n < 2; ++n) \
        acc[ai][bj][m][n] = __builtin_amdgcn_mfma_scale_f32_16x16x128_f8f6f4(PG8_CAT(Bt[n][0], Bt[n][1]), PG8_CAT(At[m][0], At[m][1]), acc[ai][bj][m][n], 0, 0, 0, 0x7f7f7f7f, 0, 0x7f7f7f7f); } \
        else { _Pragma("unroll") for (int m = 0; m < 4; ++m) _Pragma("unroll") for (int n = 0; n < 2; ++n) _Pragma("unroll") for (int k = 0; k < 2; ++k) \
        acc[ai][bj][m][n] = __builtin_amdgcn_mfma_f32_16x16x32_bf16(Bt[n][k], At[m][k], acc[ai][bj][m][n], 0, 0, 0); } __builtin_amdgcn_s_setprio(0); } while (0)
#define PG8_WAIT_V(n) asm volatile("s_waitcnt vmcnt(" #n ")" ::: "memory")
#define PG8_WAIT_L(n) asm volatile("s_waitcnt lgkmcnt(" #n ")" ::: "memory")
#define PG8_BAR __builtin_amdgcn_s_barrier()
#define PG8_SCHED __builtin_amdgcn_sched_barrier(0)
    Unit cur, nxt; int ui = 0;
    if (!S.next(0, cur)) return;
    f32x4 acc[2][2][4][2];
#pragma unroll
    for (int a = 0; a < 2; ++a)
#pragma unroll
        for (int b = 0; b < 2; ++b)
#pragma unroll
            for (int m = 0; m < 4; ++m)
#pragma unroll
                for (int n = 0; n < 2; ++n) acc[a][b][m][n] = (f32x4){0.f, 0.f, 0.f, 0.f};
    bf16x8 At[4][2], B0[2][2], B1[2][2];
    constexpr unsigned astep = HM ? hstep : tstep;
    unsigned cA = (unsigned)cur.pm * astep, cB = (unsigned)cur.pn * tstep;
    S.a_ready(cur);
    if constexpr (SP2) {
        PG8_STAGE_B(PG8_SB(0, 0), cB, voffB); PG8_STAGE_B(PG8_SB(0, 1), cB + hstep, voffB); PG8_STAGE_A(PG8_SA(0, 0), cA, voffA); PG8_STAGE_A(PG8_SA(0, 1), cA + hstep, voffA);
        if (wr == 1) PG8_BAR;
        PG8_WAIT_V(2); PG8_BAR;
        PG8_STAGE_B(PG8_SB(1, 0), cB + kstep, voffB); PG8_STAGE_A(PG8_SA(1, 0), cA + kstep, voffA); PG8_STAGE_B(PG8_SB(1, 1), cB + hstep + kstep, voffB);
        PG8_WAIT_V(6); PG8_BAR;
    } else {
        PG8_STAGE_B(PG8_SB(0, 0), cB, voffB); PG8_STAGE_A(PG8_SA(0, 0), cA, voffA); PG8_STAGE_B(PG8_SB(0, 1), cB + hstep, voffB); PG8_STAGE_A(PG8_SA(0, 1), cA + hstep, voffA);
        if (wr == 1) PG8_BAR;
        PG8_WAIT_V(4); PG8_BAR;
        PG8_STAGE_B(PG8_SB(1, 0), cB + kstep, voffB); PG8_STAGE_A(PG8_SA(1, 0), cA + kstep, voffA); PG8_STAGE_B(PG8_SB(1, 1), cB + hstep + kstep, voffB);
        PG8_WAIT_V(6); PG8_BAR;
    }
    for (;;) {
        const bool has_next = S.next(ui + 1, nxt);
        const unsigned nA = has_next ? (unsigned)nxt.pm * astep : cA, nB = has_next ? (unsigned)nxt.pn * tstep : cB;
        for (int t = 0; t < nt; t += 2) {
            const bool last = (t == nt - 2);
            const unsigned a1 = cA + (unsigned)(t + 1) * kstep;
            const unsigned a2 = last ? nA : cA + (unsigned)(t + 2) * kstep, b2 = last ? nB : cB + (unsigned)(t + 2) * kstep;
            const unsigned a3 = a2 + kstep, b3 = b2 + kstep;
            if (last && has_next) S.a_ready(nxt);
            if constexpr (Epi::MIDK) { if (t == (nt >> 1)) E.mid(acc, cur, wr, wc, fr, fq); }
            if constexpr (SP2) {
            PG8_LDB(B0, 0, 0); PG8_LDB(B1, 0, 1); PG8_SCHED; PG8_LDA(At, 0, 0); PG8_STAGE_A(PG8_SA(1, 1), a1 + hstep, voffA);
            PG8_WAIT_V(8); PG8_WAIT_L(0); PG8_BAR; PG8_MMA(0, 0, At, B0); PG8_MMA(0, 1, At, B1); PG8_BAR; PG8_SCHED;
            if constexpr (!HM) PG8_LDA(At, 0, 1); PG8_STAGE_B(PG8_SB(0, 0), b2, voffB); PG8_STAGE_B(PG8_SB(0, 1), b2 + hstep, voffB); PG8_STAGE_A(PG8_SA(0, 0), a2, voffA);
            PG8_WAIT_V(8); PG8_WAIT_L(0); PG8_BAR; if constexpr (!HM) { PG8_MMA(1, 0, At, B0); PG8_MMA(1, 1, At, B1); } PG8_BAR; PG8_SCHED;
            PG8_LDB(B0, 1, 0); PG8_LDB(B1, 1, 1); PG8_SCHED; PG8_LDA(At, 1, 0); PG8_STAGE_A(PG8_SA(0, 1), a2 + hstep, voffA);
            PG8_WAIT_V(8); PG8_WAIT_L(0); PG8_BAR; PG8_MMA(0, 0, At, B0); PG8_MMA(0, 1, At, B1); PG8_BAR; PG8_SCHED;
            if constexpr (!HM) PG8_LDA(At, 1, 1); PG8_STAGE_B(PG8_SB(1, 0), b3, voffB); PG8_STAGE_B(PG8_SB(1, 1), b3 + hstep, voffB); PG8_STAGE_A(PG8_SA(1, 0), a3, voffA);
            PG8_WAIT_V(8); PG8_WAIT_L(0); PG8_BAR; if constexpr (!HM) { PG8_MMA(1, 0, At, B0); PG8_MMA(1, 1, At, B1); } PG8_BAR; PG8_SCHED;
            } else {
            PG8_LDB(B0, 0, 0); PG8_SCHED; PG8_LDA(At, 0, 0); PG8_STAGE_A(PG8_SA(1, 1), a1 + hstep, voffA);
            PG8_WAIT_L(8); PG8_BAR; PG8_WAIT_L(0); PG8_MMA(0, 0, At, B0); PG8_BAR; PG8_SCHED;
            PG8_LDB(B1, 0, 1); PG8_STAGE_B(PG8_SB(0, 0), b2, voffB);
            PG8_BAR; PG8_WAIT_L(0); PG8_MMA(0, 1, At, B1); PG8_BAR;
            PG8_LDA(At, 0, 1); PG8_STAGE_A(PG8_SA(0, 0), a2, voffA);
            PG8_BAR; PG8_WAIT_L(0); PG8_MMA(1, 0, At, B0); PG8_BAR; PG8_SCHED;
            PG8_STAGE_B(PG8_SB(0, 1), b2 + hstep, voffB);
            PG8_WAIT_V(6); PG8_BAR; PG8_MMA(1, 1, At, B1); PG8_BAR;
            PG8_LDB(B0, 1, 0); PG8_SCHED; PG8_LDA(At, 1, 0); PG8_STAGE_A(PG8_SA(0, 1), a2 + hstep, voffA);
            PG8_WAIT_L(8); PG8_BAR; PG8_WAIT_L(0); PG8_MMA(0, 0, At, B0); PG8_BAR; PG8_SCHED;
            PG8_LDB(B1, 1, 1); PG8_STAGE_B(PG8_SB(1, 0), b3, voffB);
            PG8_BAR; PG8_WAIT_L(0); PG8_MMA(0, 1, At, B1); PG8_BAR;
            PG8_LDA(At, 1, 1); PG8_STAGE_A(PG8_SA(1, 0), a3, voffA);
            PG8_BAR; PG8_WAIT_L(0); PG8_MMA(1, 0, At, B0); PG8_BAR; PG8_SCHED;
            PG8_STAGE_B(PG8_SB(1, 1), b3 + hstep, voffB);
            PG8_WAIT_V(6); PG8_BAR; PG8_MMA(1, 1, At, B1); PG8_BAR;
            }
        }
        if constexpr (ALIGN_EPI) { if (wr == 0) PG8_BAR; }
        E(acc, cur, wr, wc, fr, fq); S.done(cur);
        if (!has_next) break;
#pragma unroll
        for (int a = 0; a < 2; ++a)
#pragma unroll
            for (int b = 0; b < 2; ++b)
#pragma unroll
                for (int m = 0; m < 4; ++m)
#pragma unroll
                    for (int n = 0; n < 2; ++n) acc[a][b][m][n] = (f32x4){0.f, 0.f, 0.f, 0.f};
        cur = nxt; cA = nA; cB = nB; ++ui;
        if constexpr (ALIGN_EPI) { if (wr == 1) PG8_BAR; }
    }
    PG8_WAIT_V(0);
    if constexpr (!ALIGN_EPI) { if (wr == 0) PG8_BAR; }
    PG8_BAR;
#undef PG8_SA
#undef PG8_SB
#undef PG8_STAGE_R
#undef PG8_STAGE_A
#undef PG8_STAGE_B
#undef PG8_LDA
#undef PG8_LDB
#undef PG8_MMA
#undef PG8_CAT
#undef PG8_WAIT_V
#undef PG8_WAIT_L
#undef PG8_BAR
#undef PG8_SCHED
}
}

#ifndef PG8_SP2
#define PG8_SP2 true
#endif
#ifndef PG8_ALIGN
#define PG8_ALIGN true
#endif
#ifndef MK_SPLIT
#define MK_SPLIT 0
#endif

constexpr int NWAVES = 8;
constexpr int D = 4096, MP = 8192, MS = 128, MTOT = MP + MS, MPAD = 8448, NIN = 18944, DA = 2048, DKV = 256, DSG = 2048;
constexpr int NSEQ = 36, NMOD = 3 * D, SEQ = 2048, WIN = 128;
constexpr int PB8 = D + 128, LD8 = PB8 / 2, K8 = D / 2;
constexpr float SA8 = 32.f, SB8 = 8.f, SWP = 128.f, SMG = 16.f, SWO = 256.f, SH8 = 8.f, SWI = 128.f,
                SQ8 = 16.f, SZA8 = 8.f, SUZ8 = 4.f, SVB8 = 8.f, SG8 = 256.f;
constexpr int LDK = D + 64;
constexpr float ALPHA = 1.4142135623730951f;
constexpr float LN_EPS = 1e-5f;
constexpr float LOG2E = 1.4426950408889634f;
constexpr float QSCALE = 0.125f * LOG2E;
constexpr size_t O_YP = 0, O_YS = 33554432, O_WK = 34078720, O_WV = 34340864, O_NK = 34603008, O_NV = 34668544, O_SV = 34734080, O_END = 35258368;

constexpr size_t MiB = 1u << 20;
constexpr size_t WS_CTL = 0, CTL_ZERO_BYTES = 32768;
constexpr size_t WS_MOD = 1 * MiB;
constexpr size_t WS_WSB = 5 * MiB;
constexpr size_t WS_VST = 6 * MiB;
constexpr size_t WS_RST = 9 * MiB;
constexpr size_t WS_KB = 14 * MiB;
constexpr size_t WS_VB = 19 * MiB;
constexpr size_t WS_WIN = 24 * MiB;
constexpr size_t WS_WP = 328 * MiB;
constexpr size_t WS_WO = 394 * MiB;
constexpr size_t WS_HB = 460 * MiB;
constexpr size_t WS_QB = 528 * MiB;
constexpr size_t WS_ZA = 561 * MiB;
constexpr size_t WS_UZ = 594 * MiB;
constexpr size_t WS_VBB = 627 * MiB;
constexpr size_t WS_VBS = 644 * MiB;
constexpr size_t WS_RR = 660 * MiB;
constexpr size_t WS_SGB = 726 * MiB;
constexpr size_t WS_AB = 792 * MiB;
constexpr size_t WS_MG = 860 * MiB;
constexpr size_t WS_RBUF = 928 * MiB;
constexpr size_t WS_RB0 = 928 * MiB;
constexpr size_t WS_RB1 = 992 * MiB;
constexpr size_t WS_RS = 1056 * MiB;
constexpr size_t WS_X1S = 1058 * MiB;
constexpr size_t WS_ST0 = 1060 * MiB;
constexpr size_t WS_HB8 = 1192 * MiB;
constexpr size_t WS_WIN8 = 1228 * MiB;
constexpr size_t WS_END = 1384 * MiB;
static_assert(WS_HB8 + (size_t)MPAD * PB8 <= WS_WIN8 && WS_WIN8 + 2ull * NIN * PB8 <= WS_END, "d_ws map (fp8)");
static_assert(WS_WIN + 2ull * NIN * LDK * 2 <= WS_WP && WS_WP + 2ull * D * LDK * 2 <= WS_WO && WS_WO + 2ull * D * LDK * 2 <= WS_HB && WS_HB + (size_t)MPAD * LDK * 2 <= WS_QB && WS_AB + (size_t)MPAD * LDK * 2 <= WS_MG && WS_MG + (size_t)MPAD * LDK * 2 <= WS_RBUF, "d_ws map");
static_assert((4096 + 3456) * 4 <= (int)CTL_ZERO_BYTES, "barrier words inside the zeroed region");
constexpr int CW_TMO = 0, CW_CODE = 1, CW_WORK0 = 512, CW_WORK1 = 1024, CW_ADA1 = 192, CW_DONE1 = 256, CW_WORK2 = 1536, CW_BAR = 4096;

constexpr int RING_BYTES = 131072;
constexpr int LDSCTL_OFF = 155648, MISC_OFF = LDSCTL_OFF + 320, PTAB_OFF = LDSCTL_OFF + 512;
constexpr int LDS_BYTES = 159744;

#define GAS __attribute__((address_space(1)))
#define LAS __attribute__((address_space(3)))
typedef unsigned short bf16;
typedef unsigned v4u __attribute__((ext_vector_type(4)));
typedef unsigned v2u __attribute__((ext_vector_type(2)));
typedef float f32x4 __attribute__((ext_vector_type(4)));
typedef float f32x2 __attribute__((ext_vector_type(2)));
typedef GAS unsigned gu32;
#define RLX_AGENT __ATOMIC_RELAXED, __HIP_MEMORY_SCOPE_AGENT
#define LDS_WAIT() asm volatile("s_waitcnt lgkmcnt(0)" ::: "memory")
#define VM_WAIT() asm volatile("s_waitcnt vmcnt(0)" ::: "memory")
__device__ __forceinline__ unsigned f2bf(float f) { unsigned u = __builtin_bit_cast(unsigned, f); return (u + 0x7fffu + ((u >> 16) & 1u)) >> 16; }
__device__ __forceinline__ unsigned pk2(float lo, float hi) { return f2bf(lo) | (f2bf(hi) << 16); }
__device__ __forceinline__ float bflo(unsigned u) { return __builtin_bit_cast(float, u << 16); }
__device__ __forceinline__ float bfhi(unsigned u) { return __builtin_bit_cast(float, u & 0xffff0000u); }
__device__ __forceinline__ unsigned pk4_fp8(float a, float b, float c, float d) { int w = 0; w = __builtin_amdgcn_cvt_pk_fp8_f32(a, b, w, false); w = __builtin_amdgcn_cvt_pk_fp8_f32(c, d, w, true); return (unsigned)w; }
__device__ __forceinline__ int lane_now() { int l; asm volatile("v_mbcnt_lo_u32_b32 %0, -1, 0\n\tv_mbcnt_hi_u32_b32 %0, -1, %0" : "=v"(l)); return l; }
template <int K> __device__ __forceinline__ float xadd(float v) {
    if constexpr (K < 32) return v + __builtin_bit_cast(float, __builtin_amdgcn_ds_swizzle(__builtin_bit_cast(int, v), (K << 10) | 0x1f));
    else { const unsigned u = __builtin_bit_cast(unsigned, v); auto rr = __builtin_amdgcn_permlane32_swap(u, u, false, false); return __builtin_bit_cast(float, (unsigned)rr[0]) + __builtin_bit_cast(float, (unsigned)rr[1]); }
}
template <int K> __device__ __forceinline__ float xmax(float v) {
    if constexpr (K < 32) return fmaxf(v, __builtin_bit_cast(float, __builtin_amdgcn_ds_swizzle(__builtin_bit_cast(int, v), (K << 10) | 0x1f)));
    else { const unsigned u = __builtin_bit_cast(unsigned, v); auto rr = __builtin_amdgcn_permlane32_swap(u, u, false, false); return fmaxf(__builtin_bit_cast(float, (unsigned)rr[0]), __builtin_bit_cast(float, (unsigned)rr[1])); }
}
__device__ __forceinline__ float xadd_wave(float v) { v = xadd<1>(v); v = xadd<2>(v); v = xadd<4>(v); v = xadd<8>(v); v = xadd<16>(v); return xadd<32>(v); }
__device__ __forceinline__ float xmax_wave(float v) { v = xmax<1>(v); v = xmax<2>(v); v = xmax<4>(v); v = xmax<8>(v); v = xmax<16>(v); return xmax<32>(v); }
__device__ __forceinline__ float xadd_32(float v) { v = xadd<1>(v); v = xadd<2>(v); v = xadd<4>(v); v = xadd<8>(v); return xadd<16>(v); }
__device__ __forceinline__ f32x4 f8x4(unsigned w) { const f32x2 a = __builtin_amdgcn_cvt_pk_f32_fp8((int)w, false), b = __builtin_amdgcn_cvt_pk_f32_fp8((int)w, true); return (f32x4){a.x, a.y, b.x, b.y}; }
__device__ __forceinline__ float f8x1(unsigned char b) { return __builtin_amdgcn_cvt_f32_fp8((int)b, 0); }
__device__ __forceinline__ float sigmoidf_(float x) { return __builtin_amdgcn_rcpf(1.0f + __builtin_amdgcn_exp2f(-x * LOG2E)); }
__device__ __forceinline__ float siluf_(float x) { return x * sigmoidf_(x); }

#define XB_TMO      128
#define XB_XCNT(j)  (256  + 64 * (j))
#define XB_XSUB(j)  (1280 + 64 * (j))
#define XB_XGEN(j)  (2304 + 64 * (j))
#define XB_TOP      3328
#define XB_TOPGEN   3392
#define XCD_BAR_WORDS 3456
#define XB_SPIN_CAP (1u << 18)
__device__ __forceinline__ unsigned xb_ld(unsigned* p)              { return __hip_atomic_load(p, __ATOMIC_RELAXED, __HIP_MEMORY_SCOPE_AGENT); }
__device__ __forceinline__ unsigned xb_add(unsigned* p, unsigned v) { return __hip_atomic_fetch_add(p, v, __ATOMIC_RELAXED, __HIP_MEMORY_SCOPE_AGENT); }
__device__ __forceinline__ unsigned xb_xcc_id() { return (unsigned)__builtin_amdgcn_s_getreg((3 << 11) | 20) & 0xFu; }
#define XB_SPIN(cond, bar) do { unsigned _sp = 0; while (cond) { __builtin_amdgcn_s_sleep(1); \
    if ((++_sp & 255u) == 0u) { if (xb_ld(&(bar)[XB_TMO])) break; if (_sp > XB_SPIN_CAP) { atomicAdd(&(bar)[XB_TMO], 1u); break; } } } } while (0)
struct XcdBarrier { unsigned* bar; unsigned x; volatile LAS unsigned* st; };
__device__ __forceinline__ XcdBarrier xcd_barrier_post(unsigned* bar, volatile LAS unsigned* st) {
    XcdBarrier b; b.bar = bar; b.x = xb_xcc_id(); b.st = st;
    if (threadIdx.x == 0) (void)xb_add(&bar[XB_XCNT(b.x)], 1u);
    return b;
}
__device__ __forceinline__ void xcd_barrier_complete(unsigned* bar, unsigned x, unsigned& nloc, unsigned& nx) {
    const unsigned G = gridDim.x * gridDim.y * gridDim.z;
    unsigned sum, cnt, mine, sp = 0u;
    for (;;) {
        sum = 0u; cnt = 0u; mine = 0u;
#pragma unroll
        for (unsigned j = 0; j < 16; ++j) { const unsigned c = xb_ld(&bar[XB_XCNT(j)]); sum += c; cnt += (c > 0u) ? 1u : 0u; mine = (j == x) ? c : mine; }
        if (sum == G) break;
        __builtin_amdgcn_s_sleep(1);
        if ((++sp & 255u) == 0u) { if (xb_ld(&bar[XB_TMO])) break; if (sp > XB_SPIN_CAP) { atomicAdd(&bar[XB_TMO], 1u); break; } }
    }
    nloc = mine > 0u ? mine : 1u; nx = cnt > 0u ? cnt : 1u;
}
__device__ __forceinline__ void xcd_barrier(const XcdBarrier& b, const bool leader) {
    asm volatile("s_waitcnt vmcnt(0)" ::: "memory");
    __syncthreads();
    if (leader) {
        unsigned* bar = b.bar; unsigned bx_ = b.x;
        asm volatile("" : "+s"(bar), "+s"(bx_));
        __builtin_amdgcn_s_waitcnt(0);
        unsigned nloc = b.st[0], nx = b.st[1];
        if (nloc == 0u) { xcd_barrier_complete(bar, bx_, nloc, nx); b.st[0] = nloc; b.st[1] = nx; }
        const unsigned old = xb_add(&bar[XB_XSUB(bx_)], 1u);
        const unsigned gen = old / nloc;
        if (old + 1u == (gen + 1u) * nloc) {
            __builtin_amdgcn_fence(__ATOMIC_RELEASE, "agent");
            asm volatile("s_waitcnt vmcnt(0)" ::: "memory");
            const unsigned og = xb_add(&bar[XB_TOP], 1u);
            const unsigned tg = og / nx;
            if (og + 1u == (tg + 1u) * nx) xb_add(&bar[XB_TOPGEN], 1u);
            else XB_SPIN(xb_ld(&bar[XB_TOPGEN]) == tg, bar);
            __builtin_amdgcn_fence(__ATOMIC_ACQUIRE, "agent");
            xb_add(&bar[XB_XGEN(bx_)], 1u);
            asm volatile("s_waitcnt vmcnt(0)" ::: "memory");
        } else {
            XB_SPIN(xb_ld(&bar[XB_XGEN(bx_)]) == gen, bar);
            __builtin_amdgcn_fence(__ATOMIC_ACQUIRE, "agent");
            asm volatile("s_waitcnt vmcnt(0)" ::: "memory");
        }
    }
    __syncthreads();
}

struct Frame {
    LAS unsigned char* lds;
    unsigned char* ws;
    float* out;
    int tid, lane, wave, bx;
    static constexpr int G = 256;
};
enum { I_XP = 0, I_XS, I_CK, I_CV, I_CP, I_CS, I_WADA, I_BADA, I_WIN, I_SINK, I_SG, I_SB, I_SW, I_SBS, I_WPA, I_WPB, I_WO, I_LNG, I_LNB };
__device__ __forceinline__ const float* inp(const Frame& F, int k) {
    volatile LAS unsigned* t = (volatile LAS unsigned*)(F.lds + PTAB_OFF) + 2 * k;
    const unsigned lo = __builtin_amdgcn_readfirstlane(t[0]), hi = __builtin_amdgcn_readfirstlane(t[1]);
    return (const float*)(const GAS float*)(((unsigned long long)hi << 32) | lo);
}
#define WSP(T, off) ((T*)(F.ws + (off)))
__device__ __forceinline__ int row_seq(int row) { return row < MP ? (row >> 11) : 4 + ((row - MP) >> 2); }

__device__ __forceinline__ void ada_item(Frame& F, int item) {
    const int l = item / 96, cb = item % 96;
    LAS float* sc = (LAS float*)(F.lds);
    LAS float* red = (LAS float*)(F.lds + 40960);
    const float* W = inp(F, I_WADA) + (size_t)l * D * NMOD + cb * 128;
    const float* cp = inp(F, I_CP); const float* cs = inp(F, I_CS);
    const int half = F.lane >> 5, c4 = (F.lane & 31) * 4;
    f32x4 acc[18];
#pragma unroll
    for (int s = 0; s < 18; ++s) acc[s] = (f32x4){0.f, 0.f, 0.f, 0.f};
    f32x4 w[8];
    const float* Wl = W + (size_t)(F.wave * 16) * NMOD + c4;
#pragma unroll
    for (int j = 0; j < 8; ++j) w[j] = __builtin_nontemporal_load((const f32x4*)(Wl + (size_t)j * NMOD));
    const int sq0 = F.tid >> 7, kk = F.tid & 127;
    float cv[9];
    cv[0] = cp[sq0 * D + kk];
#pragma unroll
    for (int j = 1; j < 9; ++j) cv[j] = cs[(sq0 + 4 * j - 4) * D + kk];
    for (int ch = 0; ch < 32; ++ch) {
        LAS float* scb = sc + (ch & 1) * 5120;
#pragma unroll
        for (int j = 0; j < 9; ++j) { const int s = sq0 + 4 * j; scb[kk * 40 + (s < 18 ? s : s + 2)] = siluf_(cv[j]); }
        { const int cn = (ch + 1 < 32 ? ch + 1 : ch) * 128 + kk;
          cv[0] = cp[sq0 * D + cn];
#pragma unroll
          for (int j = 1; j < 9; ++j) cv[j] = cs[(sq0 + 4 * j - 4) * D + cn]; }
        __syncthreads();
#pragma unroll
        for (int h2 = 0; h2 < 2; ++h2) {
            const float* Wn = Wl + (size_t)((h2 == 0 ? ch * 128 + 8 : (ch + 1 < 32 ? (ch + 1) * 128 : ch * 128))) * NMOD;
            f32x4 ac[5];
            { const LAS f32x4* a4 = (const LAS f32x4*)(scb + (F.wave * 16 + h2 * 8) * 40 + half * 20);
#pragma unroll
              for (int s4 = 0; s4 < 5; ++s4) ac[s4] = a4[s4]; }
#pragma unroll
            for (int j = 0; j < 8; ++j) {
                f32x4 an[5];
                if (j + 1 < 8) { const LAS f32x4* a4 = (const LAS f32x4*)(scb + (F.wave * 16 + h2 * 8 + j + 1) * 40 + half * 20);
#pragma unroll
                    for (int s4 = 0; s4 < 5; ++s4) an[s4] = a4[s4]; }
                const f32x4 wv = w[j];
#pragma unroll
                for (int s4 = 0; s4 < 5; ++s4) { const f32x4 a = ac[s4];
                    acc[4 * s4 + 0] += a.x * wv; acc[4 * s4 + 1] += a.y * wv;
                    if (s4 < 4) { acc[4 * s4 + 2] += a.z * wv; acc[4 * s4 + 3] += a.w * wv; } }
                w[j] = __builtin_nontemporal_load((const f32x4*)(Wn + (size_t)j * NMOD));
                if (j + 1 < 8) {
#pragma unroll
                    for (int s4 = 0; s4 < 5; ++s4) ac[s4] = an[s4]; }
                __builtin_amdgcn_sched_barrier(0);
            }
        }
    }
    float* mod = WSP(float, WS_MOD); const float* bada = inp(F, I_BADA);
#pragma unroll
    for (int p = 0; p < 2; ++p) {
        __syncthreads();
#pragma unroll
        for (int s9 = 0; s9 < 9; ++s9) *(LAS f32x4*)(red + (F.wave * 18 + half * 9 + s9) * 128 + c4) = acc[p * 9 + s9];
        __syncthreads();
        for (int i = F.tid; i < 18 * 128; i += 512) { const int r = i >> 7, c = i & 127; float v = 0.f;
#pragma unroll
            for (int w8 = 0; w8 < 8; ++w8) v += red[(w8 * 18 + r) * 128 + c];
            const int sq = (r < 9) ? p * 9 + r : 18 + p * 9 + (r - 9), col = cb * 128 + c;
            mod[(size_t)(l * NSEQ + sq) * NMOD + col] = v + bada[l * NMOD + col]; }
    }
    __syncthreads();
}

__device__ __forceinline__ void tr_load(const float* src, int Nsrc, int lane, float (&v)[32]) {
    unsigned off = (unsigned)((lane >> 5) * Nsrc + (lane & 31)) * 4u; const unsigned step = (unsigned)Nsrc * 8u;
#pragma unroll
    for (int i = 0; i < 32; ++i) { v[i] = __builtin_nontemporal_load((const float*)((const char*)src + off)); off += step; }
}
__device__ __forceinline__ void tr_store(void* dst, int f8, float scale, LAS float* scr, int lane, const float (&v)[32]) {
#pragma unroll
    for (int i = 0; i < 32; ++i) scr[(2 * i + (lane >> 5)) * 33 + (lane & 31)] = v[i];
    LDS_WAIT(); asm volatile("" ::: "memory");
    const int c = lane & 7;
#pragma unroll
    for (int j = 0; j < 4; ++j) { const int n = (lane >> 3) + 8 * j; const LAS float* s = scr + (8 * c) * 33 + n;
        if (f8) { v2u o; o.x = pk4_fp8(s[0 * 33] * scale, s[1 * 33] * scale, s[2 * 33] * scale, s[3 * 33] * scale); o.y = pk4_fp8(s[4 * 33] * scale, s[5 * 33] * scale, s[6 * 33] * scale, s[7 * 33] * scale);
            *(GAS v2u*)((unsigned char*)dst + (size_t)n * PB8 + 8 * c) = o; }
        else { v4u o; o.x = pg8::cvt_pk_bf16(s[0 * 33], s[1 * 33]); o.y = pg8::cvt_pk_bf16(s[2 * 33], s[3 * 33]); o.z = pg8::cvt_pk_bf16(s[4 * 33], s[5 * 33]); o.w = pg8::cvt_pk_bf16(s[6 * 33], s[7 * 33]);
            *(GAS v4u*)((bf16*)dst + (size_t)n * LDK + 8 * c) = o; } }
    LDS_WAIT(); asm volatile("" ::: "memory");
}
__host__ __device__ __forceinline__ int win_row(int c) {
    if (c < 4608) return c;
    if (c < 6656) { const int j = (c - 4608) >> 7, i = (c - 4608) & 127; return 4608 + 256 * j + i; }
    if (c < 8704) return 8704 + (c - 6656);
    if (c < 10752) { const int j = (c - 8704) >> 7, i = (c - 8704) & 127; return 4608 + 256 * j + 128 + i; }
    if (c < 14848) { const int j = (c - 10752) >> 7, i = (c - 10752) & 127; return 10752 + 256 * j + i; }
    { const int j = (c - 14848) >> 7, i = (c - 14848) & 127; return 10752 + 256 * j + 128 + i; }
}
constexpr int I_IN = 64 * 592, I_PA = 32 * 128, I_O = 64 * 128, I_LAYER = I_IN + 2 * I_PA + I_O, I_TR = 2 * I_LAYER, I_WS = 128, I_ALL = I_TR + I_WS;
static_assert(I_TR % 8 == 0 && I_WS % 8 == 0 && I_IN % 8 == 0, "chunks of 8 items never straddle the item kinds");
__device__ __forceinline__ void tr_desc(Frame& F, int it, const float*& src, int& Nsrc, void*& dst, void*& dst2, int& f8, float& scale) {
    const int l = it / I_LAYER; int r = it % I_LAYER; f8 = 0; scale = 1.f; dst2 = nullptr;
    if (r < I_IN) { const int kb = r / 592, nb = r % 592, wrow = win_row(32 * nb); Nsrc = NIN; f8 = 1; scale = SWI;
        src = inp(F, I_WIN) + (size_t)l * D * NIN + (size_t)(64 * kb) * NIN + 32 * nb; dst = WSP(unsigned char, WS_WIN8) + (size_t)l * NIN * PB8 + (size_t)wrow * PB8 + 64 * kb;
        if ((wrow >= 2048 && wrow < 2560) || (wrow >= 8704 && wrow < 10752)) { f8 = 2; dst2 = WSP(bf16, WS_WIN) + (size_t)l * NIN * LDK + (size_t)wrow * LDK + 64 * kb; }
        return; }
    r -= I_IN; Nsrc = D; f8 = 1; scale = SWP;
    if (r < I_PA) { const int kb = r / 128, nb = r % 128;
        src = inp(F, I_WPA) + (size_t)l * DA * D + (size_t)(64 * kb) * D + 32 * nb; dst = WSP(unsigned char, WS_WP) + (size_t)l * D * PB8 + (size_t)(32 * nb) * PB8 + 64 * kb; return; }
    r -= I_PA;
    if (r < I_PA) { const int kb = r / 128, nb = r % 128;
        src = inp(F, I_WPB) + (size_t)l * DSG * D + (size_t)(64 * kb) * D + 32 * nb; dst = WSP(unsigned char, WS_WP) + (size_t)l * D * PB8 + (size_t)(32 * nb) * PB8 + 2048 + 64 * kb; return; }
    r -= I_PA; scale = SWO;
    { const int kb = r / 128, nb = r % 128;
        src = inp(F, I_WO) + (size_t)l * D * D + (size_t)(64 * kb) * D + 32 * nb; dst = WSP(unsigned char, WS_WO) + (size_t)l * D * PB8 + (size_t)(32 * nb) * PB8 + 64 * kb; }
}
__device__ __forceinline__ void copy_chunk(Frame& F, int base, LAS float* scr) {
    if (base >= I_TR) {
        const float* sw = inp(F, I_SW); bf16* Wsb = WSP(bf16, WS_WSB);
        for (int it = base; it < base + 8; ++it) { const int e0 = (it - I_TR) * 2048 + F.lane * 4;
#pragma unroll
            for (int j = 0; j < 8; ++j) { const int e = e0 + j * 256; const f32x4 v = *(const f32x4*)(sw + e); const int s = e & 127, t = (e >> 7) & 127;
                v2u o; o.x = pk2(s <= t ? v.x : 0.f, s + 1 <= t ? v.y : 0.f); o.y = pk2(s + 2 <= t ? v.z : 0.f, s + 3 <= t ? v.w : 0.f);
                *(GAS v2u*)(Wsb + e) = o; } }
        return;
    }
    float va[32], vb[32]; const float* src; int ns; void *da, *db, *da2, *db2; int fa, fb; float sa, sb;
    tr_desc(F, base, src, ns, da, da2, fa, sa); tr_load(src, ns, F.lane, va);
#pragma unroll 1
    for (int j = 0; j < 8; j += 2) {
        tr_desc(F, base + j + 1, src, ns, db, db2, fb, sb); tr_load(src, ns, F.lane, vb);
        tr_store(da, fa != 0, sa, scr, F.lane, va); if (fa == 2) tr_store(da2, 0, 1.f, scr, F.lane, va);
        if (j + 2 < 8) { tr_desc(F, base + j + 2, src, ns, da, da2, fa, sa); tr_load(src, ns, F.lane, va); }
        tr_store(db, fb != 0, sb, scr, F.lane, vb); if (fb == 2) tr_store(db2, 0, 1.f, scr, F.lane, vb);
    }
}

__device__ __forceinline__ int pull8(gu32* q, int nchunks, int& s, int& left, int lane) {
    while (left > 0) { int k = 0; if (lane == 0) k = (int)__hip_atomic_fetch_add((unsigned*)(q + 64 * s), 1u, RLX_AGENT);
        const int c = 8 * __builtin_amdgcn_readfirstlane(k) + s; if (c < nchunks) return 8 * c;
        s = (s + 1) & 7; --left; }
    return -1; }
__device__ __forceinline__ void steal_copies(Frame& F, bool until_done, int q, int quota) {
    gu32* ctl = (gu32*)(F.ws + WS_CTL); LAS float* scr = (LAS float*)(F.lds + F.wave * 16384);
    gu32* head = ctl + (q == 1 ? CW_WORK1 : CW_WORK2); const int n = q == 1 ? I_IN : I_LAYER - I_IN, base = q == 1 ? I_LAYER : I_LAYER + I_IN;
    int sh = F.bx & 7, left = 8;
    for (int it = 0; it < quota; ++it) {
        if (until_done) { unsigned d = 0; if (F.lane == 0) d = __hip_atomic_load((unsigned*)(ctl + CW_DONE1), RLX_AGENT); if ((unsigned)__builtin_amdgcn_readfirstlane(d) >= (unsigned)Frame::G) break; }
        const int v = pull8(head, n / 8, sh, left, F.lane); if (v < 0) break;
        copy_chunk(F, base + v, scr);
    }
}

__device__ __forceinline__ void h_rows(Frame& F, const float* x, int row0, int nrows, int seq, int slice, int l) {
    const int col = slice * 1024 + F.lane * 4;
    const float* md = WSP(float, WS_MOD) + (size_t)(l * NSEQ + seq) * NMOD; bf16* Hb = WSP(bf16, WS_HB); unsigned char* Hb8 = WSP(unsigned char, WS_HB8);
    const bool wb = row0 >= MP || (row0 & 2047) >= 1792;
    f32x4 sh[4], sc[4];
#pragma unroll
    for (int j = 0; j < 4; ++j) { sh[j] = *(const f32x4*)(md + col + 256 * j); sc[j] = *(const f32x4*)(md + D + col + 256 * j) + 1.0f; }
    for (int r0 = 0; r0 < nrows; r0 += 4) {
        f32x4 xv[4][4];
#pragma unroll
        for (int rr = 0; rr < 4; ++rr)
#pragma unroll
            for (int j = 0; j < 4; ++j) xv[rr][j] = *(const f32x4*)(x + (size_t)(r0 + rr) * D + col + 256 * j);
#pragma unroll
        for (int rr = 0; rr < 4; ++rr) { const int r = r0 + rr;
#pragma unroll
            for (int j = 0; j < 4; ++j) { const f32x4 v = xv[rr][j] * sc[j] + sh[j];
                *(GAS unsigned*)(Hb8 + (size_t)(row0 + r) * PB8 + col + 256 * j) = pk4_fp8(v.x * SH8, v.y * SH8, v.z * SH8, v.w * SH8);
                if (wb) { v2u o; o.x = pk2(v.x, v.y); o.y = pk2(v.z, v.w); *(GAS v2u*)(Hb + (size_t)(row0 + r) * LDK + col + 256 * j) = o; } } }
    }
}

constexpr int G1_NBF = 18, G1_NF8W = 256 - G1_NBF, G1_UNITS = 33 * 74;
struct OrderF8 { int c;
    __device__ __forceinline__ bool next(int i, pg8::Unit& u) const {
        int L;
        if (i < 8) L = i * 256 + c;
        else { if (c >= G1_NF8W) return false; L = 2048 + (i - 8) * G1_NF8W + c; if (L >= G1_UNITS) return false; }
        pg8::StaticOrderC<MPAD, NIN>::map(L, u); return true; }
    __device__ __forceinline__ void a_ready(const pg8::Unit&) const {}
    __device__ __forceinline__ void done(const pg8::Unit&) const {} };
struct OrderBf { int c;
    __device__ __forceinline__ bool next(int i, pg8::Unit& u) const {
        const int j = c - G1_NF8W; if (i != 0 || j < 0) return false;
        if (j < 8) { u.pm = 8 * (j >> 1) + 7; u.pn = 8 + (j & 1); }
        else { const int jj = j - 8; u.pm = 32; u.pn = jj < 2 ? 8 + jj : 34 + (jj - 2); }
        return true; }
    __device__ __forceinline__ void a_ready(const pg8::Unit&) const {}
    __device__ __forceinline__ void done(const pg8::Unit&) const {} };

__host__ __device__ __forceinline__ bool is_bf16_unit(int pm, int pn) { return ((pn == 8 || pn == 9) && ((pm & 7) == 7 || pm == 32)) || (pm == 32 && pn >= 34 && pn < 42); }
template <bool F8> struct EpiInT {
    static constexpr bool PERM = true, MIDK = false;
    unsigned char* ws; float* outl;
    int l;
    __device__ __forceinline__ void mid(pg8::f32x4 (&)[2][2][4][2], const pg8::Unit&, int, int, int, int) const {}
    __device__ __forceinline__ void operator()(const pg8::f32x4 (&acc)[2][2][4][2], const pg8::Unit& u, int wr, int wc, int fr_, int fq_) const {
        if (F8 && is_bf16_unit(u.pm, u.pn)) return;
        constexpr float DS = F8 ? 1.0f / (SH8 * SWI) : 1.0f;
        const int ln_ = lane_now(), fr = ln_ & 15, fq = ln_ >> 4; (void)fr_; (void)fq_;
        const int row0 = u.pm * 256 + wr * 64 + fr, c8 = wc * 32 + 8 * fq, pn = u.pn;
        if (pn < 8 || (pn >= 10 && pn < 18) || (pn >= 34 && pn < 42)) {
            const int kind = pn < 8 ? 0 : (pn < 18 ? 1 : 2);
            unsigned char* base = kind == 0 ? (ws + WS_QB) + pn * 256 : (kind == 1 ? (ws + WS_ZA) + (pn - 10) * 256 : (ws + WS_VBB) + (pn - 34) * 256);
            const float osc = kind == 0 ? QSCALE * SQ8 : (kind == 1 ? SZA8 : SVB8);
            f32x2* vst = (f32x2*)(ws + WS_VST);
#pragma unroll
            for (int ai = 0; ai < 2; ++ai)
#pragma unroll
                for (int m = 0; m < 4; ++m) { const int row = row0 + ai * 128 + m * 16; unsigned char* rowp = base + (size_t)row * 2048 + c8; float s1 = 0.f, s2 = 0.f;
#pragma unroll
                    for (int bj = 0; bj < 2; ++bj) { f32x4 v0 = acc[ai][bj][m][0] * DS, v1 = acc[ai][bj][m][1] * DS;
                        if (kind == 1) { v0 = (f32x4){siluf_(v0.x), siluf_(v0.y), siluf_(v0.z), siluf_(v0.w)}; v1 = (f32x4){siluf_(v1.x), siluf_(v1.y), siluf_(v1.z), siluf_(v1.w)}; }
                        if (kind == 2) { s1 += (v0.x + v0.y) + (v0.z + v0.w) + (v1.x + v1.y) + (v1.z + v1.w);
                                         s2 += (v0.x * v0.x + v0.y * v0.y) + (v0.z * v0.z + v0.w * v0.w) + (v1.x * v1.x + v1.y * v1.y) + (v1.z * v1.z + v1.w * v1.w); }
                        if (!F8 && kind == 2) {
                            v4u w; w.x = pg8::cvt_pk_bf16(v0.x, v0.y); w.y = pg8::cvt_pk_bf16(v0.z, v0.w); w.z = pg8::cvt_pk_bf16(v1.x, v1.y); w.w = pg8::cvt_pk_bf16(v1.z, v1.w);
                            *(v4u*)((bf16*)(ws + WS_VBS) + (size_t)(row - MP) * 2048 + (pn - 34) * 256 + c8 + bj * 128) = w;
                        } else {
                            v0 = v0 * osc; v1 = v1 * osc;
                            v2u w; w.x = pk4_fp8(v0.x, v0.y, v0.z, v0.w); w.y = pk4_fp8(v1.x, v1.y, v1.z, v1.w);
                            *(v2u*)(rowp + bj * 128) = w; } }
                    if (kind == 2) { s1 = xadd<32>(xadd<16>(s1)); s2 = xadd<32>(xadd<16>(s2));
                        if (fq == 0) vst[(size_t)row * 32 + (pn - 34) * 4 + wc] = (f32x2){s1, s2}; }
                }
        } else if (pn < 10) {
            bf16* base = (bf16*)(ws + (pn == 8 ? WS_KB : WS_VB));
            float* ow = outl + (pn == 8 ? O_WK : O_WV) + (size_t)l * 131072; float* on = outl + (pn == 8 ? O_NK : O_NV) + (size_t)l * 32768;
#pragma unroll
            for (int ai = 0; ai < 2; ++ai)
#pragma unroll
                for (int m = 0; m < 4; ++m) { const int row = row0 + ai * 128 + m * 16; bf16* rowp = base + (size_t)row * 256 + c8;
                    const int rin = wr * 64 + m * 16 + fr;
                    float* fo = nullptr;
                    if (!F8) { if (u.pm < 32) { if ((u.pm & 7) == 7 && ai == 1) fo = ow + ((size_t)(u.pm >> 3) * 128 + rin) * 256; } else if (ai == 0) fo = on + (size_t)rin * 256; }
#pragma unroll
                    for (int bj = 0; bj < 2; ++bj) { const f32x4 v0 = acc[ai][bj][m][0] * DS, v1 = acc[ai][bj][m][1] * DS;
                        v4u w; w.x = pg8::cvt_pk_bf16(v0.x, v0.y); w.y = pg8::cvt_pk_bf16(v0.z, v0.w); w.z = pg8::cvt_pk_bf16(v1.x, v1.y); w.w = pg8::cvt_pk_bf16(v1.z, v1.w);
                        *(v4u*)(rowp + bj * 128) = w;
                        if (fo) { *(f32x4*)(fo + bj * 128 + c8) = v0; *(f32x4*)(fo + bj * 128 + c8 + 4) = v1; } }
                }
        } else if (pn < 34) {
            unsigned char* base = (ws + WS_UZ) + (pn - 18) * 128;
#pragma unroll
            for (int ai = 0; ai < 2; ++ai)
#pragma unroll
                for (int m = 0; m < 4; ++m) { const int row = row0 + ai * 128 + m * 16;
                    const f32x4 u0 = acc[ai][0][m][0] * DS, u1 = acc[ai][0][m][1] * DS, z0 = acc[ai][1][m][0] * DS, z1 = acc[ai][1][m][1] * DS;
                    v2u w; w.x = pk4_fp8(u0.x * siluf_(z0.x) * SUZ8, u0.y * siluf_(z0.y) * SUZ8, u0.z * siluf_(z0.z) * SUZ8, u0.w * siluf_(z0.w) * SUZ8);
                    w.y = pk4_fp8(u1.x * siluf_(z1.x) * SUZ8, u1.y * siluf_(z1.y) * SUZ8, u1.z * siluf_(z1.z) * SUZ8, u1.w * siluf_(z1.w) * SUZ8);
                    *(v2u*)(base + (size_t)row * 2048 + c8) = w; }
        } else {
            const int cb = (pn - 42) * 128 + c8; bf16* RR = (bf16*)(ws + WS_RR); unsigned char* SGB = ws + WS_SGB;
#pragma unroll
            for (int ai = 0; ai < 2; ++ai)
#pragma unroll
                for (int m = 0; m < 4; ++m) { const int row = row0 + ai * 128 + m * 16;
                    float ra[8], sb[8];
#pragma unroll
                    for (int n = 0; n < 2; ++n)
#pragma unroll
                        for (int e = 0; e < 4; ++e) {
                            const float xa = __builtin_amdgcn_fmed3f(acc[ai][0][m][n][e] * (-DS * LOG2E), -60.0f, 60.0f), xb = __builtin_amdgcn_fmed3f(acc[ai][1][m][n][e] * (-DS * LOG2E), -60.0f, 60.0f);
                            const float pa = 1.0f + __builtin_amdgcn_exp2f(xa), pb = 1.0f + __builtin_amdgcn_exp2f(xb), r = __builtin_amdgcn_rcpf(pa * pb);
                            sb[n * 4 + e] = fmaxf(r * pa, 1.52587890625e-05f);
                            ra[n * 4 + e] = fminf(pb, 65536.0f) * (r * pb); }
                    v4u w; w.x = pg8::cvt_pk_bf16(ra[0], ra[1]); w.y = pg8::cvt_pk_bf16(ra[2], ra[3]); w.z = pg8::cvt_pk_bf16(ra[4], ra[5]); w.w = pg8::cvt_pk_bf16(ra[6], ra[7]);
                    *(v4u*)(RR + (size_t)row * D + cb) = w;
                    v2u x; x.x = pk4_fp8(sb[0] * SG8, sb[1] * SG8, sb[2] * SG8, sb[3] * SG8); x.y = pk4_fp8(sb[4] * SG8, sb[5] * SG8, sb[6] * SG8, sb[7] * SG8);
                    *(v2u*)(SGB + (size_t)row * D + cb) = x; }
        }
    }
};

struct EpiMerge {
    static constexpr bool PERM = true, MIDK = true;
    const bf16* RR; const unsigned char* SGB; unsigned char* MG;
    __device__ __forceinline__ void mid(pg8::f32x4 (&acc)[2][2][4][2], const pg8::Unit& u, int wr, int wc, int, int) const {
        const int ln_ = lane_now(), fr = ln_ & 15, fq = ln_ >> 4;
        unsigned off0 = ((unsigned)(u.pm * 256 + wr * 64 + fr) * D + (unsigned)(u.pn * 256 + wc * 32 + 8 * fq)) * 2u;
        asm volatile("" : "+v"(off0));
        v4u w[2][4][2];
#pragma unroll
        for (int ai = 0; ai < 2; ++ai)
#pragma unroll
            for (int m = 0; m < 4; ++m)
#pragma unroll
                for (int bj = 0; bj < 2; ++bj) w[ai][m][bj] = *(const v4u*)((const char*)RR + off0 + (unsigned)((ai * 128 + m * 16) * D * 2) + bj * 256);
#pragma unroll
        for (int ai = 0; ai < 2; ++ai) {
#pragma unroll
            for (int m = 0; m < 4; ++m)
#pragma unroll
                for (int bj = 0; bj < 2; ++bj) { const v4u x = w[ai][m][bj];
                    acc[ai][bj][m][0] = acc[ai][bj][m][0] * ((f32x4){bflo(x.x), bfhi(x.x), bflo(x.y), bfhi(x.y)} * (SB8 / SA8));
                    acc[ai][bj][m][1] = acc[ai][bj][m][1] * ((f32x4){bflo(x.z), bfhi(x.z), bflo(x.w), bfhi(x.w)} * (SB8 / SA8)); }
            asm volatile("" ::: "memory");
        }
    }
    __device__ __forceinline__ void operator()(const pg8::f32x4 (&acc)[2][2][4][2], const pg8::Unit& u, int wr, int wc, int, int) const {
        const int ln_ = lane_now(), fr = ln_ & 15, fq = ln_ >> 4;
        unsigned off0 = (unsigned)(u.pm * 256 + wr * 64 + fr) * D + (unsigned)(u.pn * 256 + wc * 32 + 8 * fq);
        asm volatile("" : "+v"(off0));
        const unsigned offm = (unsigned)(u.pm * 256 + wr * 64 + fr) * (unsigned)PB8 + (unsigned)(u.pn * 256 + wc * 32 + 8 * fq);
        v2u sv[2][4][2];
#pragma unroll
        for (int ai = 0; ai < 2; ++ai)
#pragma unroll
            for (int m = 0; m < 4; ++m)
#pragma unroll
                for (int bj = 0; bj < 2; ++bj) sv[ai][m][bj] = *(const v2u*)(SGB + off0 + (unsigned)((ai * 128 + m * 16) * D) + bj * 128);
#pragma unroll
        for (int ai = 0; ai < 2; ++ai) {
#pragma unroll
            for (int m = 0; m < 4; ++m)
#pragma unroll
                for (int bj = 0; bj < 2; ++bj) { const v2u s = sv[ai][m][bj];
                    const f32x4 v0 = acc[ai][bj][m][0] * (f8x4(s.x) * (SMG / (SB8 * SWP * SG8)));
                    const f32x4 v1 = acc[ai][bj][m][1] * (f8x4(s.y) * (SMG / (SB8 * SWP * SG8)));
                    v2u w; w.x = pk4_fp8(v0.x, v0.y, v0.z, v0.w); w.y = pk4_fp8(v1.x, v1.y, v1.z, v1.w);
                    *(v2u*)(MG + offm + (unsigned)((ai * 128 + m * 16) * PB8) + bj * 128) = w; }
            asm volatile("" ::: "memory");
        }
    }
};

template <int L> struct EpiOutT {
    static constexpr bool PERM = false, MIDK = false;
    const float* xp; const bf16* rb0; const f32x2* st0; const float *g0, *b0;
    const float* gate;
    bf16* rb; f32x2* rst;
    __device__ __forceinline__ void mid(pg8::f32x4 (&)[2][2][4][2], const pg8::Unit&, int, int, int, int) const {}
    __device__ __forceinline__ void operator()(const pg8::f32x4 (&acc)[2][2][4][2], const pg8::Unit& u, int wr, int wc, int fr_, int fq_) const {
        const int ln_ = lane_now(), fr = ln_ & 15, fq = ln_ >> 4; (void)fr_; (void)fq_;
        const unsigned col0 = (unsigned)(u.pn * 256 + wc * 32 + 4 * fq);
        const unsigned rowb = (unsigned)(u.pm * 256 + wr * 64 + fr);
        const unsigned eo0 = rowb * D + col0;
        const char* gb = (const char*)(gate + (size_t)(u.pm >> 3) * NMOD) + col0 * 4u;
        f32x4 gv[2][2], g0v[2][2], b0v[2][2];
#pragma unroll
        for (int bj = 0; bj < 2; ++bj)
#pragma unroll
            for (int n = 0; n < 2; ++n) { gv[bj][n] = *(const f32x4*)(gb + (bj * 128 + n * 16) * 4);
                if (L == 1) { g0v[bj][n] = *(const f32x4*)((const char*)g0 + (col0 + bj * 128 + n * 16) * 4u); b0v[bj][n] = *(const f32x4*)((const char*)b0 + (col0 + bj * 128 + n * 16) * 4u); } }
#pragma unroll
        for (int ap = 0; ap < 4; ++ap) { const int ai = ap >> 1, m0 = (ap & 1) * 2;
            f32x4 xv[2][2][2]; v2u xb[2][2][2]; f32x2 st[2];
#pragma unroll
            for (int mm = 0; mm < 2; ++mm) { const unsigned eo = eo0 + (unsigned)((ai * 128 + (m0 + mm) * 16) * D);
                if (L == 1) st[mm] = st0[rowb + (unsigned)(ai * 128 + (m0 + mm) * 16)];
#pragma unroll
                for (int bj = 0; bj < 2; ++bj)
#pragma unroll
                    for (int n = 0; n < 2; ++n) {
                        if (L == 0) xv[mm][bj][n] = *(const f32x4*)((const char*)xp + (eo + bj * 128 + n * 16) * 4u);
                        else xb[mm][bj][n] = *(const v2u*)((const char*)rb0 + (eo + bj * 128 + n * 16) * 2u); } }
#pragma unroll
            for (int mm = 0; mm < 2; ++mm) { const int m = m0 + mm; const unsigned eo = eo0 + (unsigned)((ai * 128 + m * 16) * D); const unsigned row = rowb + (unsigned)(ai * 128 + m * 16);
                float s1 = 0.f, s2 = 0.f;
#pragma unroll
                for (int bj = 0; bj < 2; ++bj)
#pragma unroll
                    for (int n = 0; n < 2; ++n) { f32x4 x;
                        if (L == 0) x = xv[mm][bj][n];
                        else { const v2u w = xb[mm][bj][n]; x = ((f32x4){bflo(w.x), bfhi(w.x), bflo(w.y), bfhi(w.y)} - st[mm].x) * st[mm].y * g0v[bj][n] + b0v[bj][n]; }
                        const f32x4 r = x * ALPHA + gv[bj][n] * (acc[ai][bj][m][n] * (1.0f / (SMG * SWO)));
                        v2u o; o.x = pg8::cvt_pk_bf16(r.x, r.y); o.y = pg8::cvt_pk_bf16(r.z, r.w);
                        *(v2u*)((char*)rb + (eo + bj * 128 + n * 16) * 2u) = o;
                        s1 += (r.x + r.y) + (r.z + r.w); s2 += (r.x * r.x + r.y * r.y) + (r.z * r.z + r.w * r.w); }
                s1 = xadd<32>(xadd<16>(s1)); s2 = xadd<32>(xadd<16>(s2));
                if (fq == 0) rst[(size_t)row * 64 + u.pn * 4 + wc] = (f32x2){s1, s2};
            }
            asm volatile("" ::: "memory");
        }
    }
};

typedef short bf16x8_t __attribute__((ext_vector_type(8)));
typedef short s16x4_t __attribute__((ext_vector_type(4)));
typedef float f32x16 __attribute__((ext_vector_type(16)));
__device__ __forceinline__ s16x4_t vtr(const LAS char* p) { return __builtin_bit_cast(s16x4_t, __builtin_amdgcn_ds_read_tr16_b64_v4i16((LAS s16x4_t*)p)); }
__device__ __forceinline__ bf16x8_t cat8(s16x4_t a, s16x4_t b) { return (bf16x8_t){a[0], a[1], a[2], a[3], b[0], b[1], b[2], b[3]}; }
#define MFMA32(a, b, c) __builtin_amdgcn_mfma_f32_32x32x16_bf16((a), (b), (c), 0, 0, 0)

__device__ __forceinline__ void attn_prompt_unit(Frame& F, int l, int unit) {
    const int kv = unit & 3, n = (unit >> 2) & 15, b = unit >> 6, tid = F.tid, lane = F.lane;
    LAS char* Kl = (LAS char*)F.lds; LAS char* Vl = Kl + 32768;
    const bf16* Kb = WSP(bf16, WS_KB); const bf16* Vb = WSP(bf16, WS_VB); const unsigned char* Qb = WSP(unsigned char, WS_QB); const unsigned char* Za = WSP(unsigned char, WS_ZA); unsigned char* AB = WSP(unsigned char, WS_AB);
    const int rowq0 = b * SEQ + n * 128, rowk0 = rowq0 - 128;
#pragma unroll
    for (int i = 0; i < 4; ++i) { const int idx = tid + 512 * i;
        { const int chunk = idx >> 8, key = idx & 255; v4u v = (v4u){0u, 0u, 0u, 0u};
          if (n > 0 || key >= 128) v = *(const v4u*)(Kb + (size_t)(rowk0 + key) * 256 + kv * 64 + chunk * 8);
          *(LAS v4u*)(Kl + chunk * 4096 + key * 16) = v; }
        { const int dh = idx >> 10, key = (idx >> 2) & 255, c4 = idx & 3; v4u v = (v4u){0u, 0u, 0u, 0u};
          if (n > 0 || key >= 128) v = *(const v4u*)(Vb + (size_t)(rowk0 + key) * 256 + kv * 64 + dh * 32 + c4 * 8);
          *(LAS v4u*)(Vl + dh * 16384 + key * 64 + c4 * 16) = v; } }
    const int h = lane >> 5, r32 = lane & 31, head = kv * 8 + F.wave;
    v2u qn[4];
#pragma unroll
    for (int ks = 0; ks < 4; ++ks) qn[ks] = *(const v2u*)(Qb + (size_t)(rowq0 + r32) * 2048 + head * 64 + 16 * ks + 8 * h);
    __syncthreads();
    const float sink2 = inp(F, I_SINK)[l * 32 + head] * LOG2E;
    const LAS char* kbase = Kl + h * 4096 + r32 * 16;
    const LAS char* vbase = Vl + (4 * h + ((lane & 15) >> 2)) * 64 + ((lane >> 4) & 1) * 32 + (lane & 3) * 8;
#pragma unroll 1
    for (int c = 0; c < 4; ++c) {
        const size_t qrow = (size_t)(rowq0 + 32 * c + r32);
        bf16x8_t qf[4];
#pragma unroll
        for (int ks = 0; ks < 4; ++ks) { const f32x4 a = f8x4(qn[ks].x) * (1.0f / SQ8), b2 = f8x4(qn[ks].y) * (1.0f / SQ8);
            v4u w; w.x = pg8::cvt_pk_bf16(a.x, a.y); w.y = pg8::cvt_pk_bf16(a.z, a.w); w.z = pg8::cvt_pk_bf16(b2.x, b2.y); w.w = pg8::cvt_pk_bf16(b2.z, b2.w);
            qf[ks] = __builtin_bit_cast(bf16x8_t, w); }
        { const size_t qnext = qrow + (c + 1 < 4 ? 32 : 0);
#pragma unroll
            for (int ks = 0; ks < 4; ++ks) qn[ks] = *(const v2u*)(Qb + qnext * 2048 + head * 64 + 16 * ks + 8 * h); }
        unsigned zv[2][4];
#pragma unroll
        for (int dt = 0; dt < 2; ++dt)
#pragma unroll
            for (int g4 = 0; g4 < 4; ++g4) zv[dt][g4] = *(const unsigned*)(Za + qrow * 2048 + head * 64 + 32 * dt + 8 * g4 + 4 * h);
        f32x16 S[5];
#pragma unroll
        for (int k5 = 0; k5 < 5; ++k5)
#pragma unroll
            for (int r = 0; r < 16; ++r) S[k5][r] = 0.f;
        {
          bf16x8_t kf[2][5];
#pragma unroll
          for (int k5 = 0; k5 < 5; ++k5) kf[0][k5] = *(const LAS bf16x8_t*)(kbase + (32 * (c + k5)) * 16);
#pragma unroll
          for (int ks = 0; ks < 4; ++ks) {
              if (ks + 1 < 4) {
#pragma unroll
                  for (int k5 = 0; k5 < 5; ++k5) kf[(ks + 1) & 1][k5] = *(const LAS bf16x8_t*)(kbase + (2 * (ks + 1)) * 4096 + (32 * (c + k5)) * 16); }
              __builtin_amdgcn_sched_barrier(0);
#pragma unroll
              for (int k5 = 0; k5 < 5; ++k5) S[k5] = MFMA32(kf[ks & 1][k5], qf[ks], S[k5]);
              __builtin_amdgcn_sched_barrier(0);
          } }
        float mx = sink2;
#pragma unroll
        for (int k5 = 0; k5 < 5; ++k5) { const bool dead = (n == 0) && (c + k5 < 4);
            float bm = -INFINITY;
#pragma unroll
            for (int r = 0; r < 16; ++r) { const int kk = (r & 3) + 8 * (r >> 2) + 4 * h; float v = S[k5][r];
                if (k5 == 0) v = (kk > r32) ? v : -INFINITY;
                if (k5 == 4) v = (kk <= r32) ? v : -INFINITY;
                S[k5][r] = v; bm = fmaxf(bm, v); }
            mx = fmaxf(mx, dead ? -INFINITY : bm); }
        mx = xmax<32>(mx);
        float ls = 0.f;
#pragma unroll
        for (int k5 = 0; k5 < 5; ++k5) { const float off = ((n == 0) && (c + k5 < 4)) ? INFINITY : mx;
#pragma unroll
            for (int r = 0; r < 16; ++r) { const float p = __builtin_amdgcn_exp2f(S[k5][r] - off); S[k5][r] = p; ls += p; } }
        ls = xadd<32>(ls); ls += __builtin_amdgcn_exp2f(sink2 - mx);
        f32x16 O[2];
#pragma unroll
        for (int r = 0; r < 16; ++r) { O[0][r] = 0.f; O[1][r] = 0.f; }
        {
          s16x4_t vq[2][2][2];
          const LAS char* vp0 = vbase + (32 * c) * 64;
#pragma unroll
          for (int dt = 0; dt < 2; ++dt) { vq[0][dt][0] = vtr(vp0 + dt * 16384); vq[0][dt][1] = vtr(vp0 + dt * 16384 + 512); }
#pragma unroll
          for (int j = 0; j < 10; ++j) { const int k5 = j >> 1, s = j & 1;
              if (j + 1 < 10) { const LAS char* vp = vp0 + (16 * (j + 1)) * 64;
#pragma unroll
                  for (int dt = 0; dt < 2; ++dt) { vq[(j + 1) & 1][dt][0] = vtr(vp + dt * 16384); vq[(j + 1) & 1][dt][1] = vtr(vp + dt * 16384 + 512); } }
              v4u pw; pw.x = pg8::cvt_pk_bf16(S[k5][8 * s + 0], S[k5][8 * s + 1]); pw.y = pg8::cvt_pk_bf16(S[k5][8 * s + 2], S[k5][8 * s + 3]);
              pw.z = pg8::cvt_pk_bf16(S[k5][8 * s + 4], S[k5][8 * s + 5]); pw.w = pg8::cvt_pk_bf16(S[k5][8 * s + 6], S[k5][8 * s + 7]);
              const bf16x8_t pf = __builtin_bit_cast(bf16x8_t, pw);
              __builtin_amdgcn_sched_barrier(0);
#pragma unroll
              for (int dt = 0; dt < 2; ++dt) O[dt] = MFMA32(cat8(vq[j & 1][dt][0], vq[j & 1][dt][1]), pf, O[dt]);
              __builtin_amdgcn_sched_barrier(0);
          } }
        const float inv = SA8 / (SZA8 * ls);
#pragma unroll
        for (int dt = 0; dt < 2; ++dt)
#pragma unroll
            for (int g4 = 0; g4 < 4; ++g4) { const int d0 = head * 64 + 32 * dt + 8 * g4 + 4 * h;
                const f32x4 z = f8x4(zv[dt][g4]);
                *(unsigned*)(AB + qrow * PB8 + d0) = pk4_fp8(O[dt][4 * g4 + 0] * inv * z.x, O[dt][4 * g4 + 1] * inv * z.y, O[dt][4 * g4 + 2] * inv * z.z, O[dt][4 * g4 + 3] * inv * z.w); }
    }
    __syncthreads();
}
__device__ __forceinline__ void attn_sample_unit(Frame& F, int l, int unit) {
    const int kv = unit & 3, b = unit >> 2, h = kv * 8 + F.wave, lane = F.lane, tid = F.tid;
    LAS float* Kf = (LAS float*)F.lds;
    LAS float* Vf = Kf + 8704;
    LAS float* qs = Kf + 17408 + F.wave * 1024;
    LAS float* ps = qs + 256;
    const unsigned char* Qb = WSP(unsigned char, WS_QB); const unsigned char* Za = WSP(unsigned char, WS_ZA); unsigned char* AB = WSP(unsigned char, WS_AB);
    const int row0 = MP + b * 4;
    const float* ck = inp(F, I_CK) + ((size_t)(l * 32 + b) * 128) * 256 + kv * 64;
    const float* cv = inp(F, I_CV) + ((size_t)(l * 32 + b) * 128) * 256 + kv * 64;
    const float* nk = F.out + O_NK + (size_t)(l * 128 + b * 4) * 256 + kv * 64;
    const float* nv = F.out + O_NV + (size_t)(l * 128 + b * 4) * 256 + kv * 64;
    unsigned char zq[4];
#pragma unroll
    for (int t = 0; t < 4; ++t) zq[t] = Za[(size_t)(row0 + t) * 2048 + h * 64 + lane];
    { f32x4 kx[5], vx[5]; unsigned char qv[4];
#pragma unroll
      for (int j = 0; j < 5; ++j) { const int i = tid + 512 * j, ic = i < 132 * 16 ? i : 132 * 16 - 1, key = ic >> 4, d4 = (ic & 15) * 4;
        kx[j] = *(const f32x4*)((key < 128 ? ck + (size_t)key * 256 : nk + (size_t)(key - 128) * 256) + d4);
        vx[j] = *(const f32x4*)((key < 128 ? cv + (size_t)key * 256 : nv + (size_t)(key - 128) * 256) + d4); }
#pragma unroll
      for (int t = 0; t < 4; ++t) qv[t] = Qb[(size_t)(row0 + t) * 2048 + h * 64 + lane];
#pragma unroll
      for (int j = 0; j < 5; ++j) { const int i = tid + 512 * j, key = i >> 4, d4 = (i & 15) * 4;
        if (i < 132 * 16) { LAS float* kd = Kf + key * 65 + d4; kd[0] = kx[j].x; kd[1] = kx[j].y; kd[2] = kx[j].z; kd[3] = kx[j].w;
            *(LAS f32x4*)(Vf + key * 64 + d4) = vx[j]; } }
#pragma unroll
      for (int t = 0; t < 4; ++t) qs[t * 64 + lane] = f8x1(qv[t]) * (1.0f / SQ8); }
    __syncthreads();
    const float sink2 = inp(F, I_SINK)[l * 32 + h] * LOG2E;
    float sc[3][4];
#pragma unroll
    for (int ps_ = 0; ps_ < 3; ++ps_) {
        const int key = ps_ * 64 + lane; const bool inr = key < 132; const LAS float* kr = Kf + (inr ? key : 0) * 65;
        float s[4] = {0.f, 0.f, 0.f, 0.f};
#pragma unroll 4
        for (int d4 = 0; d4 < 16; ++d4) { const float k0 = kr[d4 * 4], k1 = kr[d4 * 4 + 1], k2 = kr[d4 * 4 + 2], k3 = kr[d4 * 4 + 3];
#pragma unroll
            for (int t = 0; t < 4; ++t) { const f32x4 qx = *(const LAS f32x4*)(qs + t * 64 + d4 * 4); s[t] += (qx.x * k0 + qx.y * k1) + (qx.z * k2 + qx.w * k3); } }
#pragma unroll
        for (int t = 0; t < 4; ++t) { const bool ok = inr && (key < 128 ? key > t : (key - 128) <= t); sc[ps_][t] = ok ? s[t] : -INFINITY; }
    }
#pragma unroll
    for (int t = 0; t < 4; ++t) {
        float mx = fmaxf(fmaxf(sc[0][t], sc[1][t]), fmaxf(sc[2][t], sink2));
        mx = xmax_wave(mx);
        float p0 = __builtin_amdgcn_exp2f(sc[0][t] - mx), p1 = __builtin_amdgcn_exp2f(sc[1][t] - mx), p2 = __builtin_amdgcn_exp2f(sc[2][t] - mx);
        float sum = p0 + p1 + p2;
        sum = xadd_wave(sum);
        const float inv = 1.0f / (sum + __builtin_amdgcn_exp2f(sink2 - mx));
        ps[t * 136 + lane] = p0 * inv; ps[t * 136 + 64 + lane] = p1 * inv; if (lane < 8) ps[t * 136 + 128 + lane] = p2 * inv;
    }
    LDS_WAIT(); asm volatile("" ::: "memory");
    float o[4] = {0.f, 0.f, 0.f, 0.f};
#pragma unroll 4
    for (int key = 0; key < 132; ++key) { const float v = Vf[key * 64 + lane];
#pragma unroll
        for (int t = 0; t < 4; ++t) o[t] += ps[t * 136 + key] * v; }
#pragma unroll
    for (int t = 0; t < 4; ++t) { const size_t row = (size_t)(row0 + t); const float z = f8x1(zq[t]) * (1.0f / SZA8);
        AB[row * PB8 + h * 64 + lane] = (unsigned char)(pk4_fp8(o[t] * z * SA8, 0.f, 0.f, 0.f) & 0xffu); }
    __syncthreads();
}
__device__ __forceinline__ void sgu_prompt_unit(Frame& F, int l, int unit, int par) {
    const int g = unit & 7, n = (unit >> 3) & 15, b = unit >> 7, tid = F.tid, lane = F.lane, w = F.wave;
    LAS f32x2* rs = (LAS f32x2*)(F.lds + 65536) + par * 128;
    LAS char* Lw = (LAS char*)F.lds + w * 8192;
    const f32x2* vst = WSP(f32x2, WS_VST); const unsigned char* Vbb = WSP(unsigned char, WS_VBB); const unsigned char* UZ = WSP(unsigned char, WS_UZ); unsigned char* AB = WSP(unsigned char, WS_AB); const bf16* Wsb = WSP(bf16, WS_WSB);
    const int row0 = b * SEQ + n * 128, colw = g * 256 + 32 * w, h = lane >> 5, r32 = lane & 31, ch = lane & 3;
    f32x2 pst[8];
    { const int row = tid >> 2, part = tid & 3;
#pragma unroll
      for (int k = 0; k < 8; ++k) pst[k] = vst[(size_t)(row0 + row) * 32 + part * 8 + k]; }
    v2u xv[8];
#pragma unroll
    for (int i = 0; i < 8; ++i) xv[i] = *(const v2u*)(Vbb + (size_t)(row0 + (lane >> 2) + 16 * i) * 2048 + colw + ch * 8);
    unsigned uzv[4][4];
#pragma unroll
    for (int tb = 0; tb < 4; ++tb)
#pragma unroll
        for (int g4 = 0; g4 < 4; ++g4) uzv[tb][g4] = *(const unsigned*)(UZ + (size_t)(row0 + 32 * tb + r32) * 2048 + colw + 8 * g4 + 4 * h);
    const float* sg = inp(F, I_SG) + l * 2048 + colw + ch * 8; const float* sb = inp(F, I_SB) + l * 2048 + colw + ch * 8;
    const f32x4 g0 = *(const f32x4*)sg, g1 = *(const f32x4*)(sg + 4), b0 = *(const f32x4*)sb, b1 = *(const f32x4*)(sb + 4);
    const float* bs = inp(F, I_SBS) + (size_t)(l * 8 + g) * 128;
    float bst[4];
#pragma unroll
    for (int tb = 0; tb < 4; ++tb) bst[tb] = bs[32 * tb + r32];
    const bf16* Wg = Wsb + (size_t)(l * 8 + g) * 16384 + 8 * h;
    bf16x8_t bfr[20];
#pragma unroll
    for (int tb = 0; tb < 4; ++tb)
#pragma unroll
        for (int ks = 0; ks < 2 * tb + 2; ++ks) bfr[tb * (tb + 1) + ks] = *(const bf16x8_t*)(Wg + (32 * tb + r32) * 128 + 16 * ks);
    { const int row = tid >> 2, part = tid & 3; float s1 = 0.f, s2 = 0.f;
#pragma unroll
      for (int k = 0; k < 8; ++k) { s1 += pst[k].x; s2 += pst[k].y; }
      s1 = xadd<2>(xadd<1>(s1)); s2 = xadd<2>(xadd<1>(s2));
      const float mean = s1 * (1.0f / 2048.0f), var = s2 * (1.0f / 2048.0f) - mean * mean;
      if (part == 0) rs[row] = (f32x2){mean, 1.0f / sqrtf(var + LN_EPS)}; }
    __syncthreads();
    f32x2 stv[8];
#pragma unroll
    for (int i = 0; i < 8; ++i) stv[i] = rs[(lane >> 2) + 16 * i];
#pragma unroll
    for (int i = 0; i < 8; ++i) { const int sp = (lane >> 2) + 16 * i; const v2u x = xv[i]; const f32x2 st = stv[i];
        const f32x4 v0 = (f8x4(x.x) * (1.0f / SVB8) - st.x) * st.y * g0 + b0;
        const f32x4 v1 = (f8x4(x.y) * (1.0f / SVB8) - st.x) * st.y * g1 + b1;
        v4u o; o.x = pg8::cvt_pk_bf16(v0.x, v0.y); o.y = pg8::cvt_pk_bf16(v0.z, v0.w); o.z = pg8::cvt_pk_bf16(v1.x, v1.y); o.w = pg8::cvt_pk_bf16(v1.z, v1.w);
        *(LAS v4u*)(Lw + sp * 64 + ch * 16) = o; }
    LDS_WAIT(); asm volatile("" ::: "memory");
    bf16x8_t af[8];
    { const LAS char* ap = Lw + (8 * h + ((lane & 15) >> 2)) * 64 + ((lane >> 4) & 1) * 32 + (lane & 3) * 8;
#pragma unroll
      for (int ks = 0; ks < 8; ++ks) af[ks] = cat8(vtr(ap + ks * 1024), vtr(ap + ks * 1024 + 256)); }
#pragma unroll
    for (int tb = 0; tb < 4; ++tb) { const int t = 32 * tb + r32; f32x16 a;
#pragma unroll
        for (int r = 0; r < 16; ++r) a[r] = 0.f;
#pragma unroll
        for (int ks = 0; ks < 2 * tb + 2; ++ks) a = MFMA32(af[ks], bfr[tb * (tb + 1) + ks], a);
        const size_t row = (size_t)(row0 + t);
#pragma unroll
        for (int g4 = 0; g4 < 4; ++g4) { const int c0 = colw + 8 * g4 + 4 * h;
            const f32x4 uz = f8x4(uzv[tb][g4]) * (SB8 / SUZ8);
            *(unsigned*)(AB + row * PB8 + 2048 + c0) = pk4_fp8(uz.x * (a[4 * g4 + 0] + bst[tb]), uz.y * (a[4 * g4 + 1] + bst[tb]), uz.z * (a[4 * g4 + 2] + bst[tb]), uz.w * (a[4 * g4 + 3] + bst[tb])); }
    }
    LDS_WAIT(); asm volatile("" ::: "memory");
}
__device__ __forceinline__ void sgu_sample_unit(Frame& F, int l, int b) {
    const int tid = F.tid, c0 = tid * 4, g = c0 >> 8, row0 = MP + b * 4;
    LAS f32x2* rs = (LAS f32x2*)(F.lds);
    const f32x2* vst = WSP(f32x2, WS_VST); const unsigned char* UZ = WSP(unsigned char, WS_UZ); unsigned char* AB = WSP(unsigned char, WS_AB);
    const bf16* Vbs = WSP(bf16, WS_VBS);
    if (tid < 128) { const int row = tid >> 5, k = tid & 31; const f32x2 p = vst[(size_t)(row0 + row) * 32 + k]; float s1 = p.x, s2 = p.y;
        s1 = xadd_32(s1); s2 = xadd_32(s2);
        const float mean = s1 * (1.0f / 2048.0f), var = s2 * (1.0f / 2048.0f) - mean * mean;
        if (k == 0) rs[row] = (f32x2){mean, 1.0f / sqrtf(var + LN_EPS)}; }
    __syncthreads();
    const f32x4 gn = *(const f32x4*)(inp(F, I_SG) + l * 2048 + c0), bi = *(const f32x4*)(inp(F, I_SB) + l * 2048 + c0);
    f32x4 ln[4];
#pragma unroll
    for (int t = 0; t < 4; ++t) { const v2u w = *(const v2u*)(Vbs + (size_t)(b * 4 + t) * 2048 + c0); const f32x2 st = rs[t];
        ln[t] = ((f32x4){bflo(w.x), bfhi(w.x), bflo(w.y), bfhi(w.y)} - st.x) * st.y * gn + bi;
        *(f32x4*)(F.out + O_SV + ((size_t)(l * 32 + b) * 4 + t) * 2048 + c0) = ln[t]; }
    const float* Wg = inp(F, I_SW) + (size_t)(l * 8 + g) * 16384; const float* bs = inp(F, I_SBS) + (size_t)(l * 8 + g) * 128;
#pragma unroll
    for (int t = 0; t < 4; ++t) { f32x4 a = (f32x4){bs[t], bs[t], bs[t], bs[t]};
#pragma unroll
        for (int s = 0; s <= t; ++s) a += Wg[t * 128 + s] * ln[s];
        const f32x4 uz = f8x4(*(const unsigned*)(UZ + (size_t)(row0 + t) * 2048 + c0)) * (SB8 / SUZ8);
        *(unsigned*)(AB + (size_t)(row0 + t) * PB8 + 2048 + c0) = pk4_fp8(uz.x * a.x, uz.y * a.y, uz.z * a.z, uz.w * a.w); }
    __syncthreads();
}

template <int MODE> __device__ __forceinline__ void skinny_gemm(Frame& F, int l, int unit) {
    const int lane = F.lane, w = F.wave, r16 = lane & 15, kq = lane >> 4, rb = w & 1, cb = w >> 1;
    const int rin = 32 * (unit & 3) + 16 * rb + r16, row = MP + rin, n0 = 64 * (unit >> 2), col = n0 + 16 * cb + 4 * kq;
    LAS char* R0 = (LAS char*)F.lds;
    const int lr = lane >> 5, lc = lane & 31;
    const char* Ag[2]; const char* Bg[4];
#pragma unroll
    for (int i = 0; i < 2; ++i) { const int r = 2 * (2 * w + i) + lr; Ag[i] = (const char*)(MODE == 0 ? WSP(unsigned char, WS_AB) : WSP(unsigned char, WS_MG)) + (size_t)(MP + 32 * (unit & 3) + r) * PB8 + ((lc ^ (r & 15)) & 31) * 16; }
#pragma unroll
    for (int i = 0; i < 4; ++i) { const int r = 2 * (4 * w + i) + lr; Bg[i] = (const char*)(MODE == 0 ? WSP(unsigned char, WS_WP) : WSP(unsigned char, WS_WO)) + (size_t)l * D * PB8 + (size_t)(n0 + r) * PB8 + ((lc ^ (r & 15)) & 31) * 16; }
#define SK_STAGE(blk) do { LAS char* Rd = R0 + ((blk) % 3) * 49152; \
        _Pragma("unroll") for (int i = 0; i < 2; ++i) __builtin_amdgcn_global_load_lds((const unsigned*)(Ag[i] + (blk) * 512), (LAS unsigned*)(Rd + (2 * w + i) * 1024), 16, 0, 0); \
        _Pragma("unroll") for (int i = 0; i < 4; ++i) __builtin_amdgcn_global_load_lds((const unsigned*)(Bg[i] + (blk) * 512), (LAS unsigned*)(Rd + 16384 + (4 * w + i) * 1024), 16, 0, 0); } while (0)
    SK_STAGE(0); SK_STAGE(1);
    f32x4 acc = (f32x4){0.f, 0.f, 0.f, 0.f};
#pragma unroll 1
    for (int blk = 0; blk < 8; ++blk) {
        if (blk + 1 < 8) asm volatile("s_waitcnt vmcnt(6)" ::: "memory");
        else asm volatile("s_waitcnt vmcnt(0)" ::: "memory");
        __builtin_amdgcn_s_barrier(); asm volatile("" ::: "memory");
        if (blk + 2 < 8) SK_STAGE(blk + 2);
        if (MODE == 0 && blk == 4) { const v2u x = *(const v2u*)(WSP(bf16, WS_RR) + (size_t)row * D + col); acc = acc * ((f32x4){bflo(x.x), bfhi(x.x), bflo(x.y), bfhi(x.y)} * (SB8 / SA8)); }
        const LAS char* Ab = R0 + (blk % 3) * 49152 + (16 * rb + r16) * 512; const LAS char* Bb = R0 + (blk % 3) * 49152 + 16384 + (16 * cb + r16) * 512;
        pg8::v4i_t fa[4][2], fb[4][2];
#pragma unroll
        for (int u = 0; u < 4; ++u) { const int c0 = ((8 * u + kq) ^ r16) & 31, c1 = ((8 * u + 4 + kq) ^ r16) & 31;
            fa[u][0] = *(const LAS pg8::v4i_t*)(Ab + c0 * 16); fa[u][1] = *(const LAS pg8::v4i_t*)(Ab + c1 * 16);
            fb[u][0] = *(const LAS pg8::v4i_t*)(Bb + c0 * 16); fb[u][1] = *(const LAS pg8::v4i_t*)(Bb + c1 * 16); }
        __builtin_amdgcn_sched_barrier(0);
#pragma unroll
        for (int u = 0; u < 4; ++u)
            acc = __builtin_amdgcn_mfma_scale_f32_16x16x128_f8f6f4(__builtin_shufflevector(fb[u][0], fb[u][1], 0, 1, 2, 3, 4, 5, 6, 7), __builtin_shufflevector(fa[u][0], fa[u][1], 0, 1, 2, 3, 4, 5, 6, 7), acc, 0, 0, 0, 0x7f7f7f7f, 0, 0x7f7f7f7f);
        asm volatile("s_waitcnt lgkmcnt(0)" ::: "memory");
    }
    __builtin_amdgcn_s_barrier(); asm volatile("" ::: "memory");
#undef SK_STAGE
    if (MODE == 0) {
        const unsigned sg = *(const unsigned*)(WSP(unsigned char, WS_SGB) + (size_t)row * D + col);
        const f32x4 v = acc * (f8x4(sg) * (SMG / (SB8 * SWP * SG8)));
        *(unsigned*)(WSP(unsigned char, WS_MG) + (size_t)row * PB8 + col) = pk4_fp8(v.x, v.y, v.z, v.w);
    } else {
        const float* xr = (l == 0 ? inp(F, I_XS) : WSP(float, WS_X1S)) + (size_t)rin * D + col;
        const float* gr = WSP(float, WS_MOD) + (size_t)(l * NSEQ + 4 + (rin >> 2)) * NMOD + 2 * D + col;
        const f32x4 r = *(const f32x4*)xr * ALPHA + *(const f32x4*)gr * (acc * (1.0f / (SMG * SWO)));
        *(f32x4*)(WSP(float, WS_RS) + (size_t)rin * D + col) = r;
    }
}
__device__ __forceinline__ void ln_sample_row(Frame& F, int l, int rin, float* dst, bool hb) {
    const int row = MP + rin, seq = 4 + (rin >> 2), lane = F.lane;
    const float* rp = WSP(float, WS_RS) + (size_t)rin * D + lane * 4;
    f32x4 v[16]; float s1 = 0.f;
#pragma unroll
    for (int j = 0; j < 16; ++j) { v[j] = *(const f32x4*)(rp + 256 * j); s1 += (v[j].x + v[j].y) + (v[j].z + v[j].w); }
    s1 = xadd_wave(s1);
    const float mean = s1 * (1.0f / 4096.0f); float s2 = 0.f;
#pragma unroll
    for (int j = 0; j < 16; ++j) { v[j] = v[j] - mean; s2 += (v[j].x * v[j].x + v[j].y * v[j].y) + (v[j].z * v[j].z + v[j].w * v[j].w); }
    s2 = xadd_wave(s2);
    const float rstd = 1.0f / sqrtf(s2 * (1.0f / 4096.0f) + LN_EPS);
    const float* lg = inp(F, I_LNG) + l * D + lane * 4; const float* lb = inp(F, I_LNB) + l * D + lane * 4;
    const float* md = WSP(float, WS_MOD) + (size_t)(1 * NSEQ + seq) * NMOD + lane * 4; bf16* Hb = WSP(bf16, WS_HB) + (size_t)row * LDK + lane * 4; unsigned char* Hb8 = WSP(unsigned char, WS_HB8) + (size_t)row * PB8 + lane * 4;
#pragma unroll
    for (int j = 0; j < 16; ++j) { const f32x4 o = v[j] * rstd * *(const f32x4*)(lg + 256 * j) + *(const f32x4*)(lb + 256 * j);
        *(f32x4*)(dst + lane * 4 + 256 * j) = o;
        if (hb) { const f32x4 hv = o * (*(const f32x4*)(md + D + 256 * j) + 1.0f) + *(const f32x4*)(md + 256 * j); v2u p; p.x = pk2(hv.x, hv.y); p.y = pk2(hv.z, hv.w); *(GAS v2u*)(Hb + 256 * j) = p;
            *(GAS unsigned*)(Hb8 + 256 * j) = pk4_fp8(hv.x * SH8, hv.y * SH8, hv.z * SH8, hv.w * SH8); } }
}

__device__ __forceinline__ void ln_rows(Frame& F, int l, int row0, int nrows, int seq, int slice, float* dst  ) {
    const int col = slice * 1024 + F.lane * 4; const bool hb = (l == 0);
    f32x4 gn[4], bi[4], sh[4], sc[4];
    const float* md = WSP(float, WS_MOD) + (size_t)(1 * NSEQ + seq) * NMOD; const float* lg = inp(F, I_LNG) + l * D; const float* lb = inp(F, I_LNB) + l * D;
    const f32x2* rst = WSP(f32x2, WS_RST); const bf16* Rb = l == 0 ? WSP(bf16, WS_RB0) : WSP(bf16, WS_RB1); bf16* Hb = WSP(bf16, WS_HB); unsigned char* Hb8 = WSP(unsigned char, WS_HB8); f32x2* st0 = WSP(f32x2, WS_ST0);
    const bool wb = (row0 & 2047) >= 1792;
#pragma unroll
    for (int j = 0; j < 4; ++j) { gn[j] = *(const f32x4*)(lg + col + 256 * j); bi[j] = *(const f32x4*)(lb + col + 256 * j);
        if (hb) { sh[j] = *(const f32x4*)(md + col + 256 * j); sc[j] = *(const f32x4*)(md + D + col + 256 * j) + 1.0f; } else { sh[j] = (f32x4){0.f, 0.f, 0.f, 0.f}; sc[j] = sh[j]; } }
    for (int r0 = 0; r0 < nrows; r0 += 4) {
      f32x2 pp[4]; v2u wv[4][4];
#pragma unroll
      for (int rr = 0; rr < 4; ++rr) pp[rr] = rst[(size_t)(row0 + r0 + rr) * 64 + F.lane];
#pragma unroll
      for (int rr = 0; rr < 4; ++rr)
#pragma unroll
          for (int j = 0; j < 4; ++j) wv[rr][j] = *(const v2u*)(Rb + (size_t)(row0 + r0 + rr) * D + col + 256 * j);
#pragma unroll
      for (int rr = 0; rr < 4; ++rr) { const int r = r0 + rr;
        float s1 = pp[rr].x, s2 = pp[rr].y;
        s1 = xadd_wave(s1); s2 = xadd_wave(s2);
        const float mean = s1 * (1.0f / 4096.0f), var = s2 * (1.0f / 4096.0f) - mean * mean, rstd = 1.0f / sqrtf(var + LN_EPS);
        if (hb && slice == 0 && F.lane == 0) st0[row0 + r] = (f32x2){mean, rstd};
#pragma unroll
        for (int j = 0; j < 4; ++j) { const v2u w = wv[rr][j];
            const f32x4 v = ((f32x4){bflo(w.x), bfhi(w.x), bflo(w.y), bfhi(w.y)} - mean) * rstd * gn[j] + bi[j];
            if (hb) { const f32x4 hv = v * sc[j] + sh[j]; *(GAS unsigned*)(Hb8 + (size_t)(row0 + r) * PB8 + col + 256 * j) = pk4_fp8(hv.x * SH8, hv.y * SH8, hv.z * SH8, hv.w * SH8);
                if (wb) { v2u o; o.x = pk2(hv.x, hv.y); o.y = pk2(hv.z, hv.w); *(GAS v2u*)(Hb + (size_t)(row0 + r) * LDK + col + 256 * j) = o; } }
            else *(f32x4*)(dst + (size_t)r * D + col + 256 * j) = v; }
      }
    }
}

struct Args { const float* in[19]; float* out; unsigned char* ws; int ph_lo, ph_hi; };
#ifndef PH_MASK
#define PH_MASK 0xfff
#endif
__global__ void __launch_bounds__(NWAVES * 64, 2) mk_fwd(Args args) {
    extern __shared__ __attribute__((aligned(16))) unsigned char lds[];
    Frame F;
    F.lds = (LAS unsigned char*)lds;
    volatile LAS unsigned* MISC = (volatile LAS unsigned*)(F.lds + MISC_OFF);
    F.tid = threadIdx.x; F.lane = F.tid & 63; F.wave = __builtin_amdgcn_readfirstlane(F.tid >> 6); F.bx = blockIdx.x;
    F.ws = args.ws; F.out = args.out;
    gu32* ctl = (gu32*)(F.ws + WS_CTL);
    asm volatile("s_setreg_imm32_b32 hwreg(HW_REG_MODE, 23, 1), 1");
    for (int u = F.tid; u < (LDS_BYTES - LDSCTL_OFF) / 4; u += NWAVES * 64) ((LAS unsigned*)(F.lds + LDSCTL_OFF))[u] = 0u;
    __syncthreads();
    if (F.tid == 0) { volatile LAS unsigned long long* pt = (volatile LAS unsigned long long*)(F.lds + PTAB_OFF);
#pragma unroll
        for (int k = 0; k < 19; ++k) pt[k] = (unsigned long long)args.in[k]; }
    __syncthreads();
#if MK_SPLIT
    const int lo = args.ph_lo, hi = args.ph_hi;
#else
    constexpr int lo = 0, hi = 12;
#endif
    const bool use_bar = (hi - lo) > 1;
    XcdBarrier bar; bar.bar = (unsigned*)(ctl + CW_BAR); bar.x = 0; bar.st = nullptr;
    if (use_bar) bar = xcd_barrier_post((unsigned*)(ctl + CW_BAR), MISC + 8);
#define IN(k) (((PH_MASK >> ((k) > 6 ? (k) - 5 : (k))) & 1) && lo <= (k) && (k) < hi)
#define SEAM(k) do { if (lo <= (k) && (k) + 1 < hi) { REFRESH(); xcd_barrier(bar, F.tid == 0); } } while (0)
#define REFRESH() do { int t_, w_ = wave0, b_ = bx0; asm volatile("v_mbcnt_lo_u32_b32 %0, -1, 0\n\tv_mbcnt_hi_u32_b32 %0, -1, %0" : "=v"(t_), "+s"(w_), "+s"(b_)); F.lane = t_; F.wave = w_; F.bx = b_; F.tid = w_ * 64 + t_; } while (0)
#define GW (F.bx * NWAVES + F.wave)
    const int NGW = F.G * NWAVES; const int wave0 = F.wave, bx0 = F.bx;

    if (IN(0)) {
        asm volatile("; MARK_P0a");
        REFRESH();
        if (F.bx < 192) ada_item(F, F.bx);
        LAS float* scr = (LAS float*)(F.lds + F.wave * 16384);
        int sh = F.bx & 7, left = 8;
        for (;;) {
            const int v = pull8(ctl + CW_WORK0, (I_LAYER + I_WS) / 8, sh, left, F.lane);
            if (v < 0) break;
            copy_chunk(F, v < I_LAYER ? v : I_TR + (v - I_LAYER), scr);
        }
    }
    SEAM(0);
    if (IN(1)) {
        asm volatile("; MARK_P0b");
        REFRESH();
        for (int it = GW; it < 2048 + 128; it += NGW) {
            if (it < 2048) { const int rb = it >> 2, sl = it & 3; h_rows(F, inp(F, I_XP) + (size_t)rb * 16 * D, rb * 16, 16, rb >> 7, sl, 0); }
            else { const int q = it - 2048, sq = q >> 2, sl = q & 3; h_rows(F, inp(F, I_XS) + (size_t)sq * 4 * D, MP + sq * 4, 4, 4 + sq, sl, 0); }
        }
    }
    SEAM(1);
#pragma unroll 1
    for (int l = 0; l < 2; ++l) {
        const int pb = 2 + 5 * l;
        if (IN(pb)) {
            asm volatile("; MARK_GEMM1");
            REFRESH();
            { pg8::Gemm g8{WSP(bf16, WS_HB8), (const bf16*)(WSP(unsigned char, WS_WIN8) + (size_t)l * NIN * PB8), MPAD, NIN, K8};
              OrderF8 S; S.c = F.bx; EpiInT<true> E{F.ws, F.out, l};
              pg8::gemm_phase<K8, LD8, EpiInT<true>, OrderF8, PG8_ALIGN, PG8_SP2, false, true>(F.lds, g8, S, E, F.wave); }
            REFRESH();
            { pg8::Gemm g{WSP(bf16, WS_HB), WSP(bf16, WS_WIN) + (size_t)l * NIN * LDK, MPAD, NIN, D};
              OrderBf S; S.c = F.bx; EpiInT<false> E{F.ws, F.out, l};
              pg8::gemm_phase<D, LDK, EpiInT<false>, OrderBf, PG8_ALIGN, PG8_SP2>(F.lds, g, S, E, F.wave); }
            if (l == 0) {
                REFRESH();
                if (F.tid == 0) (void)__hip_atomic_fetch_add((unsigned*)(ctl + CW_DONE1), 1u, RLX_AGENT);
                if (F.bx >= G1_UNITS - 2048 - G1_NF8W && F.bx < G1_NF8W) steal_copies(F, true, 1, 3);
            } else {
                REFRESH();
                if (F.bx >= G1_UNITS - 2048 - G1_NF8W && F.bx < G1_NF8W) steal_copies(F, false, 2, 1 << 20);
            }
        }
        SEAM(pb);
        if (IN(pb + 1)) {
            asm volatile("; MARK_MIX");
            REFRESH();
            for (int u = F.bx; u < 256; u += F.G) attn_prompt_unit(F, l, u);
            REFRESH();
            { int par = 0; for (int u = F.bx; u < 512; u += F.G) { sgu_prompt_unit(F, l, u, par); par ^= 1; } }
            __syncthreads();
            REFRESH();
            for (int u = F.bx; u < 128; u += F.G) attn_sample_unit(F, l, u);
            REFRESH();
            for (int u = F.bx - 128; u < 32; u += F.G) if (u >= 0) sgu_sample_unit(F, l, u);
            if (F.bx >= 160) {
                const unsigned char* wp = WSP(unsigned char, WS_WP) + (size_t)l * D * PB8; const unsigned char* wo = WSP(unsigned char, WS_WO) + (size_t)l * D * PB8;
                constexpr unsigned NB16 = (unsigned)((size_t)D * PB8 / 16);
                unsigned acc_ = 0;
                static_assert(NB16 == 22u * 96u * 512u, "22 pieces of each matrix per thread");
                const unsigned i0 = (unsigned)(F.bx - 160) * 512u + (unsigned)F.tid;
#pragma unroll
                for (int hh = 0; hh < 2; ++hh) { v4u a[11], b[11];
#pragma unroll
                    for (int j = 0; j < 11; ++j) { const size_t o = (size_t)(i0 + (unsigned)(hh * 11 + j) * 96u * 512u) * 16; a[j] = *(const v4u*)(wp + o); b[j] = *(const v4u*)(wo + o); }
#pragma unroll
                    for (int j = 0; j < 11; ++j) acc_ |= (a[j].x ^ b[j].x) & (a[j].y ^ b[j].y) & (a[j].z ^ b[j].z) & (a[j].w ^ b[j].w); }
                if (acc_ == 0x12345678u && F.tid == 99999) WSP(unsigned, WS_CTL)[8000] = acc_;
            }
        }
        SEAM(pb + 1);
        if (IN(pb + 2)) {
            asm volatile("; MARK_GEMM2");
            REFRESH();
            pg8::Gemm g{WSP(bf16, WS_AB), (const bf16*)(WSP(unsigned char, WS_WP) + (size_t)l * D * PB8), MP, D, K8}; pg8::StaticOrderC<MP, D> S; S.init(F.G, F.bx);
            EpiMerge E{WSP(bf16, WS_RR), WSP(unsigned char, WS_SGB), WSP(unsigned char, WS_MG)};
            if (F.bx & 8) { skinny_gemm<0>(F, l, F.bx); REFRESH(); }
            pg8::gemm_phase<K8, LD8, EpiMerge, pg8::StaticOrderC<MP, D>, PG8_ALIGN, PG8_SP2, false, true>(F.lds, g, S, E, F.wave);
            REFRESH();
            if (!(F.bx & 8)) skinny_gemm<0>(F, l, F.bx);
        }
        SEAM(pb + 2);
        if (IN(pb + 3)) {
            asm volatile("; MARK_GEMM3");
            REFRESH();
            pg8::Gemm g{WSP(bf16, WS_MG), (const bf16*)(WSP(unsigned char, WS_WO) + (size_t)l * D * PB8), MP, D, K8}; pg8::StaticOrderC<MP, D> S; S.init(F.G, F.bx);
            if (F.bx & 8) { skinny_gemm<1>(F, l, F.bx); REFRESH(); }
            if (l == 0) { EpiOutT<0> E{inp(F, I_XP), nullptr, nullptr, nullptr, nullptr, WSP(float, WS_MOD) + 2 * D, WSP(bf16, WS_RB0), WSP(f32x2, WS_RST)};
                pg8::gemm_phase<K8, LD8, EpiOutT<0>, pg8::StaticOrderC<MP, D>, PG8_ALIGN, PG8_SP2, false, true>(F.lds, g, S, E, F.wave); }
            else { EpiOutT<1> E{nullptr, WSP(bf16, WS_RB0), WSP(f32x2, WS_ST0), inp(F, I_LNG), inp(F, I_LNB), WSP(float, WS_MOD) + (size_t)NSEQ * NMOD + 2 * D, WSP(bf16, WS_RB1), WSP(f32x2, WS_RST)};
                pg8::gemm_phase<K8, LD8, EpiOutT<1>, pg8::StaticOrderC<MP, D>, PG8_ALIGN, PG8_SP2, false, true>(F.lds, g, S, E, F.wave); }
            REFRESH();
            if (!(F.bx & 8)) skinny_gemm<1>(F, l, F.bx);
        }
        SEAM(pb + 3);
        if (IN(pb + 4)) {
            asm volatile("; MARK_LN");
            REFRESH();
            float* dp = F.out + O_YP; float* ds = l == 0 ? WSP(float, WS_X1S) : F.out + O_YS;
            for (int it = GW; it < 2048 + 128; it += NGW) {
                if (it < 2048) { const int rb = it >> 2, sl = it & 3; ln_rows(F, l, rb * 16, 16, rb >> 7, sl, dp + (size_t)rb * 16 * D); }
                else { const int rin = it - 2048; ln_sample_row(F, l, rin, ds + (size_t)rin * D, l == 0); }
            }
            if (l == 0) steal_copies(F, false, 1, 1 << 20);
        }
        if (l == 0) SEAM(pb + 4);
    }
#undef IN
#undef SEAM
}

extern "C" void kernel_launch(void* const* d_in, const int* in_sizes, int n_in, void* d_out, int out_size, void* d_ws, size_t ws_size, hipStream_t stream) {
    static int grid = 0;
    if (grid == 0) {
        if (n_in != 19 || out_size != (int)O_END || ws_size < WS_END) { fprintf(stderr, "kernel_launch: unexpected sizes (n_in %d, out %d, ws %zu); nothing launched\n", n_in, out_size, ws_size); grid = -1; return; }
        int dev = 0, cus = 0, per_cu = 0;
        if (hipGetDevice(&dev) != hipSuccess || hipDeviceGetAttribute(&cus, hipDeviceAttributeMultiprocessorCount, dev) != hipSuccess) { grid = -1; return; }
        if (hipFuncSetAttribute((const void*)mk_fwd, hipFuncAttributeMaxDynamicSharedMemorySize, LDS_BYTES) != hipSuccess) { fprintf(stderr, "kernel_launch: hipFuncSetAttribute failed\n"); grid = -1; return; }
        if (hipOccupancyMaxActiveBlocksPerMultiprocessor(&per_cu, (const void*)mk_fwd, NWAVES * 64, LDS_BYTES) != hipSuccess || per_cu < 1)
            fprintf(stderr, "kernel_launch: note: occupancy query reports %d workgroups per CU\n", per_cu);
        (void)hipGetLastError();
        if (cus != Frame::G) { fprintf(stderr, "kernel_launch: built for a %d-CU device, found %d CUs; nothing launched\n", Frame::G, cus); grid = -1; return; }
        grid = cus;
    }
    if (grid < 0) return;
    if (hipMemsetAsync((char*)d_ws + WS_CTL, 0, CTL_ZERO_BYTES, stream) != hipSuccess) return;
    Args a{};
    for (int i = 0; i < 19; ++i) a.in[i] = (const float*)d_in[i];
    a.out = (float*)d_out; a.ws = (unsigned char*)d_ws;
#if MK_SPLIT
    for (int p = 0; p < 12; ++p) { a.ph_lo = p; a.ph_hi = p + 1; hipLaunchKernelGGL(mk_fwd, dim3(grid), dim3(NWAVES * 64), LDS_BYTES, stream, a); }
#else
    a.ph_lo = 0; a.ph_hi = 12;
    hipLaunchKernelGGL(mk_fwd, dim3(grid), dim3(NWAVES * 64), LDS_BYTES, stream, a);
#endif
    const hipError_t le = hipPeekAtLastError();
    if (le != hipSuccess) fprintf(stderr, "kernel_launch: launch failed: %s\n", hipGetErrorName(le));
}
```

```cpp
#include <hip/hip_runtime.h>
#include <cstdio>
#include <cstdint>

namespace pg8 {
#define PG8_LAS __attribute__((address_space(3)))
typedef unsigned short bf16_t;
typedef short bf16x8 __attribute__((ext_vector_type(8)));
typedef float f32x4 __attribute__((ext_vector_type(4)));
typedef unsigned u32x4 __attribute__((ext_vector_type(4)));
typedef unsigned u32x2 __attribute__((ext_vector_type(2)));
typedef int v4i_t __attribute__((ext_vector_type(4)));
constexpr int BM = 256, BK = 64, HALF = 128, HTB = HALF * BK * 2  , STAGE_BYTES = 8 * HTB, NXCD = 8, WGM = 8;

__host__ __device__ __forceinline__ int lds_byte(int r, int c) { const int st = (r >> 4) * 2 + (c >> 5), rr = r & 15, cc = c & 31, ob = rr * 64 + cc * 2; return st * 1024 + (ob ^ (((ob >> 9) & 1) << 5)); }
__host__ __device__ __forceinline__ void stage_rc(int b, int& R, int& C) { const int st = b / 1024, sb = b % 1024, swz = sb ^ (((sb >> 9) & 1) << 5); R = (st >> 1) * 16 + swz / 64; C = (st & 1) * 32 + (swz % 64) / 2; }
__host__ __device__ __forceinline__ int perm32(int rho) { const int n = rho >> 4, i = rho & 15; return 8 * (i >> 2) + 4 * n + (i & 3); }

struct Unit { int pm, pn; };
struct Gemm { const bf16_t* A; const bf16_t* Bt; int M, N, K; };

template <int MC, int NC> struct StaticOrderC {
    static constexpr int nM = MC / BM, nN = NC / BM, nwg = nM * nN;
    int G, c;
    __host__ __device__ void init(int G_, int c_) { G = G_; c = c_; }
    __host__ __device__ static void map(int L, Unit& u) {
        int wgid = L; { constexpr int q = nwg / NXCD, r = nwg % NXCD; const int xcd = wgid % NXCD, off = wgid / NXCD; wgid = (xcd < r ? xcd * (q + 1) : r * (q + 1) + (xcd - r) * q) + off; }
        constexpr int nig = WGM * nN; const int gid = wgid / nig, fm = gid * WGM, gsz = (nM - fm) < WGM ? (nM - fm) : WGM;
        u.pm = fm + ((wgid % nig) % gsz); u.pn = (wgid % nig) / gsz;
    }
    __host__ __device__ bool next(int i, Unit& u) const {
        const int L = i * G + c; if (L >= nwg) return false;
        int wgid = L; { constexpr int q = nwg / NXCD, r = nwg % NXCD; const int xcd = wgid % NXCD, off = wgid / NXCD; wgid = (xcd < r ? xcd * (q + 1) : r * (q + 1) + (xcd - r) * q) + off; }
        constexpr int nig = WGM * nN; const int gid = wgid / nig, fm = gid * WGM, gsz = (nM - fm) < WGM ? (nM - fm) : WGM;
        u.pm = fm + ((wgid % nig) % gsz); u.pn = (wgid % nig) / gsz; return true;
    }
    __device__ __forceinline__ void a_ready(const Unit&) const {}
    __device__ __forceinline__ void done(const Unit&) const {}
};

__device__ __forceinline__ unsigned cvt_pk_bf16(float lo, float hi) { unsigned r; asm volatile("v_cvt_pk_bf16_f32 %0, %1, %2" : "=v"(r) : "v"(lo), "v"(hi)); return r; }

template <int KC, int LD, class Epi, class Sched, bool ALIGN_EPI = false, bool SP2 = false, bool HM = false, bool F8 = false>
__device__ __forceinline__ void gemm_phase(PG8_LAS unsigned char* lds, const Gemm g, const Sched& S, const Epi& E, const int wid_) {
    const int wid = __builtin_amdgcn_readfirstlane(wid_);
    int lane_; asm volatile("v_mbcnt_lo_u32_b32 %0, -1, 0\n\tv_mbcnt_hi_u32_b32 %0, -1, %0" : "=v"(lane_));
    const int lane = lane_, tid = wid * 64 + lane, wr = wid >> 2, wc = wid & 3, fr = lane & 15, fq = lane >> 4;
    constexpr int K = KC, nt = K / BK;
    unsigned voffA[2], voffB[2];
#pragma unroll
    for (int i = 0; i < 2; ++i) { int R, C; stage_rc(tid * 16 + i * 8192, R, C); const int Rb = Epi::PERM ? ((R & ~31) + perm32(R & 31)) : R;
        voffA[i] = (unsigned)(R * LD + C) * 2u; voffB[i] = (unsigned)(Rb * LD + C) * 2u; }
    constexpr unsigned kstep = (unsigned)(BK * 2);
    constexpr unsigned hstep = (unsigned)(HALF * LD * 2);
    constexpr unsigned tstep = 2 * hstep;
    const __amdgpu_buffer_rsrc_t rA = __builtin_amdgcn_make_buffer_rsrc((void*)g.A, 0, 0x7fffffff, 0x00020000), rB = __builtin_amdgcn_make_buffer_rsrc((void*)g.Bt, 0, 0x7fffffff, 0x00020000);
    const unsigned ldsw = (unsigned)wid * 1024u;
    const int aoff = lds_byte(wr * 64 + fr, fq * 8), boff = lds_byte(wc * 32 + fr, fq * 8);
#define PG8_SA(b, h) (((b) * 2 + (h)) * HTB)
#define PG8_SB(b, h) ((4 + (b) * 2 + (h)) * HTB)
#define PG8_STAGE_R(rs, bufoff, goff, voff) do { _Pragma("unroll") for (int _i = 0; _i < 2; ++_i) \
        __builtin_amdgcn_raw_ptr_buffer_load_lds(rs, (PG8_LAS unsigned*)(lds + (bufoff) + ldsw + _i * 8192), 16, (voff)[_i], (int)(goff), 0, 0); } while (0)
#define PG8_STAGE_A(bufoff, goff, voff) PG8_STAGE_R(rA, bufoff, goff, voff)
#define PG8_STAGE_B(bufoff, goff, voff) PG8_STAGE_R(rB, bufoff, goff, voff)
#define PG8_LDA(dst, b, h) do { _Pragma("unroll") for (int m = 0; m < 4; ++m) _Pragma("unroll") for (int k = 0; k < 2; ++k) dst[m][k] = *(const PG8_LAS bf16x8*)(lds + PG8_SA(b, h) + aoff + m * 2048 + k * 1024); } while (0)
#define PG8_LDB(dst, b, h) do { _Pragma("unroll") for (int n = 0; n < 2; ++n) _Pragma("unroll") for (int k = 0; k < 2; ++k) dst[n][k] = *(const PG8_LAS bf16x8*)(lds + PG8_SB(b, h) + boff + n * 2048 + k * 1024); } while (0)
#define PG8_CAT(x0, x1) __builtin_shufflevector(__builtin_bit_cast(v4i_t, x0), __builtin_bit_cast(v4i_t, x1), 0, 1, 2, 3, 4, 5, 6, 7)
#define PG8_MMA(ai, bj, At, Bt) do { __builtin_amdgcn_s_setprio(1); if constexpr (F8) { _Pragma("unroll") for (int m = 0; m < 4; ++m) _Pragma("unroll") for (int n = 0; n < 2; ++n) \
        acc[ai][bj][m][n] = __builtin_amdgcn_mfma_scale_f32_16x16x128_f8f6f4(PG8_CAT(Bt[n][0], Bt[n][1]), PG8_CAT(At[m][0], At[m][1]), acc[ai][bj][m][n], 0, 0, 0, 0x7f7f7f7f, 0, 0x7f7f7f7f); } \
        else { _Pragma("unroll") for (int m = 0; m < 4; ++m) _Pragma("unroll") for (int n = 0; n < 2; ++n) _Pragma("unroll") for (int k = 0; k < 2; ++k) \
        acc[ai][bj][m][n] = __builtin_amdgcn_mfma_f32_16x16x32_bf16(Bt[n][k], At[m][k], acc[ai][bj][m][n], 0, 0, 0); } __builtin_amdgcn_s_setprio(0); } while (0)
#define PG8_WAIT_V(n) asm volatile("s_waitcnt vmcnt(" #n ")" ::: "memory")
#define PG8_WAIT_L(n) asm volatile("s_waitcnt lgkmcnt(" #n ")" ::: "memory")
#define PG8_BAR __builtin_amdgcn_s_barrier()
#define PG8_SCHED __builtin_amdgcn_sched_barrier(0)
    Unit cur, nxt; int ui = 0;
    if (!S.next(0, cur)) return;
    f32x4 acc[2][2][4][2];
#pragma unroll
    for (int a = 0; a < 2; ++a)
#pragma unroll
        for (int b = 0; b < 2; ++b)
#pragma unroll
            for (int m = 0; m < 4; ++m)
#pragma unroll
                for (int n = 0; n < 2; ++n) acc[a][b][m][n] = (f32x4){0.f, 0.f, 0.f, 0.f};
    bf16x8 At[4][2], B0[2][2], B1[2][2];
    constexpr unsigned astep = HM ? hstep : tstep;
    unsigned cA = (unsigned)cur.pm * astep, cB = (unsigned)cur.pn * tstep;
    S.a_ready(cur);
    if constexpr (SP2) {
        PG8_STAGE_B(PG8_SB(0, 0), cB, voffB); PG8_STAGE_B(PG8_SB(0, 1), cB + hstep, voffB); PG8_STAGE_A(PG8_SA(0, 0), cA, voffA); PG8_STAGE_A(PG8_SA(0, 1), cA + hstep, voffA);
        if (wr == 1) PG8_BAR;
        PG8_WAIT_V(2); PG8_BAR;
        PG8_STAGE_B(PG8_SB(1, 0), cB + kstep, voffB); PG8_STAGE_A(PG8_SA(1, 0), cA + kstep, voffA); PG8_STAGE_B(PG8_SB(1, 1), cB + hstep + kstep, voffB);
        PG8_WAIT_V(6); PG8_BAR;
    } else {
        PG8_STAGE_B(PG8_SB(0, 0), cB, voffB); PG8_STAGE_A(PG8_SA(0, 0), cA, voffA); PG8_STAGE_B(PG8_SB(0, 1), cB + hstep, voffB); PG8_STAGE_A(PG8_SA(0, 1), cA + hstep, voffA);
        if (wr == 1) PG8_BAR;
        PG8_WAIT_V(4); PG8_BAR;
        PG8_STAGE_B(PG8_SB(1, 0), cB + kstep, voffB); PG8_STAGE_A(PG8_SA(1, 0), cA + kstep, voffA); PG8_STAGE_B(PG8_SB(1, 1), cB + hstep + kstep, voffB);
        PG8_WAIT_V(6); PG8_BAR;
    }
    for (;;) {
        const bool has_next = S.next(ui + 1, nxt);
        const unsigned nA = has_next ? (unsigned)nxt.pm * astep : cA, nB = has_next ? (unsigned)nxt.pn * tstep : cB;
        for (int t = 0; t < nt; t += 2) {
            const bool last = (t == nt - 2);
            const unsigned a1 = cA + (unsigned)(t + 1) * kstep;
            const unsigned a2 = last ? nA : cA + (unsigned)(t + 2) * kstep, b2 = last ? nB : cB + (unsigned)(t + 2) * kstep;
            const unsigned a3 = a2 + kstep, b3 = b2 + kstep;
            if (last && has_next) S.a_ready(nxt);
            if constexpr (Epi::MIDK) { if (t == (nt >> 1)) E.mid(acc, cur, wr, wc, fr, fq); }
            if constexpr (SP2) {
            PG8_LDB(B0, 0, 0); PG8_LDB(B1, 0, 1); PG8_SCHED; PG8_LDA(At, 0, 0); PG8_STAGE_A(PG8_SA(1, 1), a1 + hstep, voffA);
            PG8_WAIT_V(8); PG8_WAIT_L(0); PG8_BAR; PG8_MMA(0, 0, At, B0); PG8_MMA(0, 1, At, B1); PG8_BAR; PG8_SCHED;
            if constexpr (!HM) PG8_LDA(At, 0, 1); PG8_STAGE_B(PG8_SB(0, 0), b2, voffB); PG8_STAGE_B(PG8_SB(0, 1), b2 + hstep, voffB); PG8_STAGE_A(PG8_SA(0, 0), a2, voffA);
            PG8_WAIT_V(8); PG8_WAIT_L(0); PG8_BAR; if constexpr (!HM) { PG8_MMA(1, 0, At, B0); PG8_MMA(1, 1, At, B1); } PG8_BAR; PG8_SCHED;
            PG8_LDB(B0, 1, 0); PG8_LDB(B1, 1, 1); PG8_SCHED; PG8_LDA(At, 1, 0); PG8_STAGE_A(PG8_SA(0, 1), a2 + hstep, voffA);
            PG8_WAIT_V(8); PG8_WAIT_L(0); PG8_BAR; PG8_MMA(0, 0, At, B0); PG8_MMA(0, 1, At, B1); PG8_BAR; PG8_SCHED;
            if constexpr (!HM) PG8_LDA(At, 1, 1); PG8_STAGE_B(PG8_SB(1, 0), b3, voffB); PG8_STAGE_B(PG8_SB(1, 1), b3 + hstep, voffB); PG8_STAGE_A(PG8_SA(1, 0), a3, voffA);
            PG8_WAIT_V(8); PG8_WAIT_L(0); PG8_BAR; if constexpr (!HM) { PG8_MMA(1, 0, At, B0); PG8_MMA(1, 1, At, B1); } PG8_BAR; PG8_SCHED;
            } else {
            PG8_LDB(B0, 0, 0); PG8_SCHED; PG8_LDA(At, 0, 0); PG8_STAGE_A(PG8_SA(1, 1), a1 + hstep, voffA);
            PG8_WAIT_L(8); PG8_BAR; PG8_WAIT_L(0); PG8_MMA(0, 0, At, B0); PG8_BAR; PG8_SCHED;
            PG8_LDB(B1, 0, 1); PG8_STAGE_B(PG8_SB(0, 0), b2, voffB);
            PG8_BAR; PG8_WAIT_L(0); PG8_MMA(0, 1, At, B1); PG8_BAR;
            PG8_LDA(At, 0, 1); PG8_STAGE_A(PG8_SA(0, 0), a2, voffA);
            PG8_BAR; PG8_WAIT_L(0); PG8_MMA(1, 0, At, B0); PG8_BAR; PG8_SCHED;
            PG8_STAGE_B(PG8_SB(0, 1), b2 + hstep, voffB);
            PG8_WAIT_V(6); PG8_BAR; PG8_MMA(1, 1, At, B1); PG8_BAR;
            PG8_LDB(B0, 1, 0); PG8_SCHED; PG8_LDA(At, 1, 0); PG8_STAGE_A(PG8_SA(0, 1), a2 + hstep, voffA);
            PG8_WAIT_L(8); PG8_BAR; PG8_WAIT_L(0); PG8_MMA(0, 0, At, B0); PG8_BAR; PG8_SCHED;
            PG8_LDB(B1, 1, 1); PG8_STAGE_B(PG8_SB(1, 0), b3, voffB);
            PG8_BAR; PG8_WAIT_L(0); PG8_MMA(0, 1, At, B1); PG8_BAR;
            PG8_LDA(At, 1, 1); PG8_STAGE_A(PG8_SA(1, 0), a3, voffA);
            PG8_BAR; PG8_WAIT_L(0); PG8_MMA(1, 0, At, B0); PG8_BAR; PG8_SCHED;
            PG8_STAGE_B(PG8_SB(1, 1), b3 + hstep, voffB);
            PG8_WAIT_V(6); PG8_BAR; PG8_MMA(1, 1, At, B1); PG8_BAR;
            }
        }
        if constexpr (ALIGN_EPI) { if (wr == 0) PG8_BAR; }
        E(acc, cur, wr, wc, fr, fq); S.done(cur);
        if (!has_next) break;
#pragma unroll
        for (int a = 0; a < 2; ++a)
#pragma unroll
            for (int b = 0; b < 2; ++b)
#pragma unroll
                for (int m = 0; m < 4; ++m)
#pragma unroll
                    for (int n = 0; n < 2; ++n) acc[a][b][m][n] = (f32x4){0.f, 0.f, 0.f, 0.f};
        cur = nxt; cA = nA; cB = nB; ++ui;
        if constexpr (ALIGN_EPI) { if (wr == 1) PG8_BAR; }
    }
    PG8_WAIT_V(0);
    if constexpr (!ALIGN_EPI) { if (wr == 0) PG8_BAR; }
    PG8_BAR;
#undef PG8_SA
#undef PG8_SB
#undef PG8_STAGE_R
#undef PG8_STAGE_A
#undef PG8_STAGE_B
#undef PG8_LDA
#undef PG8_LDB
#undef PG8_MMA
#undef PG8_CAT
#undef PG8_WAIT_V
#undef PG8_WAIT_L
#undef PG8_BAR
#undef PG8_SCHED
}
}

#ifndef PG8_SP2
#define PG8_SP2 true
#endif
#ifndef PG8_ALIGN
#define PG8_ALIGN true
#endif
#ifndef MK_SPLIT
#define MK_SPLIT 0
#endif

constexpr int NWAVES = 8;
constexpr int D = 4096, MP = 8192, MS = 128, MTOT = MP + MS, MPAD = 8448, NIN = 18944, DA = 2048, DKV = 256, DSG = 2048;
constexpr int NSEQ = 36, NMOD = 3 * D, SEQ = 2048, WIN = 128;
constexpr int PB8 = D + 128, LD8 = PB8 / 2, K8 = D / 2;
constexpr float SA8 = 32.f, SB8 = 8.f, SWP = 128.f, SMG = 16.f, SWO = 256.f, SH8 = 8.f, SWI = 128.f,
                SQ8 = 16.f, SZA8 = 8.f, SUZ8 = 4.f, SVB8 = 8.f, SG8 = 256.f;
constexpr int LDK = D + 64;
constexpr float ALPHA = 1.4142135623730951f;
constexpr float LN_EPS = 1e-5f;
constexpr float LOG2E = 1.4426950408889634f;
constexpr float QSCALE = 0.125f * LOG2E;
constexpr size_t O_YP = 0, O_YS = 33554432, O_WK = 34078720, O_WV = 34340864, O_NK = 34603008, O_NV = 34668544, O_SV = 34734080, O_END = 35258368;

constexpr size_t MiB = 1u << 20;
constexpr size_t WS_CTL = 0, CTL_ZERO_BYTES = 32768;
constexpr size_t WS_MOD = 1 * MiB;
constexpr size_t WS_WSB = 5 * MiB;
constexpr size_t WS_VST = 6 * MiB;
constexpr size_t WS_RST = 9 * MiB;
constexpr size_t WS_KB = 14 * MiB;
constexpr size_t WS_VB = 19 * MiB;
constexpr size_t WS_WIN = 24 * MiB;
constexpr size_t WS_WP = 328 * MiB;
constexpr size_t WS_WO = 394 * MiB;
constexpr size_t WS_HB = 460 * MiB;
constexpr size_t WS_QB = 528 * MiB;
constexpr size_t WS_ZA = 561 * MiB;
constexpr size_t WS_UZ = 594 * MiB;
constexpr size_t WS_VBB = 627 * MiB;
constexpr size_t WS_VBS = 644 * MiB;
constexpr size_t WS_RR = 660 * MiB;
constexpr size_t WS_SGB = 726 * MiB;
constexpr size_t WS_AB = 792 * MiB;
constexpr size_t WS_MG = 860 * MiB;
constexpr size_t WS_RBUF = 928 * MiB;
constexpr size_t WS_RB0 = 928 * MiB;
constexpr size_t WS_RB1 = 992 * MiB;
constexpr size_t WS_RS = 1056 * MiB;
constexpr size_t WS_X1S = 1058 * MiB;
constexpr size_t WS_ST0 = 1060 * MiB;
constexpr size_t WS_HB8 = 1192 * MiB;
constexpr size_t WS_WIN8 = 1228 * MiB;
constexpr size_t WS_END = 1384 * MiB;
static_assert(WS_HB8 + (size_t)MPAD * PB8 <= WS_WIN8 && WS_WIN8 + 2ull * NIN * PB8 <= WS_END, "d_ws map (fp8)");
static_assert(WS_WIN + 2ull * NIN * LDK * 2 <= WS_WP && WS_WP + 2ull * D * LDK * 2 <= WS_WO && WS_WO + 2ull * D * LDK * 2 <= WS_HB && WS_HB + (size_t)MPAD * LDK * 2 <= WS_QB && WS_AB + (size_t)MPAD * LDK * 2 <= WS_MG && WS_MG + (size_t)MPAD * LDK * 2 <= WS_RBUF, "d_ws map");
static_assert((4096 + 3456) * 4 <= (int)CTL_ZERO_BYTES, "barrier words inside the zeroed region");
constexpr int CW_TMO = 0, CW_CODE = 1, CW_WORK0 = 512, CW_WORK1 = 1024, CW_ADA1 = 192, CW_DONE1 = 256, CW_WORK2 = 1536, CW_BAR = 4096;

constexpr int RING_BYTES = 131072;
constexpr int LDSCTL_OFF = 155648, MISC_OFF = LDSCTL_OFF + 320, PTAB_OFF = LDSCTL_OFF + 512;
constexpr int LDS_BYTES = 159744;

#define GAS __attribute__((address_space(1)))
#define LAS __attribute__((address_space(3)))
typedef unsigned short bf16;
typedef unsigned v4u __attribute__((ext_vector_type(4)));
typedef unsigned v2u __attribute__((ext_vector_type(2)));
typedef float f32x4 __attribute__((ext_vector_type(4)));
typedef float f32x2 __attribute__((ext_vector_type(2)));
typedef GAS unsigned gu32;
#define RLX_AGENT __ATOMIC_RELAXED, __HIP_MEMORY_SCOPE_AGENT
#define LDS_WAIT() asm volatile("s_waitcnt lgkmcnt(0)" ::: "memory")
#define VM_WAIT() asm volatile("s_waitcnt vmcnt(0)" ::: "memory")
__device__ __forceinline__ unsigned f2bf(float f) { unsigned u = __builtin_bit_cast(unsigned, f); return (u + 0x7fffu + ((u >> 16) & 1u)) >> 16; }
__device__ __forceinline__ unsigned pk2(float lo, float hi) { return f2bf(lo) | (f2bf(hi) << 16); }
__device__ __forceinline__ float bflo(unsigned u) { return __builtin_bit_cast(float, u << 16); }
__device__ __forceinline__ float bfhi(unsigned u) { return __builtin_bit_cast(float, u & 0xffff0000u); }
__device__ __forceinline__ unsigned pk4_fp8(float a, float b, float c, float d) { int w = 0; w = __builtin_amdgcn_cvt_pk_fp8_f32(a, b, w, false); w = __builtin_amdgcn_cvt_pk_fp8_f32(c, d, w, true); return (unsigned)w; }
__device__ __forceinline__ int lane_now() { int l; asm volatile("v_mbcnt_lo_u32_b32 %0, -1, 0\n\tv_mbcnt_hi_u32_b32 %0, -1, %0" : "=v"(l)); return l; }
template <int K> __device__ __forceinline__ float xadd(float v) {
    if constexpr (K < 32) return v + __builtin_bit_cast(float, __builtin_amdgcn_ds_swizzle(__builtin_bit_cast(int, v), (K << 10) | 0x1f));
    else { const unsigned u = __builtin_bit_cast(unsigned, v); auto rr = __builtin_amdgcn_permlane32_swap(u, u, false, false); return __builtin_bit_cast(float, (unsigned)rr[0]) + __builtin_bit_cast(float, (unsigned)rr[1]); }
}
template <int K> __device__ __forceinline__ float xmax(float v) {
    if constexpr (K < 32) return fmaxf(v, __builtin_bit_cast(float, __builtin_amdgcn_ds_swizzle(__builtin_bit_cast(int, v), (K << 10) | 0x1f)));
    else { const unsigned u = __builtin_bit_cast(unsigned, v); auto rr = __builtin_amdgcn_permlane32_swap(u, u, false, false); return fmaxf(__builtin_bit_cast(float, (unsigned)rr[0]), __builtin_bit_cast(float, (unsigned)rr[1])); }
}
__device__ __forceinline__ float xadd_wave(float v) { v = xadd<1>(v); v = xadd<2>(v); v = xadd<4>(v); v = xadd<8>(v); v = xadd<16>(v); return xadd<32>(v); }
__device__ __forceinline__ float xmax_wave(float v) { v = xmax<1>(v); v = xmax<2>(v); v = xmax<4>(v); v = xmax<8>(v); v = xmax<16>(v); return xmax<32>(v); }
__device__ __forceinline__ float xadd_32(float v) { v = xadd<1>(v); v = xadd<2>(v); v = xadd<4>(v); v = xadd<8>(v); return xadd<16>(v); }
__device__ __forceinline__ f32x4 f8x4(unsigned w) { const f32x2 a = __builtin_amdgcn_cvt_pk_f32_fp8((int)w, false), b = __builtin_amdgcn_cvt_pk_f32_fp8((int)w, true); return (f32x4){a.x, a.y, b.x, b.y}; }
__device__ __forceinline__ float f8x1(unsigned char b) { return __builtin_amdgcn_cvt_f32_fp8((int)b, 0); }
__device__ __forceinline__ float sigmoidf_(float x) { return __builtin_amdgcn_rcpf(1.0f + __builtin_amdgcn_exp2f(-x * LOG2E)); }
__device__ __forceinline__ float siluf_(float x) { return x * sigmoidf_(x); }

#define XB_TMO      128
#define XB_XCNT(j)  (256  + 64 * (j))
#define XB_XSUB(j)  (1280 + 64 * (j))
#define XB_XGEN(j)  (2304 + 64 * (j))
#define XB_TOP      3328
#define XB_TOPGEN   3392
#define XCD_BAR_WORDS 3456
#define XB_SPIN_CAP (1u << 18)
__device__ __forceinline__ unsigned xb_ld(unsigned* p)              { return __hip_atomic_load(p, __ATOMIC_RELAXED, __HIP_MEMORY_SCOPE_AGENT); }
__device__ __forceinline__ unsigned xb_add(unsigned* p, unsigned v) { return __hip_atomic_fetch_add(p, v, __ATOMIC_RELAXED, __HIP_MEMORY_SCOPE_AGENT); }
__device__ __forceinline__ unsigned xb_xcc_id() { return (unsigned)__builtin_amdgcn_s_getreg((3 << 11) | 20) & 0xFu; }
#define XB_SPIN(cond, bar) do { unsigned _sp = 0; while (cond) { __builtin_amdgcn_s_sleep(1); \
    if ((++_sp & 255u) == 0u) { if (xb_ld(&(bar)[XB_TMO])) break; if (_sp > XB_SPIN_CAP) { atomicAdd(&(bar)[XB_TMO], 1u); break; } } } } while (0)
struct XcdBarrier { unsigned* bar; unsigned x; volatile LAS unsigned* st; };
__device__ __forceinline__ XcdBarrier xcd_barrier_post(unsigned* bar, volatile LAS unsigned* st) {
    XcdBarrier b; b.bar = bar; b.x = xb_xcc_id(); b.st = st;
    if (threadIdx.x == 0) (void)xb_add(&bar[XB_XCNT(b.x)], 1u);
    return b;
}
__device__ __forceinline__ void xcd_barrier_complete(unsigned* bar, unsigned x, unsigned& nloc, unsigned& nx) {
    const unsigned G = gridDim.x * gridDim.y * gridDim.z;
    unsigned sum, cnt, mine, sp = 0u;
    for (;;) {
        sum = 0u; cnt = 0u; mine = 0u;
#pragma unroll
        for (unsigned j = 0; j < 16; ++j) { const unsigned c = xb_ld(&bar[XB_XCNT(j)]); sum += c; cnt += (c > 0u) ? 1u : 0u; mine = (j == x) ? c : mine; }
        if (sum == G) break;
        __builtin_amdgcn_s_sleep(1);
        if ((++sp & 255u) == 0u) { if (xb_ld(&bar[XB_TMO])) break; if (sp > XB_SPIN_CAP) { atomicAdd(&bar[XB_TMO], 1u); break; } }
    }
    nloc = mine > 0u ? mine : 1u; nx = cnt > 0u ? cnt : 1u;
}
__device__ __forceinline__ void xcd_barrier(const XcdBarrier& b, const bool leader) {
    asm volatile("s_waitcnt vmcnt(0)" ::: "memory");
    __syncthreads();
    if (leader) {
        unsigned* bar = b.bar; unsigned bx_ = b.x;
        asm volatile("" : "+s"(bar), "+s"(bx_));
        __builtin_amdgcn_s_waitcnt(0);
        unsigned nloc = b.st[0], nx = b.st[1];
        if (nloc == 0u) { xcd_barrier_complete(bar, bx_, nloc, nx); b.st[0] = nloc; b.st[1] = nx; }
        const unsigned old = xb_add(&bar[XB_XSUB(bx_)], 1u);
        const unsigned gen = old / nloc;
        if (old + 1u == (gen + 1u) * nloc) {
            __builtin_amdgcn_fence(__ATOMIC_RELEASE, "agent");
            asm volatile("s_waitcnt vmcnt(0)" ::: "memory");
            const unsigned og = xb_add(&bar[XB_TOP], 1u);
            const unsigned tg = og / nx;
            if (og + 1u == (tg + 1u) * nx) xb_add(&bar[XB_TOPGEN], 1u);
            else XB_SPIN(xb_ld(&bar[XB_TOPGEN]) == tg, bar);
            __builtin_amdgcn_fence(__ATOMIC_ACQUIRE, "agent");
            xb_add(&bar[XB_XGEN(bx_)], 1u);
            asm volatile("s_waitcnt vmcnt(0)" ::: "memory");
        } else {
            XB_SPIN(xb_ld(&bar[XB_XGEN(bx_)]) == gen, bar);
            __builtin_amdgcn_fence(__ATOMIC_ACQUIRE, "agent");
            asm volatile("s_waitcnt vmcnt(0)" ::: "memory");
        }
    }
    __syncthreads();
}

struct Frame {
    LAS unsigned char* lds;
    unsigned char* ws;
    float* out;
    int tid, lane, wave, bx;
    static constexpr int G = 256;
};
enum { I_XP = 0, I_XS, I_CK, I_CV, I_CP, I_CS, I_WADA, I_BADA, I_WIN, I_SINK, I_SG, I_SB, I_SW, I_SBS, I_WPA, I_WPB, I_WO, I_LNG, I_LNB };
__device__ __forceinline__ const float* inp(const Frame& F, int k) {
    volatile LAS unsigned* t = (volatile LAS unsigned*)(F.lds + PTAB_OFF) + 2 * k;
    const unsigned lo = __builtin_amdgcn_readfirstlane(t[0]), hi = __builtin_amdgcn_readfirstlane(t[1]);
    return (const float*)(const GAS float*)(((unsigned long long)hi << 32) | lo);
}
#define WSP(T, off) ((T*)(F.ws + (off)))
__device__ __forceinline__ int row_seq(int row) { return row < MP ? (row >> 11) : 4 + ((row - MP) >> 2); }

__device__ __forceinline__ void ada_item(Frame& F, int item) {
    const int l = item / 96, cb = item % 96;
    LAS float* sc = (LAS float*)(F.lds);
    LAS float* red = (LAS float*)(F.lds + 40960);
    const float* W = inp(F, I_WADA) + (size_t)l * D * NMOD + cb * 128;
    const float* cp = inp(F, I_CP); const float* cs = inp(F, I_CS);
    const int half = F.lane >> 5, c4 = (F.lane & 31) * 4;
    f32x4 acc[18];
#pragma unroll
    for (int s = 0; s < 18; ++s) acc[s] = (f32x4){0.f, 0.f, 0.f, 0.f};
    f32x4 w[8];
    const float* Wl = W + (size_t)(F.wave * 16) * NMOD + c4;
#pragma unroll
    for (int j = 0; j < 8; ++j) w[j] = __builtin_nontemporal_load((const f32x4*)(Wl + (size_t)j * NMOD));
    const int sq0 = F.tid >> 7, kk = F.tid & 127;
    float cv[9];
    cv[0] = cp[sq0 * D + kk];
#pragma unroll
    for (int j = 1; j < 9; ++j) cv[j] = cs[(sq0 + 4 * j - 4) * D + kk];
    for (int ch = 0; ch < 32; ++ch) {
        LAS float* scb = sc + (ch & 1) * 5120;
#pragma unroll
        for (int j = 0; j < 9; ++j) { const int s = sq0 + 4 * j; scb[kk * 40 + (s < 18 ? s : s + 2)] = siluf_(cv[j]); }
        { const int cn = (ch + 1 < 32 ? ch + 1 : ch) * 128 + kk;
          cv[0] = cp[sq0 * D + cn];
#pragma unroll
          for (int j = 1; j < 9; ++j) cv[j] = cs[(sq0 + 4 * j - 4) * D + cn]; }
        __syncthreads();
#pragma unroll
        for (int h2 = 0; h2 < 2; ++h2) {
            const float* Wn = Wl + (size_t)((h2 == 0 ? ch * 128 + 8 : (ch + 1 < 32 ? (ch + 1) * 128 : ch * 128))) * NMOD;
            f32x4 ac[5];
            { const LAS f32x4* a4 = (const LAS f32x4*)(scb + (F.wave * 16 + h2 * 8) * 40 + half * 20);
#pragma unroll
              for (int s4 = 0; s4 < 5; ++s4) ac[s4] = a4[s4]; }
#pragma unroll
            for (int j = 0; j < 8; ++j) {
                f32x4 an[5];
                if (j + 1 < 8) { const LAS f32x4* a4 = (const LAS f32x4*)(scb + (F.wave * 16 + h2 * 8 + j + 1) * 40 + half * 20);
#pragma unroll
                    for (int s4 = 0; s4 < 5; ++s4) an[s4] = a4[s4]; }
                const f32x4 wv = w[j];
#pragma unroll
                for (int s4 = 0; s4 < 5; ++s4) { const f32x4 a = ac[s4];
                    acc[4 * s4 + 0] += a.x * wv; acc[4 * s4 + 1] += a.y * wv;
                    if (s4 < 4) { acc[4 * s4 + 2] += a.z * wv; acc[4 * s4 + 3] += a.w * wv; } }
                w[j] = __builtin_nontemporal_load((const f32x4*)(Wn + (size_t)j * NMOD));
                if (j + 1 < 8) {
#pragma unroll
                    for (int s4 = 0; s4 < 5; ++s4) ac[s4] = an[s4]; }
                __builtin_amdgcn_sched_barrier(0);
            }
        }
    }
    float* mod = WSP(float, WS_MOD); const float* bada = inp(F, I_BADA);
#pragma unroll
    for (int p = 0; p < 2; ++p) {
        __syncthreads();
#pragma unroll
        for (int s9 = 0; s9 < 9; ++s9) *(LAS f32x4*)(red + (F.wave * 18 + half * 9 + s9) * 128 + c4) = acc[p * 9 + s9];
        __syncthreads();
        for (int i = F.tid; i < 18 * 128; i += 512) { const int r = i >> 7, c = i & 127; float v = 0.f;
#pragma unroll
            for (int w8 = 0; w8 < 8; ++w8) v += red[(w8 * 18 + r) * 128 + c];
            const int sq = (r < 9) ? p * 9 + r : 18 + p * 9 + (r - 9), col = cb * 128 + c;
            mod[(size_t)(l * NSEQ + sq) * NMOD + col] = v + bada[l * NMOD + col]; }
    }
    __syncthreads();
}

__device__ __forceinline__ void tr_load(const float* src, int Nsrc, int lane, float (&v)[32]) {
    unsigned off = (unsigned)((lane >> 5) * Nsrc + (lane & 31)) * 4u; const unsigned step = (unsigned)Nsrc * 8u;
#pragma unroll
    for (int i = 0; i < 32; ++i) { v[i] = __builtin_nontemporal_load((const float*)((const char*)src + off)); off += step; }
}
__device__ __forceinline__ void tr_store(void* dst, int f8, float scale, LAS float* scr, int lane, const float (&v)[32]) {
#pragma unroll
    for (int i = 0; i < 32; ++i) scr[(2 * i + (lane >> 5)) * 33 + (lane & 31)] = v[i];
    LDS_WAIT(); asm volatile("" ::: "memory");
    const int c = lane & 7;
#pragma unroll
    for (int j = 0; j < 4; ++j) { const int n = (lane >> 3) + 8 * j; const LAS float* s = scr + (8 * c) * 33 + n;
        if (f8) { v2u o; o.x = pk4_fp8(s[0 * 33] * scale, s[1 * 33] * scale, s[2 * 33] * scale, s[3 * 33] * scale); o.y = pk4_fp8(s[4 * 33] * scale, s[5 * 33] * scale, s[6 * 33] * scale, s[7 * 33] * scale);
            *(GAS v2u*)((unsigned char*)dst + (size_t)n * PB8 + 8 * c) = o; }
        else { v4u o; o.x = pg8::cvt_pk_bf16(s[0 * 33], s[1 * 33]); o.y = pg8::cvt_pk_bf16(s[2 * 33], s[3 * 33]); o.z = pg8::cvt_pk_bf16(s[4 * 33], s[5 * 33]); o.w = pg8::cvt_pk_bf16(s[6 * 33], s[7 * 33]);
            *(GAS v4u*)((bf16*)dst + (size_t)n * LDK + 8 * c) = o; } }
    LDS_WAIT(); asm volatile("" ::: "memory");
}
__host__ __device__ __forceinline__ int win_row(int c) {
    if (c < 4608) return c;
    if (c < 6656) { const int j = (c - 4608) >> 7, i = (c - 4608) & 127; return 4608 + 256 * j + i; }
    if (c < 8704) return 8704 + (c - 6656);
    if (c < 10752) { const int j = (c - 8704) >> 7, i = (c - 8704) & 127; return 4608 + 256 * j + 128 + i; }
    if (c < 14848) { const int j = (c - 10752) >> 7, i = (c - 10752) & 127; return 10752 + 256 * j + i; }
    { const int j = (c - 14848) >> 7, i = (c - 14848) & 127; return 10752 + 256 * j + 128 + i; }
}
constexpr int I_IN = 64 * 592, I_PA = 32 * 128, I_O = 64 * 128, I_LAYER = I_IN + 2 * I_PA + I_O, I_TR = 2 * I_LAYER, I_WS = 128, I_ALL = I_TR + I_WS;
static_assert(I_TR % 8 == 0 && I_WS % 8 == 0 && I_IN % 8 == 0, "chunks of 8 items never straddle the item kinds");
__device__ __forceinline__ void tr_desc(Frame& F, int it, const float*& src, int& Nsrc, void*& dst, void*& dst2, int& f8, float& scale) {
    const int l = it / I_LAYER; int r = it % I_LAYER; f8 = 0; scale = 1.f; dst2 = nullptr;
    if (r < I_IN) { const int kb = r / 592, nb = r % 592, wrow = win_row(32 * nb); Nsrc = NIN; f8 = 1; scale = SWI;
        src = inp(F, I_WIN) + (size_t)l * D * NIN + (size_t)(64 * kb) * NIN + 32 * nb; dst = WSP(unsigned char, WS_WIN8) + (size_t)l * NIN * PB8 + (size_t)wrow * PB8 + 64 * kb;
        if ((wrow >= 2048 && wrow < 2560) || (wrow >= 8704 && wrow < 10752)) { f8 = 2; dst2 = WSP(bf16, WS_WIN) + (size_t)l * NIN * LDK + (size_t)wrow * LDK + 64 * kb; }
        return; }
    r -= I_IN; Nsrc = D; f8 = 1; scale = SWP;
    if (r < I_PA) { const int kb = r / 128, nb = r % 128;
        src = inp(F, I_WPA) + (size_t)l * DA * D + (size_t)(64 * kb) * D + 32 * nb; dst = WSP(unsigned char, WS_WP) + (size_t)l * D * PB8 + (size_t)(32 * nb) * PB8 + 64 * kb; return; }
    r -= I_PA;
    if (r < I_PA) { const int kb = r / 128, nb = r % 128;
        src = inp(F, I_WPB) + (size_t)l * DSG * D + (size_t)(64 * kb) * D + 32 * nb; dst = WSP(unsigned char, WS_WP) + (size_t)l * D * PB8 + (size_t)(32 * nb) * PB8 + 2048 + 64 * kb; return; }
    r -= I_PA; scale = SWO;
    { const int kb = r / 128, nb = r % 128;
        src = inp(F, I_WO) + (size_t)l * D * D + (size_t)(64 * kb) * D + 32 * nb; dst = WSP(unsigned char, WS_WO) + (size_t)l * D * PB8 + (size_t)(32 * nb) * PB8 + 64 * kb; }
}
__device__ __forceinline__ void copy_chunk(Frame& F, int base, LAS float* scr) {
    if (base >= I_TR) {
        const float* sw = inp(F, I_SW); bf16* Wsb = WSP(bf16, WS_WSB);
        for (int it = base; it < base + 8; ++it) { const int e0 = (it - I_TR) * 2048 + F.lane * 4;
#pragma unroll
            for (int j = 0; j < 8; ++j) { const int e = e0 + j * 256; const f32x4 v = *(const f32x4*)(sw + e); const int s = e & 127, t = (e >> 7) & 127;
                v2u o; o.x = pk2(s <= t ? v.x : 0.f, s + 1 <= t ? v.y : 0.f); o.y = pk2(s + 2 <= t ? v.z : 0.f, s + 3 <= t ? v.w : 0.f);
                *(GAS v2u*)(Wsb + e) = o; } }
        return;
    }
    float va[32], vb[32]; const float* src; int ns; void *da, *db, *da2, *db2; int fa, fb; float sa, sb;
    tr_desc(F, base, src, ns, da, da2, fa, sa); tr_load(src, ns, F.lane, va);
#pragma unroll 1
    for (int j = 0; j < 8; j += 2) {
        tr_desc(F, base + j + 1, src, ns, db, db2, fb, sb); tr_load(src, ns, F.lane, vb);
        tr_store(da, fa != 0, sa, scr, F.lane, va); if (fa == 2) tr_store(da2, 0, 1.f, scr, F.lane, va);
        if (j + 2 < 8) { tr_desc(F, base + j + 2, src, ns, da, da2, fa, sa); tr_load(src, ns, F.lane, va); }
        tr_store(db, fb != 0, sb, scr, F.lane, vb); if (fb == 2) tr_store(db2, 0, 1.f, scr, F.lane, vb);
    }
}

__device__ __forceinline__ int pull8(gu32* q, int nchunks, int& s, int& left, int lane) {
    while (left > 0) { int k = 0; if (lane == 0) k = (int)__hip_atomic_fetch_add((unsigned*)(q + 64 * s), 1u, RLX_AGENT);
        const int c = 8 * __builtin_amdgcn_readfirstlane(k) + s; if (c < nchunks) return 8 * c;
        s = (s + 1) & 7; --left; }
    return -1; }
__device__ __forceinline__ void steal_copies(Frame& F, bool until_done, int q, int quota) {
    gu32* ctl = (gu32*)(F.ws + WS_CTL); LAS float* scr = (LAS float*)(F.lds + F.wave * 16384);
    gu32* head = ctl + (q == 1 ? CW_WORK1 : CW_WORK2); const int n = q == 1 ? I_IN : I_LAYER - I_IN, base = q == 1 ? I_LAYER : I_LAYER + I_IN;
    int sh = F.bx & 7, left = 8;
    for (int it = 0; it < quota; ++it) {
        if (until_done) { unsigned d = 0; if (F.lane == 0) d = __hip_atomic_load((unsigned*)(ctl + CW_DONE1), RLX_AGENT); if ((unsigned)__builtin_amdgcn_readfirstlane(d) >= (unsigned)Frame::G) break; }
        const int v = pull8(head, n / 8, sh, left, F.lane); if (v < 0) break;
        copy_chunk(F, base + v, scr);
    }
}

__device__ __forceinline__ void h_rows(Frame& F, const float* x, int row0, int nrows, int seq, int slice, int l) {
    const int col = slice * 1024 + F.lane * 4;
    const float* md = WSP(float, WS_MOD) + (size_t)(l * NSEQ + seq) * NMOD; bf16* Hb = WSP(bf16, WS_HB); unsigned char* Hb8 = WSP(unsigned char, WS_HB8);
    const bool wb = row0 >= MP || (row0 & 2047) >= 1792;
    f32x4 sh[4], sc[4];
#pragma unroll
    for (int j = 0; j < 4; ++j) { sh[j] = *(const f32x4*)(md + col + 256 * j); sc[j] = *(const f32x4*)(md + D + col + 256 * j) + 1.0f; }
    for (int r0 = 0; r0 < nrows; r0 += 4) {
        f32x4 xv[4][4];
#pragma unroll
        for (int rr = 0; rr < 4; ++rr)
#pragma unroll
            for (int j = 0; j < 4; ++j) xv[rr][j] = __builtin_nontemporal_load((const f32x4*)(x + (size_t)(r0 + rr) * D + col + 256 * j));
#pragma unroll
        for (int rr = 0; rr < 4; ++rr) { const int r = r0 + rr;
#pragma unroll
            for (int j = 0; j < 4; ++j) { const f32x4 v = xv[rr][j] * sc[j] + sh[j];
                *(GAS unsigned*)(Hb8 + (size_t)(row0 + r) * PB8 + col + 256 * j) = pk4_fp8(v.x * SH8, v.y * SH8, v.z * SH8, v.w * SH8);
                if (wb) { v2u o; o.x = pk2(v.x, v.y); o.y = pk2(v.z, v.w); *(GAS v2u*)(Hb + (size_t)(row0 + r) * LDK + col + 256 * j) = o; } } }
    }
}

constexpr int G1_NBF = 18, G1_NF8W = 256 - G1_NBF, G1_UNITS = 33 * 74;
struct OrderF8 { int c;
    __device__ __forceinline__ bool next(int i, pg8::Unit& u) const {
        int L;
        if (i < 8) L = i * 256 + c;
        else { if (c >= G1_NF8W) return false; L = 2048 + (i - 8) * G1_NF8W + c; if (L >= G1_UNITS) return false; }
        pg8::StaticOrderC<MPAD, NIN>::map(L, u); return true; }
    __device__ __forceinline__ void a_ready(const pg8::Unit&) const {}
    __device__ __forceinline__ void done(const pg8::Unit&) const {} };
struct OrderBf { int c;
    __device__ __forceinline__ bool next(int i, pg8::Unit& u) const {
        const int j = c - G1_NF8W; if (i != 0 || j < 0) return false;
        if (j < 8) { u.pm = 8 * (j >> 1) + 7; u.pn = 8 + (j & 1); }
        else { const int jj = j - 8; u.pm = 32; u.pn = jj < 2 ? 8 + jj : 34 + (jj - 2); }
        return true; }
    __device__ __forceinline__ void a_ready(const pg8::Unit&) const {}
    __device__ __forceinline__ void done(const pg8::Unit&) const {} };

__host__ __device__ __forceinline__ bool is_bf16_unit(int pm, int pn) { return ((pn == 8 || pn == 9) && ((pm & 7) == 7 || pm == 32)) || (pm == 32 && pn >= 34 && pn < 42); }
template <bool F8> struct EpiInT {
    static constexpr bool PERM = true, MIDK = false;
    unsigned char* ws; float* outl;
    int l;
    __device__ __forceinline__ void mid(pg8::f32x4 (&)[2][2][4][2], const pg8::Unit&, int, int, int, int) const {}
    __device__ __forceinline__ void operator()(const pg8::f32x4 (&acc)[2][2][4][2], const pg8::Unit& u, int wr, int wc, int fr_, int fq_) const {
        if (F8 && is_bf16_unit(u.pm, u.pn)) return;
        constexpr float DS = F8 ? 1.0f / (SH8 * SWI) : 1.0f;
        const int ln_ = lane_now(), fr = ln_ & 15, fq = ln_ >> 4; (void)fr_; (void)fq_;
        const int row0 = u.pm * 256 + wr * 64 + fr, c8 = wc * 32 + 8 * fq, pn = u.pn;
        if (pn < 8 || (pn >= 10 && pn < 18) || (pn >= 34 && pn < 42)) {
            const int kind = pn < 8 ? 0 : (pn < 18 ? 1 : 2);
            unsigned char* base = kind == 0 ? (ws + WS_QB) + pn * 256 : (kind == 1 ? (ws + WS_ZA) + (pn - 10) * 256 : (ws + WS_VBB) + (pn - 34) * 256);
            const float osc = kind == 0 ? QSCALE * SQ8 : (kind == 1 ? SZA8 : SVB8);
            f32x2* vst = (f32x2*)(ws + WS_VST);
#pragma unroll
            for (int ai = 0; ai < 2; ++ai)
#pragma unroll
                for (int m = 0; m < 4; ++m) { const int row = row0 + ai * 128 + m * 16; unsigned char* rowp = base + (size_t)row * 2048 + c8; float s1 = 0.f, s2 = 0.f;
#pragma unroll
                    for (int bj = 0; bj < 2; ++bj) { f32x4 v0 = acc[ai][bj][m][0] * DS, v1 = acc[ai][bj][m][1] * DS;
                        if (kind == 1) { v0 = (f32x4){siluf_(v0.x), siluf_(v0.y), siluf_(v0.z), siluf_(v0.w)}; v1 = (f32x4){siluf_(v1.x), siluf_(v1.y), siluf_(v1.z), siluf_(v1.w)}; }
                        if (kind == 2) { s1 += (v0.x + v0.y) + (v0.z + v0.w) + (v1.x + v1.y) + (v1.z + v1.w);
                                         s2 += (v0.x * v0.x + v0.y * v0.y) + (v0.z * v0.z + v0.w * v0.w) + (v1.x * v1.x + v1.y * v1.y) + (v1.z * v1.z + v1.w * v1.w); }
                        if (!F8 && kind == 2) {
                            v4u w; w.x = pg8::cvt_pk_bf16(v0.x, v0.y); w.y = pg8::cvt_pk_bf16(v0.z, v0.w); w.z = pg8::cvt_pk_bf16(v1.x, v1.y); w.w = pg8::cvt_pk_bf16(v1.z, v1.w);
                            *(v4u*)((bf16*)(ws + WS_VBS) + (size_t)(row - MP) * 2048 + (pn - 34) * 256 + c8 + bj * 128) = w;
                        } else {
                            v0 = v0 * osc; v1 = v1 * osc;
                            v2u w; w.x = pk4_fp8(v0.x, v0.y, v0.z, v0.w); w.y = pk4_fp8(v1.x, v1.y, v1.z, v1.w);
                            *(v2u*)(rowp + bj * 128) = w; } }
                    if (kind == 2) { s1 = xadd<32>(xadd<16>(s1)); s2 = xadd<32>(xadd<16>(s2));
                        if (fq == 0) vst[(size_t)row * 32 + (pn - 34) * 4 + wc] = (f32x2){s1, s2}; }
                }
        } else if (pn < 10) {
            bf16* base = (bf16*)(ws + (pn == 8 ? WS_KB : WS_VB));
            float* ow = outl + (pn == 8 ? O_WK : O_WV) + (size_t)l * 131072; float* on = outl + (pn == 8 ? O_NK : O_NV) + (size_t)l * 32768;
#pragma unroll
            for (int ai = 0; ai < 2; ++ai)
#pragma unroll
                for (int m = 0; m < 4; ++m) { const int row = row0 + ai * 128 + m * 16; bf16* rowp = base + (size_t)row * 256 + c8;
                    const int rin = wr * 64 + m * 16 + fr;
                    float* fo = nullptr;
                    if (!F8) { if (u.pm < 32) { if ((u.pm & 7) == 7 && ai == 1) fo = ow + ((size_t)(u.pm >> 3) * 128 + rin) * 256; } else if (ai == 0) fo = on + (size_t)rin * 256; }
#pragma unroll
                    for (int bj = 0; bj < 2; ++bj) { const f32x4 v0 = acc[ai][bj][m][0] * DS, v1 = acc[ai][bj][m][1] * DS;
                        v4u w; w.x = pg8::cvt_pk_bf16(v0.x, v0.y); w.y = pg8::cvt_pk_bf16(v0.z, v0.w); w.z = pg8::cvt_pk_bf16(v1.x, v1.y); w.w = pg8::cvt_pk_bf16(v1.z, v1.w);
                        *(v4u*)(rowp + bj * 128) = w;
                        if (fo) { *(f32x4*)(fo + bj * 128 + c8) = v0; *(f32x4*)(fo + bj * 128 + c8 + 4) = v1; } }
                }
        } else if (pn < 34) {
            unsigned char* base = (ws + WS_UZ) + (pn - 18) * 128;
#pragma unroll
            for (int ai = 0; ai < 2; ++ai)
#pragma unroll
                for (int m = 0; m < 4; ++m) { const int row = row0 + ai * 128 + m * 16;
                    const f32x4 u0 = acc[ai][0][m][0] * DS, u1 = acc[ai][0][m][1] * DS, z0 = acc[ai][1][m][0] * DS, z1 = acc[ai][1][m][1] * DS;
                    v2u w; w.x = pk4_fp8(u0.x * siluf_(z0.x) * SUZ8, u0.y * siluf_(z0.y) * SUZ8, u0.z * siluf_(z0.z) * SUZ8, u0.w * siluf_(z0.w) * SUZ8);
                    w.y = pk4_fp8(u1.x * siluf_(z1.x) * SUZ8, u1.y * siluf_(z1.y) * SUZ8, u1.z * siluf_(z1.z) * SUZ8, u1.w * siluf_(z1.w) * SUZ8);
                    *(v2u*)(base + (size_t)row * 2048 + c8) = w; }
        } else {
            const int cb = (pn - 42) * 128 + c8; bf16* RR = (bf16*)(ws + WS_RR); unsigned char* SGB = ws + WS_SGB;
#pragma unroll
            for (int ai = 0; ai < 2; ++ai)
#pragma unroll
                for (int m = 0; m < 4; ++m) { const int row = row0 + ai * 128 + m * 16;
                    float ra[8], sb[8];
#pragma unroll
                    for (int n = 0; n < 2; ++n)
#pragma unroll
                        for (int e = 0; e < 4; ++e) {
                            const float xa = __builtin_amdgcn_fmed3f(acc[ai][0][m][n][e] * (-DS * LOG2E), -60.0f, 60.0f), xb = __builtin_amdgcn_fmed3f(acc[ai][1][m][n][e] * (-DS * LOG2E), -60.0f, 60.0f);
                            const float pa = 1.0f + __builtin_amdgcn_exp2f(xa), pb = 1.0f + __builtin_amdgcn_exp2f(xb), r = __builtin_amdgcn_rcpf(pa * pb);
                            sb[n * 4 + e] = fmaxf(r * pa, 1.52587890625e-05f);
                            ra[n * 4 + e] = fminf(pb, 65536.0f) * (r * pb); }
                    v4u w; w.x = pg8::cvt_pk_bf16(ra[0], ra[1]); w.y = pg8::cvt_pk_bf16(ra[2], ra[3]); w.z = pg8::cvt_pk_bf16(ra[4], ra[5]); w.w = pg8::cvt_pk_bf16(ra[6], ra[7]);
                    *(v4u*)(RR + (size_t)row * D + cb) = w;
                    v2u x; x.x = pk4_fp8(sb[0] * SG8, sb[1] * SG8, sb[2] * SG8, sb[3] * SG8); x.y = pk4_fp8(sb[4] * SG8, sb[5] * SG8, sb[6] * SG8, sb[7] * SG8);
                    *(v2u*)(SGB + (size_t)row * D + cb) = x; }
        }
    }
};

struct EpiMerge {
    static constexpr bool PERM = true, MIDK = true;
    const bf16* RR; const unsigned char* SGB; unsigned char* MG;
    __device__ __forceinline__ void mid(pg8::f32x4 (&acc)[2][2][4][2], const pg8::Unit& u, int wr, int wc, int, int) const {
        const int ln_ = lane_now(), fr = ln_ & 15, fq = ln_ >> 4;
        unsigned off0 = ((unsigned)(u.pm * 256 + wr * 64 + fr) * D + (unsigned)(u.pn * 256 + wc * 32 + 8 * fq)) * 2u;
        asm volatile("" : "+v"(off0));
        v4u w[2][4][2];
#pragma unroll
        for (int ai = 0; ai < 2; ++ai)
#pragma unroll
            for (int m = 0; m < 4; ++m)
#pragma unroll
                for (int bj = 0; bj < 2; ++bj) w[ai][m][bj] = *(const v4u*)((const char*)RR + off0 + (unsigned)((ai * 128 + m * 16) * D * 2) + bj * 256);
#pragma unroll
        for (int ai = 0; ai < 2; ++ai) {
#pragma unroll
            for (int m = 0; m < 4; ++m)
#pragma unroll
                for (int bj = 0; bj < 2; ++bj) { const v4u x = w[ai][m][bj];
                    acc[ai][bj][m][0] = acc[ai][bj][m][0] * ((f32x4){bflo(x.x), bfhi(x.x), bflo(x.y), bfhi(x.y)} * (SB8 / SA8));
                    acc[ai][bj][m][1] = acc[ai][bj][m][1] * ((f32x4){bflo(x.z), bfhi(x.z), bflo(x.w), bfhi(x.w)} * (SB8 / SA8)); }
            asm volatile("" ::: "memory");
        }
    }
    __device__ __forceinline__ void operator()(const pg8::f32x4 (&acc)[2][2][4][2], const pg8::Unit& u, int wr, int wc, int, int) const {
        const int ln_ = lane_now(), fr = ln_ & 15, fq = ln_ >> 4;
        unsigned off0 = (unsigned)(u.pm * 256 + wr * 64 + fr) * D + (unsigned)(u.pn * 256 + wc * 32 + 8 * fq);
        asm volatile("" : "+v"(off0));
        const unsigned offm = (unsigned)(u.pm * 256 + wr * 64 + fr) * (unsigned)PB8 + (unsigned)(u.pn * 256 + wc * 32 + 8 * fq);
        v2u sv[2][4][2];
#pragma unroll
        for (int ai = 0; ai < 2; ++ai)
#pragma unroll
            for (int m = 0; m < 4; ++m)
#pragma unroll
                for (int bj = 0; bj < 2; ++bj) sv[ai][m][bj] = *(const v2u*)(SGB + off0 + (unsigned)((ai * 128 + m * 16) * D) + bj * 128);
#pragma unroll
        for (int ai = 0; ai < 2; ++ai) {
#pragma unroll
            for (int m = 0; m < 4; ++m)
#pragma unroll
                for (int bj = 0; bj < 2; ++bj) { const v2u s = sv[ai][m][bj];
                    const f32x4 v0 = acc[ai][bj][m][0] * (f8x4(s.x) * (SMG / (SB8 * SWP * SG8)));
                    const f32x4 v1 = acc[ai][bj][m][1] * (f8x4(s.y) * (SMG / (SB8 * SWP * SG8)));
                    v2u w; w.x = pk4_fp8(v0.x, v0.y, v0.z, v0.w); w.y = pk4_fp8(v1.x, v1.y, v1.z, v1.w);
                    *(v2u*)(MG + offm + (unsigned)((ai * 128 + m * 16) * PB8) + bj * 128) = w; }
            asm volatile("" ::: "memory");
        }
    }
};

template <int L> struct EpiOutT {
    static constexpr bool PERM = false, MIDK = false;
    const float* xp; const bf16* rb0; const f32x2* st0; const float *g0, *b0;
    const float* gate;
    bf16* rb; f32x2* rst;
    __device__ __forceinline__ void mid(pg8::f32x4 (&)[2][2][4][2], const pg8::Unit&, int, int, int, int) const {}
    __device__ __forceinline__ void operator()(const pg8::f32x4 (&acc)[2][2][4][2], const pg8::Unit& u, int wr, int wc, int fr_, int fq_) const {
        const int ln_ = lane_now(), fr = ln_ & 15, fq = ln_ >> 4; (void)fr_; (void)fq_;
        const unsigned col0 = (unsigned)(u.pn * 256 + wc * 32 + 4 * fq);
        const unsigned rowb = (unsigned)(u.pm * 256 + wr * 64 + fr);
        const unsigned eo0 = rowb * D + col0;
        const char* gb = (const char*)(gate + (size_t)(u.pm >> 3) * NMOD) + col0 * 4u;
        f32x4 gv[2][2], g0v[2][2], b0v[2][2];
#pragma unroll
        for (int bj = 0; bj < 2; ++bj)
#pragma unroll
            for (int n = 0; n < 2; ++n) { gv[bj][n] = *(const f32x4*)(gb + (bj * 128 + n * 16) * 4);
                if (L == 1) { g0v[bj][n] = *(const f32x4*)((const char*)g0 + (col0 + bj * 128 + n * 16) * 4u); b0v[bj][n] = *(const f32x4*)((const char*)b0 + (col0 + bj * 128 + n * 16) * 4u); } }
#pragma unroll
        for (int ap = 0; ap < 4; ++ap) { const int ai = ap >> 1, m0 = (ap & 1) * 2;
            f32x4 xv[2][2][2]; v2u xb[2][2][2]; f32x2 st[2];
#pragma unroll
            for (int mm = 0; mm < 2; ++mm) { const unsigned eo = eo0 + (unsigned)((ai * 128 + (m0 + mm) * 16) * D);
                if (L == 1) st[mm] = st0[rowb + (unsigned)(ai * 128 + (m0 + mm) * 16)];
#pragma unroll
                for (int bj = 0; bj < 2; ++bj)
#pragma unroll
                    for (int n = 0; n < 2; ++n) {
                        if (L == 0) xv[mm][bj][n] = *(const f32x4*)((const char*)xp + (eo + bj * 128 + n * 16) * 4u);
                        else xb[mm][bj][n] = *(const v2u*)((const char*)rb0 + (eo + bj * 128 + n * 16) * 2u); } }
#pragma unroll
            for (int mm = 0; mm < 2; ++mm) { const int m = m0 + mm; const unsigned eo = eo0 + (unsigned)((ai * 128 + m * 16) * D); const unsigned row = rowb + (unsigned)(ai * 128 + m * 16);
                float s1 = 0.f, s2 = 0.f;
#pragma unroll
                for (int bj = 0; bj < 2; ++bj)
#pragma unroll
                    for (int n = 0; n < 2; ++n) { f32x4 x;
                        if (L == 0) x = xv[mm][bj][n];
                        else { const v2u w = xb[mm][bj][n]; x = ((f32x4){bflo(w.x), bfhi(w.x), bflo(w.y), bfhi(w.y)} - st[mm].x) * st[mm].y * g0v[bj][n] + b0v[bj][n]; }
                        const f32x4 r = x * ALPHA + gv[bj][n] * (acc[ai][bj][m][n] * (1.0f / (SMG * SWO)));
                        v2u o; o.x = pg8::cvt_pk_bf16(r.x, r.y); o.y = pg8::cvt_pk_bf16(r.z, r.w);
                        *(v2u*)((char*)rb + (eo + bj * 128 + n * 16) * 2u) = o;
                        s1 += (r.x + r.y) + (r.z + r.w); s2 += (r.x * r.x + r.y * r.y) + (r.z * r.z + r.w * r.w); }
                s1 = xadd<32>(xadd<16>(s1)); s2 = xadd<32>(xadd<16>(s2));
                if (fq == 0) rst[(size_t)row * 64 + u.pn * 4 + wc] = (f32x2){s1, s2};
            }
            asm volatile("" ::: "memory");
        }
    }
};

typedef short bf16x8_t __attribute__((ext_vector_type(8)));
typedef short s16x4_t __attribute__((ext_vector_type(4)));
typedef float f32x16 __attribute__((ext_vector_type(16)));
__device__ __forceinline__ s16x4_t vtr(const LAS char* p) { return __builtin_bit_cast(s16x4_t, __builtin_amdgcn_ds_read_tr16_b64_v4i16((LAS s16x4_t*)p)); }
__device__ __forceinline__ bf16x8_t cat8(s16x4_t a, s16x4_t b) { return (bf16x8_t){a[0], a[1], a[2], a[3], b[0], b[1], b[2], b[3]}; }
#define MFMA32(a, b, c) __builtin_amdgcn_mfma_f32_32x32x16_bf16((a), (b), (c), 0, 0, 0)

__device__ __forceinline__ void attn_prompt_unit(Frame& F, int l, int unit) {
    const int kv = unit & 3, n = (unit >> 2) & 15, b = unit >> 6, tid = F.tid, lane = F.lane;
    LAS char* Kl = (LAS char*)F.lds; LAS char* Vl = Kl + 32768;
    const bf16* Kb = WSP(bf16, WS_KB); const bf16* Vb = WSP(bf16, WS_VB); const unsigned char* Qb = WSP(unsigned char, WS_QB); const unsigned char* Za = WSP(unsigned char, WS_ZA); unsigned char* AB = WSP(unsigned char, WS_AB);
    const int rowq0 = b * SEQ + n * 128, rowk0 = rowq0 - 128;
#pragma unroll
    for (int i = 0; i < 4; ++i) { const int idx = tid + 512 * i;
        { const int chunk = idx >> 8, key = idx & 255; v4u v = (v4u){0u, 0u, 0u, 0u};
          if (n > 0 || key >= 128) v = *(const v4u*)(Kb + (size_t)(rowk0 + key) * 256 + kv * 64 + chunk * 8);
          *(LAS v4u*)(Kl + chunk * 4096 + key * 16) = v; }
        { const int dh = idx >> 10, key = (idx >> 2) & 255, c4 = idx & 3; v4u v = (v4u){0u, 0u, 0u, 0u};
          if (n > 0 || key >= 128) v = *(const v4u*)(Vb + (size_t)(rowk0 + key) * 256 + kv * 64 + dh * 32 + c4 * 8);
          *(LAS v4u*)(Vl + dh * 16384 + key * 64 + c4 * 16) = v; } }
    const int h = lane >> 5, r32 = lane & 31, head = kv * 8 + F.wave;
    v2u qn[4];
#pragma unroll
    for (int ks = 0; ks < 4; ++ks) qn[ks] = *(const v2u*)(Qb + (size_t)(rowq0 + r32) * 2048 + head * 64 + 16 * ks + 8 * h);
    __syncthreads();
    const float sink2 = inp(F, I_SINK)[l * 32 + head] * LOG2E;
    const LAS char* kbase = Kl + h * 4096 + r32 * 16;
    const LAS char* vbase = Vl + (4 * h + ((lane & 15) >> 2)) * 64 + ((lane >> 4) & 1) * 32 + (lane & 3) * 8;
#pragma unroll 1
    for (int c = 0; c < 4; ++c) {
        const size_t qrow = (size_t)(rowq0 + 32 * c + r32);
        bf16x8_t qf[4];
#pragma unroll
        for (int ks = 0; ks < 4; ++ks) { const f32x4 a = f8x4(qn[ks].x) * (1.0f / SQ8), b2 = f8x4(qn[ks].y) * (1.0f / SQ8);
            v4u w; w.x = pg8::cvt_pk_bf16(a.x, a.y); w.y = pg8::cvt_pk_bf16(a.z, a.w); w.z = pg8::cvt_pk_bf16(b2.x, b2.y); w.w = pg8::cvt_pk_bf16(b2.z, b2.w);
            qf[ks] = __builtin_bit_cast(bf16x8_t, w); }
        { const size_t qnext = qrow + (c + 1 < 4 ? 32 : 0);
#pragma unroll
            for (int ks = 0; ks < 4; ++ks) qn[ks] = *(const v2u*)(Qb + qnext * 2048 + head * 64 + 16 * ks + 8 * h); }
        unsigned zv[2][4];
#pragma unroll
        for (int dt = 0; dt < 2; ++dt)
#pragma unroll
            for (int g4 = 0; g4 < 4; ++g4) zv[dt][g4] = *(const unsigned*)(Za + qrow * 2048 + head * 64 + 32 * dt + 8 * g4 + 4 * h);
        f32x16 S[5];
#pragma unroll
        for (int k5 = 0; k5 < 5; ++k5)
#pragma unroll
            for (int r = 0; r < 16; ++r) S[k5][r] = 0.f;
        {
          bf16x8_t kf[2][5];
#pragma unroll
          for (int k5 = 0; k5 < 5; ++k5) kf[0][k5] = *(const LAS bf16x8_t*)(kbase + (32 * (c + k5)) * 16);
#pragma unroll
          for (int ks = 0; ks < 4; ++ks) {
              if (ks + 1 < 4) {
#pragma unroll
                  for (int k5 = 0; k5 < 5; ++k5) kf[(ks + 1) & 1][k5] = *(const LAS bf16x8_t*)(kbase + (2 * (ks + 1)) * 4096 + (32 * (c + k5)) * 16); }
              __builtin_amdgcn_sched_barrier(0);
#pragma unroll
              for (int k5 = 0; k5 < 5; ++k5) S[k5] = MFMA32(kf[ks & 1][k5], qf[ks], S[k5]);
              __builtin_amdgcn_sched_barrier(0);
          } }
        float mx = sink2;
#pragma unroll
        for (int k5 = 0; k5 < 5; ++k5) { const bool dead = (n == 0) && (c + k5 < 4);
            float bm = -INFINITY;
#pragma unroll
            for (int r = 0; r < 16; ++r) { const int kk = (r & 3) + 8 * (r >> 2) + 4 * h; float v = S[k5][r];
                if (k5 == 0) v = (kk > r32) ? v : -INFINITY;
                if (k5 == 4) v = (kk <= r32) ? v : -INFINITY;
                S[k5][r] = v; bm = fmaxf(bm, v); }
            mx = fmaxf(mx, dead ? -INFINITY : bm); }
        mx = xmax<32>(mx);
        float ls = 0.f;
#pragma unroll
        for (int k5 = 0; k5 < 5; ++k5) { const float off = ((n == 0) && (c + k5 < 4)) ? INFINITY : mx;
#pragma unroll
            for (int r = 0; r < 16; ++r) { const float p = __builtin_amdgcn_exp2f(S[k5][r] - off); S[k5][r] = p; ls += p; } }
        ls = xadd<32>(ls); ls += __builtin_amdgcn_exp2f(sink2 - mx);
        f32x16 O[2];
#pragma unroll
        for (int r = 0; r < 16; ++r) { O[0][r] = 0.f; O[1][r] = 0.f; }
        {
          s16x4_t vq[2][2][2];
          const LAS char* vp0 = vbase + (32 * c) * 64;
#pragma unroll
          for (int dt = 0; dt < 2; ++dt) { vq[0][dt][0] = vtr(vp0 + dt * 16384); vq[0][dt][1] = vtr(vp0 + dt * 16384 + 512); }
#pragma unroll
          for (int j = 0; j < 10; ++j) { const int k5 = j >> 1, s = j & 1;
              if (j + 1 < 10) { const LAS char* vp = vp0 + (16 * (j + 1)) * 64;
#pragma unroll
                  for (int dt = 0; dt < 2; ++dt) { vq[(j + 1) & 1][dt][0] = vtr(vp + dt * 16384); vq[(j + 1) & 1][dt][1] = vtr(vp + dt * 16384 + 512); } }
              v4u pw; pw.x = pg8::cvt_pk_bf16(S[k5][8 * s + 0], S[k5][8 * s + 1]); pw.y = pg8::cvt_pk_bf16(S[k5][8 * s + 2], S[k5][8 * s + 3]);
              pw.z = pg8::cvt_pk_bf16(S[k5][8 * s + 4], S[k5][8 * s + 5]); pw.w = pg8::cvt_pk_bf16(S[k5][8 * s + 6], S[k5][8 * s + 7]);
              const bf16x8_t pf = __builtin_bit_cast(bf16x8_t, pw);
              __builtin_amdgcn_sched_barrier(0);
#pragma unroll
              for (int dt = 0; dt < 2; ++dt) O[dt] = MFMA32(cat8(vq[j & 1][dt][0], vq[j & 1][dt][1]), pf, O[dt]);
              __builtin_amdgcn_sched_barrier(0);
          } }
        const float inv = SA8 / (SZA8 * ls);
#pragma unroll
        for (int dt = 0; dt < 2; ++dt)
#pragma unroll
            for (int g4 = 0; g4 < 4; ++g4) { const int d0 = head * 64 + 32 * dt + 8 * g4 + 4 * h;
                const f32x4 z = f8x4(zv[dt][g4]);
                *(unsigned*)(AB + qrow * PB8 + d0) = pk4_fp8(O[dt][4 * g4 + 0] * inv * z.x, O[dt][4 * g4 + 1] * inv * z.y, O[dt][4 * g4 + 2] * inv * z.z, O[dt][4 * g4 + 3] * inv * z.w); }
    }
    __syncthreads();
}
__device__ __forceinline__ void attn_sample_unit(Frame& F, int l, int unit) {
    const int kv = unit & 3, b = unit >> 2, h = kv * 8 + F.wave, lane = F.lane, tid = F.tid;
    LAS float* Kf = (LAS float*)F.lds;
    LAS float* Vf = Kf + 8704;
    LAS float* qs = Kf + 17408 + F.wave * 1024;
    LAS float* ps = qs + 256;
    const unsigned char* Qb = WSP(unsigned char, WS_QB); const unsigned char* Za = WSP(unsigned char, WS_ZA); unsigned char* AB = WSP(unsigned char, WS_AB);
    const int row0 = MP + b * 4;
    const float* ck = inp(F, I_CK) + ((size_t)(l * 32 + b) * 128) * 256 + kv * 64;
    const float* cv = inp(F, I_CV) + ((size_t)(l * 32 + b) * 128) * 256 + kv * 64;
    const float* nk = F.out + O_NK + (size_t)(l * 128 + b * 4) * 256 + kv * 64;
    const float* nv = F.out + O_NV + (size_t)(l * 128 + b * 4) * 256 + kv * 64;
    unsigned char zq[4];
#pragma unroll
    for (int t = 0; t < 4; ++t) zq[t] = Za[(size_t)(row0 + t) * 2048 + h * 64 + lane];
    { f32x4 kx[5], vx[5]; unsigned char qv[4];
#pragma unroll
      for (int j = 0; j < 5; ++j) { const int i = tid + 512 * j, ic = i < 132 * 16 ? i : 132 * 16 - 1, key = ic >> 4, d4 = (ic & 15) * 4;
        kx[j] = *(const f32x4*)((key < 128 ? ck + (size_t)key * 256 : nk + (size_t)(key - 128) * 256) + d4);
        vx[j] = *(const f32x4*)((key < 128 ? cv + (size_t)key * 256 : nv + (size_t)(key - 128) * 256) + d4); }
#pragma unroll
      for (int t = 0; t < 4; ++t) qv[t] = Qb[(size_t)(row0 + t) * 2048 + h * 64 + lane];
#pragma unroll
      for (int j = 0; j < 5; ++j) { const int i = tid + 512 * j, key = i >> 4, d4 = (i & 15) * 4;
        if (i < 132 * 16) { LAS float* kd = Kf + key * 65 + d4; kd[0] = kx[j].x; kd[1] = kx[j].y; kd[2] = kx[j].z; kd[3] = kx[j].w;
            *(LAS f32x4*)(Vf + key * 64 + d4) = vx[j]; } }
#pragma unroll
      for (int t = 0; t < 4; ++t) qs[t * 64 + lane] = f8x1(qv[t]) * (1.0f / SQ8); }
    __syncthreads();
    const float sink2 = inp(F, I_SINK)[l * 32 + h] * LOG2E;
    float sc[3][4];
#pragma unroll
    for (int ps_ = 0; ps_ < 3; ++ps_) {
        const int key = ps_ * 64 + lane; const bool inr = key < 132; const LAS float* kr = Kf + (inr ? key : 0) * 65;
        float s[4] = {0.f, 0.f, 0.f, 0.f};
#pragma unroll 4
        for (int d4 = 0; d4 < 16; ++d4) { const float k0 = kr[d4 * 4], k1 = kr[d4 * 4 + 1], k2 = kr[d4 * 4 + 2], k3 = kr[d4 * 4 + 3];
#pragma unroll
            for (int t = 0; t < 4; ++t) { const f32x4 qx = *(const LAS f32x4*)(qs + t * 64 + d4 * 4); s[t] += (qx.x * k0 + qx.y * k1) + (qx.z * k2 + qx.w * k3); } }
#pragma unroll
        for (int t = 0; t < 4; ++t) { const bool ok = inr && (key < 128 ? key > t : (key - 128) <= t); sc[ps_][t] = ok ? s[t] : -INFINITY; }
    }
#pragma unroll
    for (int t = 0; t < 4; ++t) {
        float mx = fmaxf(fmaxf(sc[0][t], sc[1][t]), fmaxf(sc[2][t], sink2));
        mx = xmax_wave(mx);
        float p0 = __builtin_amdgcn_exp2f(sc[0][t] - mx), p1 = __builtin_amdgcn_exp2f(sc[1][t] - mx), p2 = __builtin_amdgcn_exp2f(sc[2][t] - mx);
        float sum = p0 + p1 + p2;
        sum = xadd_wave(sum);
        const float inv = 1.0f / (sum + __builtin_amdgcn_exp2f(sink2 - mx));
        ps[t * 136 + lane] = p0 * inv; ps[t * 136 + 64 + lane] = p1 * inv; if (lane < 8) ps[t * 136 + 128 + lane] = p2 * inv;
    }
    LDS_WAIT(); asm volatile("" ::: "memory");
    float o[4] = {0.f, 0.f, 0.f, 0.f};
#pragma unroll 4
    for (int key = 0; key < 132; ++key) { const float v = Vf[key * 64 + lane];
#pragma unroll
        for (int t = 0; t < 4; ++t) o[t] += ps[t * 136 + key] * v; }
#pragma unroll
    for (int t = 0; t < 4; ++t) { const size_t row = (size_t)(row0 + t); const float z = f8x1(zq[t]) * (1.0f / SZA8);
        AB[row * PB8 + h * 64 + lane] = (unsigned char)(pk4_fp8(o[t] * z * SA8, 0.f, 0.f, 0.f) & 0xffu); }
    __syncthreads();
}
__device__ __forceinline__ void sgu_prompt_unit(Frame& F, int l, int unit, int par) {
    const int g = unit & 7, n = (unit >> 3) & 15, b = unit >> 7, tid = F.tid, lane = F.lane, w = F.wave;
    LAS f32x2* rs = (LAS f32x2*)(F.lds + 65536) + par * 128;
    LAS char* Lw = (LAS char*)F.lds + w * 8192;
    const f32x2* vst = WSP(f32x2, WS_VST); const unsigned char* Vbb = WSP(unsigned char, WS_VBB); const unsigned char* UZ = WSP(unsigned char, WS_UZ); unsigned char* AB = WSP(unsigned char, WS_AB); const bf16* Wsb = WSP(bf16, WS_WSB);
    const int row0 = b * SEQ + n * 128, colw = g * 256 + 32 * w, h = lane >> 5, r32 = lane & 31, ch = lane & 3;
    f32x2 pst[8];
    { const int row = tid >> 2, part = tid & 3;
#pragma unroll
      for (int k = 0; k < 8; ++k) pst[k] = vst[(size_t)(row0 + row) * 32 + part * 8 + k]; }
    v2u xv[8];
#pragma unroll
    for (int i = 0; i < 8; ++i) xv[i] = *(const v2u*)(Vbb + (size_t)(row0 + (lane >> 2) + 16 * i) * 2048 + colw + ch * 8);
    unsigned uzv[4][4];
#pragma unroll
    for (int tb = 0; tb < 4; ++tb)
#pragma unroll
        for (int g4 = 0; g4 < 4; ++g4) uzv[tb][g4] = *(const unsigned*)(UZ + (size_t)(row0 + 32 * tb + r32) * 2048 + colw + 8 * g4 + 4 * h);
    const float* sg = inp(F, I_SG) + l * 2048 + colw + ch * 8; const float* sb = inp(F, I_SB) + l * 2048 + colw + ch * 8;
    const f32x4 g0 = *(const f32x4*)sg, g1 = *(const f32x4*)(sg + 4), b0 = *(const f32x4*)sb, b1 = *(const f32x4*)(sb + 4);
    const float* bs = inp(F, I_SBS) + (size_t)(l * 8 + g) * 128;
    float bst[4];
#pragma unroll
    for (int tb = 0; tb < 4; ++tb) bst[tb] = bs[32 * tb + r32];
    const bf16* Wg = Wsb + (size_t)(l * 8 + g) * 16384 + 8 * h;
    bf16x8_t bfr[20];
#pragma unroll
    for (int tb = 0; tb < 4; ++tb)
#pragma unroll
        for (int ks = 0; ks < 2 * tb + 2; ++ks) bfr[tb * (tb + 1) + ks] = *(const bf16x8_t*)(Wg + (32 * tb + r32) * 128 + 16 * ks);
    { const int row = tid >> 2, part = tid & 3; float s1 = 0.f, s2 = 0.f;
#pragma unroll
      for (int k = 0; k < 8; ++k) { s1 += pst[k].x; s2 += pst[k].y; }
      s1 = xadd<2>(xadd<1>(s1)); s2 = xadd<2>(xadd<1>(s2));
      const float mean = s1 * (1.0f / 2048.0f), var = s2 * (1.0f / 2048.0f) - mean * mean;
      if (part == 0) rs[row] = (f32x2){mean, 1.0f / sqrtf(var + LN_EPS)}; }
    __syncthreads();
    f32x2 stv[8];
#pragma unroll
    for (int i = 0; i < 8; ++i) stv[i] = rs[(lane >> 2) + 16 * i];
#pragma unroll
    for (int i = 0; i < 8; ++i) { const int sp = (lane >> 2) + 16 * i; const v2u x = xv[i]; const f32x2 st = stv[i];
        const f32x4 v0 = (f8x4(x.x) * (1.0f / SVB8) - st.x) * st.y * g0 + b0;
        const f32x4 v1 = (f8x4(x.y) * (1.0f / SVB8) - st.x) * st.y * g1 + b1;
        v4u o; o.x = pg8::cvt_pk_bf16(v0.x, v0.y); o.y = pg8::cvt_pk_bf16(v0.z, v0.w); o.z = pg8::cvt_pk_bf16(v1.x, v1.y); o.w = pg8::cvt_pk_bf16(v1.z, v1.w);
        *(LAS v4u*)(Lw + sp * 64 + ch * 16) = o; }
    LDS_WAIT(); asm volatile("" ::: "memory");
    bf16x8_t af[8];
    { const LAS char* ap = Lw + (8 * h + ((lane & 15) >> 2)) * 64 + ((lane >> 4) & 1) * 32 + (lane & 3) * 8;
#pragma unroll
      for (int ks = 0; ks < 8; ++ks) af[ks] = cat8(vtr(ap + ks * 1024), vtr(ap + ks * 1024 + 256)); }
#pragma unroll
    for (int tb = 0; tb < 4; ++tb) { const int t = 32 * tb + r32; f32x16 a;
#pragma unroll
        for (int r = 0; r < 16; ++r) a[r] = 0.f;
#pragma unroll
        for (int ks = 0; ks < 2 * tb + 2; ++ks) a = MFMA32(af[ks], bfr[tb * (tb + 1) + ks], a);
        const size_t row = (size_t)(row0 + t);
#pragma unroll
        for (int g4 = 0; g4 < 4; ++g4) { const int c0 = colw + 8 * g4 + 4 * h;
            const f32x4 uz = f8x4(uzv[tb][g4]) * (SB8 / SUZ8);
            *(unsigned*)(AB + row * PB8 + 2048 + c0) = pk4_fp8(uz.x * (a[4 * g4 + 0] + bst[tb]), uz.y * (a[4 * g4 + 1] + bst[tb]), uz.z * (a[4 * g4 + 2] + bst[tb]), uz.w * (a[4 * g4 + 3] + bst[tb])); }
    }
    LDS_WAIT(); asm volatile("" ::: "memory");
}
__device__ __forceinline__ void sgu_sample_unit(Frame& F, int l, int b) {
    const int tid = F.tid, c0 = tid * 4, g = c0 >> 8, row0 = MP + b * 4;
    LAS f32x2* rs = (LAS f32x2*)(F.lds);
    const f32x2* vst = WSP(f32x2, WS_VST); const unsigned char* UZ = WSP(unsigned char, WS_UZ); unsigned char* AB = WSP(unsigned char, WS_AB);
    const bf16* Vbs = WSP(bf16, WS_VBS);
    if (tid < 128) { const int row = tid >> 5, k = tid & 31; const f32x2 p = vst[(size_t)(row0 + row) * 32 + k]; float s1 = p.x, s2 = p.y;
        s1 = xadd_32(s1); s2 = xadd_32(s2);
        const float mean = s1 * (1.0f / 2048.0f), var = s2 * (1.0f / 2048.0f) - mean * mean;
        if (k == 0) rs[row] = (f32x2){mean, 1.0f / sqrtf(var + LN_EPS)}; }
    __syncthreads();
    const f32x4 gn = *(const f32x4*)(inp(F, I_SG) + l * 2048 + c0), bi = *(const f32x4*)(inp(F, I_SB) + l * 2048 + c0);
    f32x4 ln[4];
#pragma unroll
    for (int t = 0; t < 4; ++t) { const v2u w = *(const v2u*)(Vbs + (size_t)(b * 4 + t) * 2048 + c0); const f32x2 st = rs[t];
        ln[t] = ((f32x4){bflo(w.x), bfhi(w.x), bflo(w.y), bfhi(w.y)} - st.x) * st.y * gn + bi;
        *(f32x4*)(F.out + O_SV + ((size_t)(l * 32 + b) * 4 + t) * 2048 + c0) = ln[t]; }
    const float* Wg = inp(F, I_SW) + (size_t)(l * 8 + g) * 16384; const float* bs = inp(F, I_SBS) + (size_t)(l * 8 + g) * 128;
#pragma unroll
    for (int t = 0; t < 4; ++t) { f32x4 a = (f32x4){bs[t], bs[t], bs[t], bs[t]};
#pragma unroll
        for (int s = 0; s <= t; ++s) a += Wg[t * 128 + s] * ln[s];
        const f32x4 uz = f8x4(*(const unsigned*)(UZ + (size_t)(row0 + t) * 2048 + c0)) * (SB8 / SUZ8);
        *(unsigned*)(AB + (size_t)(row0 + t) * PB8 + 2048 + c0) = pk4_fp8(uz.x * a.x, uz.y * a.y, uz.z * a.z, uz.w * a.w); }
    __syncthreads();
}

template <int MODE> __device__ __forceinline__ void skinny_gemm(Frame& F, int l, int unit) {
    const int lane = F.lane, w = F.wave, r16 = lane & 15, kq = lane >> 4, rb = w & 1, cb = w >> 1;
    const int rin = 32 * (unit & 3) + 16 * rb + r16, row = MP + rin, n0 = 64 * (unit >> 2), col = n0 + 16 * cb + 4 * kq;
    LAS char* R0 = (LAS char*)F.lds;
    const int lr = lane >> 5, lc = lane & 31;
    const char* Ag[2]; const char* Bg[4];
#pragma unroll
    for (int i = 0; i < 2; ++i) { const int r = 2 * (2 * w + i) + lr; Ag[i] = (const char*)(MODE == 0 ? WSP(unsigned char, WS_AB) : WSP(unsigned char, WS_MG)) + (size_t)(MP + 32 * (unit & 3) + r) * PB8 + ((lc ^ (r & 15)) & 31) * 16; }
#pragma unroll
    for (int i = 0; i < 4; ++i) { const int r = 2 * (4 * w + i) + lr; Bg[i] = (const char*)(MODE == 0 ? WSP(unsigned char, WS_WP) : WSP(unsigned char, WS_WO)) + (size_t)l * D * PB8 + (size_t)(n0 + r) * PB8 + ((lc ^ (r & 15)) & 31) * 16; }
#define SK_STAGE(blk) do { LAS char* Rd = R0 + ((blk) % 3) * 49152; \
        _Pragma("unroll") for (int i = 0; i < 2; ++i) __builtin_amdgcn_global_load_lds((const unsigned*)(Ag[i] + (blk) * 512), (LAS unsigned*)(Rd + (2 * w + i) * 1024), 16, 0, 0); \
        _Pragma("unroll") for (int i = 0; i < 4; ++i) __builtin_amdgcn_global_load_lds((const unsigned*)(Bg[i] + (blk) * 512), (LAS unsigned*)(Rd + 16384 + (4 * w + i) * 1024), 16, 0, 0); } while (0)
    SK_STAGE(0); SK_STAGE(1);
    f32x4 acc = (f32x4){0.f, 0.f, 0.f, 0.f};
#pragma unroll 1
    for (int blk = 0; blk < 8; ++blk) {
        if (blk + 1 < 8) asm volatile("s_waitcnt vmcnt(6)" ::: "memory");
        else asm volatile("s_waitcnt vmcnt(0)" ::: "memory");
        __builtin_amdgcn_s_barrier(); asm volatile("" ::: "memory");
        if (blk + 2 < 8) SK_STAGE(blk + 2);
        if (MODE == 0 && blk == 4) { const v2u x = *(const v2u*)(WSP(bf16, WS_RR) + (size_t)row * D + col); acc = acc * ((f32x4){bflo(x.x), bfhi(x.x), bflo(x.y), bfhi(x.y)} * (SB8 / SA8)); }
        const LAS char* Ab = R0 + (blk % 3) * 49152 + (16 * rb + r16) * 512; const LAS char* Bb = R0 + (blk % 3) * 49152 + 16384 + (16 * cb + r16) * 512;
        pg8::v4i_t fa[4][2], fb[4][2];
#pragma unroll
        for (int u = 0; u < 4; ++u) { const int c0 = ((8 * u + kq) ^ r16) & 31, c1 = ((8 * u + 4 + kq) ^ r16) & 31;
            fa[u][0] = *(const LAS pg8::v4i_t*)(Ab + c0 * 16); fa[u][1] = *(const LAS pg8::v4i_t*)(Ab + c1 * 16);
            fb[u][0] = *(const LAS pg8::v4i_t*)(Bb + c0 * 16); fb[u][1] = *(const LAS pg8::v4i_t*)(Bb + c1 * 16); }
        __builtin_amdgcn_sched_barrier(0);
#pragma unroll
        for (int u = 0; u < 4; ++u)
            acc = __builtin_amdgcn_mfma_scale_f32_16x16x128_f8f6f4(__builtin_shufflevector(fb[u][0], fb[u][1], 0, 1, 2, 3, 4, 5, 6, 7), __builtin_shufflevector(fa[u][0], fa[u][1], 0, 1, 2, 3, 4, 5, 6, 7), acc, 0, 0, 0, 0x7f7f7f7f, 0, 0x7f7f7f7f);
        asm volatile("s_waitcnt lgkmcnt(0)" ::: "memory");
    }
    __builtin_amdgcn_s_barrier(); asm volatile("" ::: "memory");
#undef SK_STAGE
    if (MODE == 0) {
        const unsigned sg = *(const unsigned*)(WSP(unsigned char, WS_SGB) + (size_t)row * D + col);
        const f32x4 v = acc * (f8x4(sg) * (SMG / (SB8 * SWP * SG8)));
        *(unsigned*)(WSP(unsigned char, WS_MG) + (size_t)row * PB8 + col) = pk4_fp8(v.x, v.y, v.z, v.w);
    } else {
        const float* xr = (l == 0 ? inp(F, I_XS) : WSP(float, WS_X1S)) + (size_t)rin * D + col;
        const float* gr = WSP(float, WS_MOD) + (size_t)(l * NSEQ + 4 + (rin >> 2)) * NMOD + 2 * D + col;
        const f32x4 r = *(const f32x4*)xr * ALPHA + *(const f32x4*)gr * (acc * (1.0f / (SMG * SWO)));
        *(f32x4*)(WSP(float, WS_RS) + (size_t)rin * D + col) = r;
    }
}
__device__ __forceinline__ void ln_sample_row(Frame& F, int l, int rin, float* dst, bool hb) {
    const int row = MP + rin, seq = 4 + (rin >> 2), lane = F.lane;
    const float* rp = WSP(float, WS_RS) + (size_t)rin * D + lane * 4;
    f32x4 v[16]; float s1 = 0.f;
#pragma unroll
    for (int j = 0; j < 16; ++j) { v[j] = *(const f32x4*)(rp + 256 * j); s1 += (v[j].x + v[j].y) + (v[j].z + v[j].w); }
    s1 = xadd_wave(s1);
    const float mean = s1 * (1.0f / 4096.0f); float s2 = 0.f;
#pragma unroll
    for (int j = 0; j < 16; ++j) { v[j] = v[j] - mean; s2 += (v[j].x * v[j].x + v[j].y * v[j].y) + (v[j].z * v[j].z + v[j].w * v[j].w); }
    s2 = xadd_wave(s2);
    const float rstd = 1.0f / sqrtf(s2 * (1.0f / 4096.0f) + LN_EPS);
    const float* lg = inp(F, I_LNG) + l * D + lane * 4; const float* lb = inp(F, I_LNB) + l * D + lane * 4;
    const float* md = WSP(float, WS_MOD) + (size_t)(1 * NSEQ + seq) * NMOD + lane * 4; bf16* Hb = WSP(bf16, WS_HB) + (size_t)row * LDK + lane * 4; unsigned char* Hb8 = WSP(unsigned char, WS_HB8) + (size_t)row * PB8 + lane * 4;
#pragma unroll
    for (int j = 0; j < 16; ++j) { const f32x4 o = v[j] * rstd * *(const f32x4*)(lg + 256 * j) + *(const f32x4*)(lb + 256 * j);
        *(f32x4*)(dst + lane * 4 + 256 * j) = o;
        if (hb) { const f32x4 hv = o * (*(const f32x4*)(md + D + 256 * j) + 1.0f) + *(const f32x4*)(md + 256 * j); v2u p; p.x = pk2(hv.x, hv.y); p.y = pk2(hv.z, hv.w); *(GAS v2u*)(Hb + 256 * j) = p;
            *(GAS unsigned*)(Hb8 + 256 * j) = pk4_fp8(hv.x * SH8, hv.y * SH8, hv.z * SH8, hv.w * SH8); } }
}

__device__ __forceinline__ void ln_rows(Frame& F, int l, int row0, int nrows, int seq, int slice, float* dst  ) {
    const int col = slice * 1024 + F.lane * 4; const bool hb = (l == 0);
    f32x4 gn[4], bi[4], sh[4], sc[4];
    const float* md = WSP(float, WS_MOD) + (size_t)(1 * NSEQ + seq) * NMOD; const float* lg = inp(F, I_LNG) + l * D; const float* lb = inp(F, I_LNB) + l * D;
    const f32x2* rst = WSP(f32x2, WS_RST); const bf16* Rb = l == 0 ? WSP(bf16, WS_RB0) : WSP(bf16, WS_RB1); bf16* Hb = WSP(bf16, WS_HB); unsigned char* Hb8 = WSP(unsigned char, WS_HB8); f32x2* st0 = WSP(f32x2, WS_ST0);
    const bool wb = (row0 & 2047) >= 1792;
#pragma unroll
    for (int j = 0; j < 4; ++j) { gn[j] = *(const f32x4*)(lg + col + 256 * j); bi[j] = *(const f32x4*)(lb + col + 256 * j);
        if (hb) { sh[j] = *(const f32x4*)(md + col + 256 * j); sc[j] = *(const f32x4*)(md + D + col + 256 * j) + 1.0f; } else { sh[j] = (f32x4){0.f, 0.f, 0.f, 0.f}; sc[j] = sh[j]; } }
    for (int r0 = 0; r0 < nrows; r0 += 4) {
      f32x2 pp[4]; v2u wv[4][4];
#pragma unroll
      for (int rr = 0; rr < 4; ++rr) pp[rr] = rst[(size_t)(row0 + r0 + rr) * 64 + F.lane];
#pragma unroll
      for (int rr = 0; rr < 4; ++rr)
#pragma unroll
          for (int j = 0; j < 4; ++j) wv[rr][j] = *(const v2u*)(Rb + (size_t)(row0 + r0 + rr) * D + col + 256 * j);
#pragma unroll
      for (int rr = 0; rr < 4; ++rr) { const int r = r0 + rr;
        float s1 = pp[rr].x, s2 = pp[rr].y;
        s1 = xadd_wave(s1); s2 = xadd_wave(s2);
        const float mean = s1 * (1.0f / 4096.0f), var = s2 * (1.0f / 4096.0f) - mean * mean, rstd = 1.0f / sqrtf(var + LN_EPS);
        if (hb && slice == 0 && F.lane == 0) st0[row0 + r] = (f32x2){mean, rstd};
#pragma unroll
        for (int j = 0; j < 4; ++j) { const v2u w = wv[rr][j];
            const f32x4 v = ((f32x4){bflo(w.x), bfhi(w.x), bflo(w.y), bfhi(w.y)} - mean) * rstd * gn[j] + bi[j];
            if (hb) { const f32x4 hv = v * sc[j] + sh[j]; *(GAS unsigned*)(Hb8 + (size_t)(row0 + r) * PB8 + col + 256 * j) = pk4_fp8(hv.x * SH8, hv.y * SH8, hv.z * SH8, hv.w * SH8);
                if (wb) { v2u o; o.x = pk2(hv.x, hv.y); o.y = pk2(hv.z, hv.w); *(GAS v2u*)(Hb + (size_t)(row0 + r) * LDK + col + 256 * j) = o; } }
            else *(f32x4*)(dst + (size_t)r * D + col + 256 * j) = v; }
      }
    }
}

struct Args { const float* in[19]; float* out; unsigned char* ws; int ph_lo, ph_hi; };
#ifndef PH_MASK
#define PH_MASK 0xfff
#endif
__global__ void __launch_bounds__(NWAVES * 64, 2) mk_fwd(Args args) {
    extern __shared__ __attribute__((aligned(16))) unsigned char lds[];
    Frame F;
    F.lds = (LAS unsigned char*)lds;
    volatile LAS unsigned* MISC = (volatile LAS unsigned*)(F.lds + MISC_OFF);
    F.tid = threadIdx.x; F.lane = F.tid & 63; F.wave = __builtin_amdgcn_readfirstlane(F.tid >> 6); F.bx = blockIdx.x;
    F.ws = args.ws; F.out = args.out;
    gu32* ctl = (gu32*)(F.ws + WS_CTL);
    asm volatile("s_setreg_imm32_b32 hwreg(HW_REG_MODE, 23, 1), 1");
    for (int u = F.tid; u < (LDS_BYTES - LDSCTL_OFF) / 4; u += NWAVES * 64) ((LAS unsigned*)(F.lds + LDSCTL_OFF))[u] = 0u;
    __syncthreads();
    if (F.tid == 0) { volatile LAS unsigned long long* pt = (volatile LAS unsigned long long*)(F.lds + PTAB_OFF);
#pragma unroll
        for (int k = 0; k < 19; ++k) pt[k] = (unsigned long long)args.in[k]; }
    __syncthreads();
#if MK_SPLIT
    const int lo = args.ph_lo, hi = args.ph_hi;
#else
    constexpr int lo = 0, hi = 12;
#endif
    const bool use_bar = (hi - lo) > 1;
    XcdBarrier bar; bar.bar = (unsigned*)(ctl + CW_BAR); bar.x = 0; bar.st = nullptr;
    if (use_bar) bar = xcd_barrier_post((unsigned*)(ctl + CW_BAR), MISC + 8);
#define IN(k) (((PH_MASK >> ((k) > 6 ? (k) - 5 : (k))) & 1) && lo <= (k) && (k) < hi)
#define SEAM(k) do { if (lo <= (k) && (k) + 1 < hi) { REFRESH(); xcd_barrier(bar, F.tid == 0); } } while (0)
#define REFRESH() do { int t_, w_ = wave0, b_ = bx0; asm volatile("v_mbcnt_lo_u32_b32 %0, -1, 0\n\tv_mbcnt_hi_u32_b32 %0, -1, %0" : "=v"(t_), "+s"(w_), "+s"(b_)); F.lane = t_; F.wave = w_; F.bx = b_; F.tid = w_ * 64 + t_; } while (0)
#define GW (F.bx * NWAVES + F.wave)
    const int NGW = F.G * NWAVES; const int wave0 = F.wave, bx0 = F.bx;

    if (IN(0)) {
        asm volatile("; MARK_P0a");
        REFRESH();
        if (F.bx < 192) ada_item(F, F.bx);
        LAS float* scr = (LAS float*)(F.lds + F.wave * 16384);
        int sh = F.bx & 7, left = 8;
        for (;;) {
            const int v = pull8(ctl + CW_WORK0, (I_LAYER + I_WS) / 8, sh, left, F.lane);
            if (v < 0) break;
            copy_chunk(F, v < I_LAYER ? I_LAYER - 8 - v : I_TR + (v - I_LAYER), scr);
        }
    }
    SEAM(0);
    if (IN(1)) {
        asm volatile("; MARK_P0b");
        REFRESH();
        for (int it = GW; it < 2048 + 128; it += NGW) {
            if (it < 2048) { const int rb = it >> 2, sl = it & 3; h_rows(F, inp(F, I_XP) + (size_t)rb * 16 * D, rb * 16, 16, rb >> 7, sl, 0); }
            else { const int q = it - 2048, sq = q >> 2, sl = q & 3; h_rows(F, inp(F, I_XS) + (size_t)sq * 4 * D, MP + sq * 4, 4, 4 + sq, sl, 0); }
        }
    }
    SEAM(1);
#pragma unroll 1
    for (int l = 0; l < 2; ++l) {
        const int pb = 2 + 5 * l;
        if (IN(pb)) {
            asm volatile("; MARK_GEMM1");
            REFRESH();
            { pg8::Gemm g8{WSP(bf16, WS_HB8), (const bf16*)(WSP(unsigned char, WS_WIN8) + (size_t)l * NIN * PB8), MPAD, NIN, K8};
              OrderF8 S; S.c = F.bx; EpiInT<true> E{F.ws, F.out, l};
              pg8::gemm_phase<K8, LD8, EpiInT<true>, OrderF8, PG8_ALIGN, PG8_SP2, false, true>(F.lds, g8, S, E, F.wave); }
            REFRESH();
            { pg8::Gemm g{WSP(bf16, WS_HB), WSP(bf16, WS_WIN) + (size_t)l * NIN * LDK, MPAD, NIN, D};
              OrderBf S; S.c = F.bx; EpiInT<false> E{F.ws, F.out, l};
              pg8::gemm_phase<D, LDK, EpiInT<false>, OrderBf, PG8_ALIGN, PG8_SP2>(F.lds, g, S, E, F.wave); }
            if (l == 0) {
                REFRESH();
                if (F.tid == 0) (void)__hip_atomic_fetch_add((unsigned*)(ctl + CW_DONE1), 1u, RLX_AGENT);
                if (F.bx >= G1_UNITS - 2048 - G1_NF8W && F.bx < G1_NF8W) steal_copies(F, true, 1, 3);
            } else {
                REFRESH();
                if (F.bx >= G1_UNITS - 2048 - G1_NF8W && F.bx < G1_NF8W) steal_copies(F, false, 2, 1 << 20);
            }
        }
        SEAM(pb);
        if (IN(pb + 1)) {
            asm volatile("; MARK_MIX");
            REFRESH();
            for (int u = F.bx; u < 256; u += F.G) attn_prompt_unit(F, l, u);
            REFRESH();
            { int par = 0; for (int u = F.bx; u < 512; u += F.G) { sgu_prompt_unit(F, l, u, par); par ^= 1; } }
            __syncthreads();
            REFRESH();
            for (int u = F.bx; u < 128; u += F.G) attn_sample_unit(F, l, u);
            REFRESH();
            for (int u = F.bx - 128; u < 32; u += F.G) if (u >= 0) sgu_sample_unit(F, l, u);
            if (F.bx >= 160) {
                const unsigned char* wp = WSP(unsigned char, WS_WP) + (size_t)l * D * PB8; const unsigned char* wo = WSP(unsigned char, WS_WO) + (size_t)l * D * PB8;
                constexpr unsigned NB16 = (unsigned)((size_t)D * PB8 / 16);
                unsigned acc_ = 0;
                static_assert(NB16 == 22u * 96u * 512u, "22 pieces of each matrix per thread");
                const unsigned i0 = (unsigned)(F.bx - 160) * 512u + (unsigned)F.tid;
#pragma unroll
                for (int hh = 0; hh < 2; ++hh) { v4u a[11], b[11];
#pragma unroll
                    for (int j = 0; j < 11; ++j) { const size_t o = (size_t)(i0 + (unsigned)(hh * 11 + j) * 96u * 512u) * 16; a[j] = *(const v4u*)(wp + o); b[j] = *(const v4u*)(wo + o); }
#pragma unroll
                    for (int j = 0; j < 11; ++j) acc_ |= (a[j].x ^ b[j].x) & (a[j].y ^ b[j].y) & (a[j].z ^ b[j].z) & (a[j].w ^ b[j].w); }
                if (acc_ == 0x12345678u && F.tid == 99999) WSP(unsigned, WS_CTL)[8000] = acc_;
            }
        }
        SEAM(pb + 1);
        if (IN(pb + 2)) {
            asm volatile("; MARK_GEMM2");
            REFRESH();
            pg8::Gemm g{WSP(bf16, WS_AB), (const bf16*)(WSP(unsigned char, WS_WP) + (size_t)l * D * PB8), MP, D, K8}; pg8::StaticOrderC<MP, D> S; S.init(F.G, F.bx);
            EpiMerge E{WSP(bf16, WS_RR), WSP(unsigned char, WS_SGB), WSP(unsigned char, WS_MG)};
            if (F.bx & 8) { skinny_gemm<0>(F, l, F.bx); REFRESH(); }
            pg8::gemm_phase<K8, LD8, EpiMerge, pg8::StaticOrderC<MP, D>, PG8_ALIGN, PG8_SP2, false, true>(F.lds, g, S, E, F.wave);
            REFRESH();
            if (!(F.bx & 8)) skinny_gemm<0>(F, l, F.bx);
        }
        SEAM(pb + 2);
        if (IN(pb + 3)) {
            asm volatile("; MARK_GEMM3");
            REFRESH();
            pg8::Gemm g{WSP(bf16, WS_MG), (const bf16*)(WSP(unsigned char, WS_WO) + (size_t)l * D * PB8), MP, D, K8}; pg8::StaticOrderC<MP, D> S; S.init(F.G, F.bx);
            if (F.bx & 8) { skinny_gemm<1>(F, l, F.bx); REFRESH(); }
            if (l == 0) { EpiOutT<0> E{inp(F, I_XP), nullptr, nullptr, nullptr, nullptr, WSP(float, WS_MOD) + 2 * D, WSP(bf16, WS_RB0), WSP(f32x2, WS_RST)};
                pg8::gemm_phase<K8, LD8, EpiOutT<0>, pg8::StaticOrderC<MP, D>, PG8_ALIGN, PG8_SP2, false, true>(F.lds, g, S, E, F.wave); }
            else { EpiOutT<1> E{nullptr, WSP(bf16, WS_RB0), WSP(f32x2, WS_ST0), inp(F, I_LNG), inp(F, I_LNB), WSP(float, WS_MOD) + (size_t)NSEQ * NMOD + 2 * D, WSP(bf16, WS_RB1), WSP(f32x2, WS_RST)};
                pg8::gemm_phase<K8, LD8, EpiOutT<1>, pg8::StaticOrderC<MP, D>, PG8_ALIGN, PG8_SP2, false, true>(F.lds, g, S, E, F.wave); }
            REFRESH();
            if (!(F.bx & 8)) skinny_gemm<1>(F, l, F.bx);
        }
        SEAM(pb + 3);
        if (IN(pb + 4)) {
            asm volatile("; MARK_LN");
            REFRESH();
            float* dp = F.out + O_YP; float* ds = l == 0 ? WSP(float, WS_X1S) : F.out + O_YS;
            for (int it = GW; it < 2048 + 128; it += NGW) {
                if (it < 2048) { const int rb = it >> 2, sl = it & 3; ln_rows(F, l, rb * 16, 16, rb >> 7, sl, dp + (size_t)rb * 16 * D); }
                else { const int rin = it - 2048; ln_sample_row(F, l, rin, ds + (size_t)rin * D, l == 0); }
            }
            if (l == 0) steal_copies(F, false, 1, 1 << 20);
        }
        if (l == 0) SEAM(pb + 4);
    }
#undef IN
#undef SEAM
}

extern "C" void kernel_launch(void* const* d_in, const int* in_sizes, int n_in, void* d_out, int out_size, void* d_ws, size_t ws_size, hipStream_t stream) {
    static int grid = 0;
    if (grid == 0) {
        if (n_in != 19 || out_size != (int)O_END || ws_size < WS_END) { fprintf(stderr, "kernel_launch: unexpected sizes (n_in %d, out %d, ws %zu); nothing launched\n", n_in, out_size, ws_size); grid = -1; return; }
        int dev = 0, cus = 0, per_cu = 0;
        if (hipGetDevice(&dev) != hipSuccess || hipDeviceGetAttribute(&cus, hipDeviceAttributeMultiprocessorCount, dev) != hipSuccess) { grid = -1; return; }
        if (hipFuncSetAttribute((const void*)mk_fwd, hipFuncAttributeMaxDynamicSharedMemorySize, LDS_BYTES) != hipSuccess) { fprintf(stderr, "kernel_launch: hipFuncSetAttribute failed\n"); grid = -1; return; }
        if (hipOccupancyMaxActiveBlocksPerMultiprocessor(&per_cu, (const void*)mk_fwd, NWAVES * 64, LDS_BYTES) != hipSuccess || per_cu < 1)
            fprintf(stderr, "kernel_launch: note: occupancy query reports %d workgroups per CU\n", per_cu);
        (void)hipGetLastError();
        if (cus != Frame::G) { fprintf(stderr, "kernel_launch: built for a %d-CU device, found %d CUs; nothing launched\n", Frame::G, cus); grid = -1; return; }
        grid = cus;
    }
    if (grid < 0) return;
    if (hipMemsetAsync((char*)d_ws + WS_CTL, 0, CTL_ZERO_BYTES, stream) != hipSuccess) return;
    Args a{};
    for (int i = 0; i < 19; ++i) a.in[i] = (const float*)d_in[i];
    a.out = (float*)d_out; a.ws = (unsigned char*)d_ws;
#if MK_SPLIT
    for (int p = 0; p < 12; ++p) { a.ph_lo = p; a.ph_hi = p + 1; hipLaunchKernelGGL(mk_fwd, dim3(grid), dim3(NWAVES * 64), LDS_BYTES, stream, a); }
#else
    a.ph_lo = 0; a.ph_hi = 12;
    hipLaunchKernelGGL(mk_fwd, dim3(grid), dim3(NWAVES * 64), LDS_BYTES, stream, a);
#endif
    const hipError_t le = hipPeekAtLastError();
    if (le != hipSuccess) fprintf(stderr, "kernel_launch: launch failed: %s\n", hipGetErrorName(le));
}
```

```cpp
#include <hip/hip_runtime.h>
#include <cstdio>
#include <cstdint>

namespace pg8 {
#define PG8_LAS __attribute__((address_space(3)))
typedef unsigned short bf16_t;
typedef short bf16x8 __attribute__((ext_vector_type(8)));
typedef float f32x4 __attribute__((ext_vector_type(4)));
typedef unsigned u32x4 __attribute__((ext_vector_type(4)));
typedef unsigned u32x2 __attribute__((ext_vector_type(2)));
typedef int v4i_t __attribute__((ext_vector_type(4)));
constexpr int BM = 256, BK = 64, HALF = 128, HTB = HALF * BK * 2  , STAGE_BYTES = 8 * HTB, NXCD = 8, WGM = 8;

__host__ __device__ __forceinline__ int lds_byte(int r, int c) { const int st = (r >> 4) * 2 + (c >> 5), rr = r & 15, cc = c & 31, ob = rr * 64 + cc * 2; return st * 1024 + (ob ^ (((ob >> 9) & 1) << 5)); }
__host__ __device__ __forceinline__ void stage_rc(int b, int& R, int& C) { const int st = b / 1024, sb = b % 1024, swz = sb ^ (((sb >> 9) & 1) << 5); R = (st >> 1) * 16 + swz / 64; C = (st & 1) * 32 + (swz % 64) / 2; }
__host__ __device__ __forceinline__ int perm32(int rho) { const int n = rho >> 4, i = rho & 15; return 8 * (i >> 2) + 4 * n + (i & 3); }

struct Unit { int pm, pn; };
struct Gemm { const bf16_t* A; const bf16_t* Bt; int M, N, K; };

template <int MC, int NC> struct StaticOrderC {
    static constexpr int nM = MC / BM, nN = NC / BM, nwg = nM * nN;
    int G, c;
    __host__ __device__ void init(int G_, int c_) { G = G_; c = c_; }
    __host__ __device__ static void map(int L, Unit& u) {
        int wgid = L; { constexpr int q = nwg / NXCD, r = nwg % NXCD; const int xcd = wgid % NXCD, off = wgid / NXCD; wgid = (xcd < r ? xcd * (q + 1) : r * (q + 1) + (xcd - r) * q) + off; }
        constexpr int nig = WGM * nN; const int gid = wgid / nig, fm = gid * WGM, gsz = (nM - fm) < WGM ? (nM - fm) : WGM;
        u.pm = fm + ((wgid % nig) % gsz); u.pn = (wgid % nig) / gsz;
    }
    __host__ __device__ bool next(int i, Unit& u) const {
        const int L = i * G + c; if (L >= nwg) return false;
        int wgid = L; { constexpr int q = nwg / NXCD, r = nwg % NXCD; const int xcd = wgid % NXCD, off = wgid / NXCD; wgid = (xcd < r ? xcd * (q + 1) : r * (q + 1) + (xcd - r) * q) + off; }
        constexpr int nig = WGM * nN; const int gid = wgid / nig, fm = gid * WGM, gsz = (nM - fm) < WGM ? (nM - fm) : WGM;
        u.pm = fm + ((wgid % nig) % gsz); u.pn = (wgid % nig) / gsz; return true;
    }
    __device__ __forceinline__ void a_ready(const Unit&) const {}
    __device__ __forceinline__ void done(const Unit&) const {}
};

__device__ __forceinline__ unsigned cvt_pk_bf16(float lo, float hi) { unsigned r; asm volatile("v_cvt_pk_bf16_f32 %0, %1, %2" : "=v"(r) : "v"(lo), "v"(hi)); return r; }

template <int KC, int LD, class Epi, class Sched, bool ALIGN_EPI = false, bool SP2 = false, bool HM = false, bool F8 = false>
__device__ __forceinline__ void gemm_phase(PG8_LAS unsigned char* lds, const Gemm g, const Sched& S, const Epi& E, const int wid_) {
    const int wid = __builtin_amdgcn_readfirstlane(wid_);
    int lane_; asm volatile("v_mbcnt_lo_u32_b32 %0, -1, 0\n\tv_mbcnt_hi_u32_b32 %0, -1, %0" : "=v"(lane_));
    const int lane = lane_, tid = wid * 64 + lane, wr = wid >> 2, wc = wid & 3, fr = lane & 15, fq = lane >> 4;
    constexpr int K = KC, nt = K / BK;
    unsigned voffA[2], voffB[2];
#pragma unroll
    for (int i = 0; i < 2; ++i) { int R, C; stage_rc(tid * 16 + i * 8192, R, C); const int Rb = Epi::PERM ? ((R & ~31) + perm32(R & 31)) : R;
        voffA[i] = (unsigned)(R * LD + C) * 2u; voffB[i] = (unsigned)(Rb * LD + C) * 2u; }
    constexpr unsigned kstep = (unsigned)(BK * 2);
    constexpr unsigned hstep = (unsigned)(HALF * LD * 2);
    constexpr unsigned tstep = 2 * hstep;
    const __amdgpu_buffer_rsrc_t rA = __builtin_amdgcn_make_buffer_rsrc((void*)g.A, 0, 0x7fffffff, 0x00020000), rB = __builtin_amdgcn_make_buffer_rsrc((void*)g.Bt, 0, 0x7fffffff, 0x00020000);
    const unsigned ldsw = (unsigned)wid * 1024u;
    const int aoff = lds_byte(wr * 64 + fr, fq * 8), boff = lds_byte(wc * 32 + fr, fq * 8);
#define PG8_SA(b, h) (((b) * 2 + (h)) * HTB)
#define PG8_SB(b, h) ((4 + (b) * 2 + (h)) * HTB)
#define PG8_STAGE_R(rs, bufoff, goff, voff) do { _Pragma("unroll") for (int _i = 0; _i < 2; ++_i) \
        __builtin_amdgcn_raw_ptr_buffer_load_lds(rs, (PG8_LAS unsigned*)(lds + (bufoff) + ldsw + _i * 8192), 16, (voff)[_i], (int)(goff), 0, 0); } while (0)
#define PG8_STAGE_A(bufoff, goff, voff) PG8_STAGE_R(rA, bufoff, goff, voff)
#define PG8_STAGE_B(bufoff, goff, voff) PG8_STAGE_R(rB, bufoff, goff, voff)
#define PG8_LDA(dst, b, h) do { _Pragma("unroll") for (int m = 0; m < 4; ++m) _Pragma("unroll") for (int k = 0; k < 2; ++k) dst[m][k] = *(const PG8_LAS bf16x8*)(lds + PG8_SA(b, h) + aoff + m * 2048 + k * 1024); } while (0)
#define PG8_LDB(dst, b, h) do { _Pragma("unroll") for (int n = 0; n < 2; ++n) _Pragma("unroll") for (int k = 0; k < 2; ++k) dst[n][k] = *(const PG8_LAS bf16x8*)(lds + PG8_SB(b, h) + boff + n * 2048 + k * 1024); } while (0)
#define PG8_CAT(x0, x1) __builtin_shufflevector(__builtin_bit_cast(v4i_t, x0), __builtin_bit_cast(v4i_t, x1), 0, 1, 2, 3, 4, 5, 6, 7)
#define PG8_MMA(ai, bj, At, Bt) do { __builtin_amdgcn_s_setprio(1); if constexpr (F8) { _Pragma("unroll") for (int m = 0; m < 4; ++m) _Pragma("unroll") for (int n = 0; n < 2; ++n) \
        acc[ai][bj][m][n] = __builtin_amdgcn_mfma_scale_f32_16x16x128_f8f6f4(PG8_CAT(Bt[n][0], Bt[n][1]), PG8_CAT(At[m][0], At[m][1]), acc[ai][bj][m][n], 0, 0, 0, 0x7f7f7f7f, 0, 0x7f7f7f7f); } \
        else { _Pragma("unroll") for (int m = 0; m < 4; ++m) _Pragma("unroll") for (int n = 0; n < 2; ++n) _Pragma("unroll") for (int k = 0; k < 2; ++k) \
        acc[ai][bj][m][n] = __builtin_amdgcn_mfma_f32_16x16x32_bf16(Bt[n][k], At[m][k], acc[ai][bj][m][n], 0, 0, 0); } __builtin_amdgcn_s_setprio(0); } while (0)
#define PG8_WAIT_V(n) asm volatile("s_waitcnt vmcnt(" #n ")" ::: "memory")
#define PG8_WAIT_L(n) asm volatile("s_waitcnt lgkmcnt(" #n ")" ::: "memory")
#define PG8_BAR __builtin_amdgcn_s_barrier()
#define PG8_SCHED __builtin_amdgcn_sched_barrier(0)
    Unit cur, nxt; int ui = 0;
    if (!S.next(0, cur)) return;
    f32x4 acc[2][2][4][2];
#pragma unroll
    for (int a = 0; a < 2; ++a)
#pragma unroll
        for (int b = 0; b < 2; ++b)
#pragma unroll
            for (int m = 0; m < 4; ++m)
#pragma unroll
                for (int n = 0; n < 2; ++n) acc[a][b][m][n] = (f32x4){0.f, 0.f, 0.f, 0.f};
    bf16x8 At[4][2], B0[2][2], B1[2][2];
    constexpr unsigned astep = HM ? hstep : tstep;
    unsigned cA = (unsigned)cur.pm * astep, cB = (unsigned)cur.pn * tstep;
    S.a_ready(cur);
    if constexpr (SP2) {
        PG8_STAGE_B(PG8_SB(0, 0), cB, voffB); PG8_STAGE_B(PG8_SB(0, 1), cB + hstep, voffB); PG8_STAGE_A(PG8_SA(0, 0), cA, voffA); PG8_STAGE_A(PG8_SA(0, 1), cA + hstep, voffA);
        if (wr == 1) PG8_BAR;
        PG8_WAIT_V(2); PG8_BAR;
        PG8_STAGE_B(PG8_SB(1, 0), cB + kstep, voffB); PG8_STAGE_A(PG8_SA(1, 0), cA + kstep, voffA); PG8_STAGE_B(PG8_SB(1, 1), cB + hstep + kstep, voffB);
        PG8_WAIT_V(6); PG8_BAR;
    } else {
        PG8_STAGE_B(PG8_SB(0, 0), cB, voffB); PG8_STAGE_A(PG8_SA(0, 0), cA, voffA); PG8_STAGE_B(PG8_SB(0, 1), cB + hstep, voffB); PG8_STAGE_A(PG8_SA(0, 1), cA + hstep, voffA);
        if (wr == 1) PG8_BAR;
        PG8_WAIT_V(4); PG8_BAR;
        PG8_STAGE_B(PG8_SB(1, 0), cB + kstep, voffB); PG8_STAGE_A(PG8_SA(1, 0), cA + kstep, voffA); PG8_STAGE_B(PG8_SB(1, 1), cB + hstep + kstep, voffB);
        PG8_WAIT_V(6); PG8_BAR;
    }
    for (;;) {
        const bool has_next = S.next(ui + 1, nxt);
        const unsigned nA = has_next ? (unsigned)nxt.pm * astep : cA, nB = has_next ? (unsigned)nxt.pn * tstep : cB;
        for (int t = 0; t < nt; t += 2) {
            const bool last = (t == nt - 2);
            const unsigned a1 = cA + (unsigned)(t + 1) * kstep;
            const unsigned a2 = last ? nA : cA + (unsigned)(t + 2) * kstep, b2 = last ? nB : cB + (unsigned)(t + 2) * kstep;
            const unsigned a3 = a2 + kstep, b3 = b2 + kstep;
            if (last && has_next) S.a_ready(nxt);
            if constexpr (Epi::MIDK) { if (t == (nt >> 1)) E.mid(acc, cur, wr, wc, fr, fq); }
            if constexpr (SP2) {
            PG8_LDB(B0, 0, 0); PG8_LDB(B1, 0, 1); PG8_SCHED; PG8_LDA(At, 0, 0); PG8_STAGE_A(PG8_SA(1, 1), a1 + hstep, voffA);
            PG8_WAIT_V(8); PG8_WAIT_L(0); PG8_BAR; PG8_MMA(0, 0, At, B0); PG8_MMA(0, 1, At, B1); PG8_BAR; PG8_SCHED;
            if constexpr (!HM) PG8_LDA(At, 0, 1); PG8_STAGE_B(PG8_SB(0, 0), b2, voffB); PG8_STAGE_B(PG8_SB(0, 1), b2 + hstep, voffB); PG8_STAGE_A(PG8_SA(0, 0), a2, voffA);
            PG8_WAIT_V(8); PG8_WAIT_L(0); PG8_BAR; if constexpr (!HM) { PG8_MMA(1, 0, At, B0); PG8_MMA(1, 1, At, B1); } PG8_BAR; PG8_SCHED;
            PG8_LDB(B0, 1, 0); PG8_LDB(B1, 1, 1); PG8_SCHED; PG8_LDA(At, 1, 0); PG8_STAGE_A(PG8_SA(0, 1), a2 + hstep, voffA);
            PG8_WAIT_V(8); PG8_WAIT_L(0); PG8_BAR; PG8_MMA(0, 0, At, B0); PG8_MMA(0, 1, At, B1); PG8_BAR; PG8_SCHED;
            if constexpr (!HM) PG8_LDA(At, 1, 1); PG8_STAGE_B(PG8_SB(1, 0), b3, voffB); PG8_STAGE_B(PG8_SB(1, 1), b3 + hstep, voffB); PG8_STAGE_A(PG8_SA(1, 0), a3, voffA);
            PG8_WAIT_V(8); PG8_WAIT_L(0); PG8_BAR; if constexpr (!HM) { PG8_MMA(1, 0, At, B0); PG8_MMA(1, 1, At, B1); } PG8_BAR; PG8_SCHED;
            } else {
            PG8_LDB(B0, 0, 0); PG8_SCHED; PG8_LDA(At, 0, 0); PG8_STAGE_A(PG8_SA(1, 1), a1 + hstep, voffA);
            PG8_WAIT_L(8); PG8_BAR; PG8_WAIT_L(0); PG8_MMA(0, 0, At, B0); PG8_BAR; PG8_SCHED;
            PG8_LDB(B1, 0, 1); PG8_STAGE_B(PG8_SB(0, 0), b2, voffB);
            PG8_BAR; PG8_WAIT_L(0); PG8_MMA(0, 1, At, B1); PG8_BAR;
            PG8_LDA(At, 0, 1); PG8_STAGE_A(PG8_SA(0, 0), a2, voffA);
            PG8_BAR; PG8_WAIT_L(0); PG8_MMA(1, 0, At, B0); PG8_BAR; PG8_SCHED;
            PG8_STAGE_B(PG8_SB(0, 1), b2 + hstep, voffB);
            PG8_WAIT_V(6); PG8_BAR; PG8_MMA(1, 1, At, B1); PG8_BAR;
            PG8_LDB(B0, 1, 0); PG8_SCHED; PG8_LDA(At, 1, 0); PG8_STAGE_A(PG8_SA(0, 1), a2 + hstep, voffA);
            PG8_WAIT_L(8); PG8_BAR; PG8_WAIT_L(0); PG8_MMA(0, 0, At, B0); PG8_BAR; PG8_SCHED;
            PG8_LDB(B1, 1, 1); PG8_STAGE_B(PG8_SB(1, 0), b3, voffB);
            PG8_BAR; PG8_WAIT_L(0); PG8_MMA(0, 1, At, B1); PG8_BAR;
            PG8_LDA(At, 1, 1); PG8_STAGE_A(PG8_SA(1, 0), a3, voffA);
            PG8_BAR; PG8_WAIT_L(0); PG8_MMA(1, 0, At, B0); PG8_BAR; PG8_SCHED;
            PG8_STAGE_B(PG8_SB(1, 1), b3 + hstep, voffB);
            PG8_WAIT_V(6); PG8_BAR; PG8_MMA(1, 1, At, B1); PG8_BAR;
            }
        }
        if constexpr (ALIGN_EPI) { if (wr == 0) PG8_BAR; }
        E(acc, cur, wr, wc, fr, fq); S.done(cur);
        if (!has_next) break;
#pragma unroll
        for (int a = 0; a < 2; ++a)
#pragma unroll
            for (int b = 0; b < 2; ++b)
#pragma unroll
                for (int m = 0; m < 4; ++m)
#pragma unroll
                    for (int n = 0; n < 2; ++n) acc[a][b][m][n] = (f32x4){0.f, 0.f, 0.f, 0.f};
        cur = nxt; cA = nA; cB = nB; ++ui;
        if constexpr (ALIGN_EPI) { if (wr == 1) PG8_BAR; }
    }
    PG8_WAIT_V(0);
    if constexpr (!ALIGN_EPI) { if (wr == 0) PG8_BAR; }
    PG8_BAR;
#undef PG8_SA
#undef PG8_SB
#undef PG8_STAGE_R
#undef PG8_STAGE_A
#undef PG8_STAGE_B
#undef PG8_LDA
#undef PG8_LDB
#undef PG8_MMA
#undef PG8_CAT
#undef PG8_WAIT_V
#undef PG8_WAIT_L
#undef PG8_BAR
#undef PG8_SCHED
}
}

#ifndef PG8_SP2
#define PG8_SP2 true
#endif
#ifndef PG8_ALIGN
#define PG8_ALIGN true
#endif
#ifndef MK_SPLIT
#define MK_SPLIT 0
#endif

constexpr int NWAVES = 8;
constexpr int D = 4096, MP = 8192, MS = 128, MTOT = MP + MS, MPAD = 8448, NIN = 18944, DA = 2048, DKV = 256, DSG = 2048;
constexpr int NSEQ = 36, NMOD = 3 * D, SEQ = 2048, WIN = 128;
constexpr int PB8 = D + 128, LD8 = PB8 / 2, K8 = D / 2;
constexpr float SA8 = 32.f, SB8 = 8.f, SWP = 128.f, SMG = 16.f, SWO = 256.f, SH8 = 8.f, SWI = 128.f,
                SQ8 = 16.f, SZA8 = 8.f, SUZ8 = 4.f, SVB8 = 8.f, SG8 = 256.f;
constexpr int LDK = D + 64;
constexpr float ALPHA = 1.4142135623730951f;
constexpr float LN_EPS = 1e-5f;
constexpr float LOG2E = 1.4426950408889634f;
constexpr float QSCALE = 0.125f * LOG2E;
constexpr size_t O_YP = 0, O_YS = 33554432, O_WK = 34078720, O_WV = 34340864, O_NK = 34603008, O_NV = 34668544, O_SV = 34734080, O_END = 35258368;

constexpr size_t MiB = 1u << 20;
constexpr size_t WS_CTL = 0, CTL_ZERO_BYTES = 32768;
constexpr size_t WS_MOD = 1 * MiB;
constexpr size_t WS_WSB = 5 * MiB;
constexpr size_t WS_VST = 6 * MiB;
constexpr size_t WS_RST = 9 * MiB;
constexpr size_t WS_KB = 14 * MiB;
constexpr size_t WS_VB = 19 * MiB;
constexpr size_t WS_WIN = 24 * MiB;
constexpr size_t WS_WP = 328 * MiB;
constexpr size_t WS_WO = 394 * MiB;
constexpr size_t WS_HB = 460 * MiB;
constexpr size_t WS_QB = 528 * MiB;
constexpr size_t WS_ZA = 561 * MiB;
constexpr size_t WS_UZ = 594 * MiB;
constexpr size_t WS_VBB = 627 * MiB;
constexpr size_t WS_VBS = 644 * MiB;
constexpr size_t WS_RR = 660 * MiB;
constexpr size_t WS_SGB = 726 * MiB;
constexpr size_t WS_AB = 792 * MiB;
constexpr size_t WS_MG = 860 * MiB;
constexpr size_t WS_RBUF = 928 * MiB;
constexpr size_t WS_RB0 = 928 * MiB;
constexpr size_t WS_RB1 = 992 * MiB;
constexpr size_t WS_RS = 1056 * MiB;
constexpr size_t WS_X1S = 1058 * MiB;
constexpr size_t WS_ST0 = 1060 * MiB;
constexpr size_t WS_HB8 = 1192 * MiB;
constexpr size_t WS_WIN8 = 1228 * MiB;
constexpr size_t WS_END = 1384 * MiB;
static_assert(WS_HB8 + (size_t)MPAD * PB8 <= WS_WIN8 && WS_WIN8 + 2ull * NIN * PB8 <= WS_END, "d_ws map (fp8)");
static_assert(WS_WIN + 2ull * NIN * LDK * 2 <= WS_WP && WS_WP + 2ull * D * LDK * 2 <= WS_WO && WS_WO + 2ull * D * LDK * 2 <= WS_HB && WS_HB + (size_t)MPAD * LDK * 2 <= WS_QB && WS_AB + (size_t)MPAD * LDK * 2 <= WS_MG && WS_MG + (size_t)MPAD * LDK * 2 <= WS_RBUF, "d_ws map");
static_assert((4096 + 3456) * 4 <= (int)CTL_ZERO_BYTES, "barrier words inside the zeroed region");
constexpr int CW_TMO = 0, CW_CODE = 1, CW_WORK0 = 512, CW_WORK1 = 1024, CW_ADA1 = 192, CW_DONE1 = 256, CW_WORK2 = 1536, CW_BAR = 4096;

constexpr int RING_BYTES = 131072;
constexpr int LDSCTL_OFF = 155648, MISC_OFF = LDSCTL_OFF + 320, PTAB_OFF = LDSCTL_OFF + 512;
constexpr int LDS_BYTES = 159744;

#define GAS __attribute__((address_space(1)))
#define LAS __attribute__((address_space(3)))
typedef unsigned short bf16;
typedef unsigned v4u __attribute__((ext_vector_type(4)));
typedef unsigned v2u __attribute__((ext_vector_type(2)));
typedef float f32x4 __attribute__((ext_vector_type(4)));
typedef float f32x2 __attribute__((ext_vector_type(2)));
typedef GAS unsigned gu32;
#define RLX_AGENT __ATOMIC_RELAXED, __HIP_MEMORY_SCOPE_AGENT
#define LDS_WAIT() asm volatile("s_waitcnt lgkmcnt(0)" ::: "memory")
#define VM_WAIT() asm volatile("s_waitcnt vmcnt(0)" ::: "memory")
__device__ __forceinline__ unsigned f2bf(float f) { unsigned u = __builtin_bit_cast(unsigned, f); return (u + 0x7fffu + ((u >> 16) & 1u)) >> 16; }
__device__ __forceinline__ unsigned pk2(float lo, float hi) { return f2bf(lo) | (f2bf(hi) << 16); }
__device__ __forceinline__ float bflo(unsigned u) { return __builtin_bit_cast(float, u << 16); }
__device__ __forceinline__ float bfhi(unsigned u) { return __builtin_bit_cast(float, u & 0xffff0000u); }
__device__ __forceinline__ unsigned pk4_fp8(float a, float b, float c, float d) { int w = 0; w = __builtin_amdgcn_cvt_pk_fp8_f32(a, b, w, false); w = __builtin_amdgcn_cvt_pk_fp8_f32(c, d, w, true); return (unsigned)w; }
__device__ __forceinline__ int lane_now() { int l; asm volatile("v_mbcnt_lo_u32_b32 %0, -1, 0\n\tv_mbcnt_hi_u32_b32 %0, -1, %0" : "=v"(l)); return l; }
template <int K> __device__ __forceinline__ float xadd(float v) {
    if constexpr (K < 32) return v + __builtin_bit_cast(float, __builtin_amdgcn_ds_swizzle(__builtin_bit_cast(int, v), (K << 10) | 0x1f));
    else { const unsigned u = __builtin_bit_cast(unsigned, v); auto rr = __builtin_amdgcn_permlane32_swap(u, u, false, false); return __builtin_bit_cast(float, (unsigned)rr[0]) + __builtin_bit_cast(float, (unsigned)rr[1]); }
}
template <int K> __device__ __forceinline__ float xmax(float v) {
    if constexpr (K < 32) return fmaxf(v, __builtin_bit_cast(float, __builtin_amdgcn_ds_swizzle(__builtin_bit_cast(int, v), (K << 10) | 0x1f)));
    else { const unsigned u = __builtin_bit_cast(unsigned, v); auto rr = __builtin_amdgcn_permlane32_swap(u, u, false, false); return fmaxf(__builtin_bit_cast(float, (unsigned)rr[0]), __builtin_bit_cast(float, (unsigned)rr[1])); }
}
__device__ __forceinline__ float xadd_wave(float v) { v = xadd<1>(v); v = xadd<2>(v); v = xadd<4>(v); v = xadd<8>(v); v = xadd<16>(v); return xadd<32>(v); }
__device__ __forceinline__ float xmax_wave(float v) { v = xmax<1>(v); v = xmax<2>(v); v = xmax<4>(v); v = xmax<8>(v); v = xmax<16>(v); return xmax<32>(v); }
__device__ __forceinline__ float xadd_32(float v) { v = xadd<1>(v); v = xadd<2>(v); v = xadd<4>(v); v = xadd<8>(v); return xadd<16>(v); }
__device__ __forceinline__ f32x4 f8x4(unsigned w) { const f32x2 a = __builtin_amdgcn_cvt_pk_f32_fp8((int)w, false), b = __builtin_amdgcn_cvt_pk_f32_fp8((int)w, true); return (f32x4){a.x, a.y, b.x, b.y}; }
__device__ __forceinline__ float f8x1(unsigned char b) { return __builtin_amdgcn_cvt_f32_fp8((int)b, 0); }
__device__ __forceinline__ float sigmoidf_(float x) { return __builtin_amdgcn_rcpf(1.0f + __builtin_amdgcn_exp2f(-x * LOG2E)); }
__device__ __forceinline__ float siluf_(float x) { return x * sigmoidf_(x); }

#define XB_TMO      128
#define XB_XCNT(j)  (256  + 64 * (j))
#define XB_XSUB(j)  (1280 + 64 * (j))
#define XB_XGEN(j)  (2304 + 64 * (j))
#define XB_TOP      3328
#define XB_TOPGEN   3392
#define XCD_BAR_WORDS 3456
#define XB_SPIN_CAP (1u << 18)
__device__ __forceinline__ unsigned xb_ld(unsigned* p)              { return __hip_atomic_load(p, __ATOMIC_RELAXED, __HIP_MEMORY_SCOPE_AGENT); }
__device__ __forceinline__ unsigned xb_add(unsigned* p, unsigned v) { return __hip_atomic_fetch_add(p, v, __ATOMIC_RELAXED, __HIP_MEMORY_SCOPE_AGENT); }
__device__ __forceinline__ unsigned xb_xcc_id() { return (unsigned)__builtin_amdgcn_s_getreg((3 << 11) | 20) & 0xFu; }
#define XB_SPIN(cond, bar) do { unsigned _sp = 0; while (cond) { __builtin_amdgcn_s_sleep(1); \
    if ((++_sp & 255u) == 0u) { if (xb_ld(&(bar)[XB_TMO])) break; if (_sp > XB_SPIN_CAP) { atomicAdd(&(bar)[XB_TMO], 1u); break; } } } } while (0)
struct XcdBarrier { unsigned* bar; unsigned x; volatile LAS unsigned* st; };
__device__ __forceinline__ XcdBarrier xcd_barrier_post(unsigned* bar, volatile LAS unsigned* st) {
    XcdBarrier b; b.bar = bar; b.x = xb_xcc_id(); b.st = st;
    if (threadIdx.x == 0) (void)xb_add(&bar[XB_XCNT(b.x)], 1u);
    return b;
}
__device__ __forceinline__ void xcd_barrier_complete(unsigned* bar, unsigned x, unsigned& nloc, unsigned& nx) {
    const unsigned G = gridDim.x * gridDim.y * gridDim.z;
    unsigned sum, cnt, mine, sp = 0u;
    for (;;) {
        sum = 0u; cnt = 0u; mine = 0u;
#pragma unroll
        for (unsigned j = 0; j < 16; ++j) { const unsigned c = xb_ld(&bar[XB_XCNT(j)]); sum += c; cnt += (c > 0u) ? 1u : 0u; mine = (j == x) ? c : mine; }
        if (sum == G) break;
        __builtin_amdgcn_s_sleep(1);
        if ((++sp & 255u) == 0u) { if (xb_ld(&bar[XB_TMO])) break; if (sp > XB_SPIN_CAP) { atomicAdd(&bar[XB_TMO], 1u); break; } }
    }
    nloc = mine > 0u ? mine : 1u; nx = cnt > 0u ? cnt : 1u;
}
__device__ __forceinline__ void xcd_barrier(const XcdBarrier& b, const bool leader) {
    asm volatile("s_waitcnt vmcnt(0)" ::: "memory");
    __syncthreads();
    if (leader) {
        unsigned* bar = b.bar; unsigned bx_ = b.x;
        asm volatile("" : "+s"(bar), "+s"(bx_));
        __builtin_amdgcn_s_waitcnt(0);
        unsigned nloc = b.st[0], nx = b.st[1];
        if (nloc == 0u) { xcd_barrier_complete(bar, bx_, nloc, nx); b.st[0] = nloc; b.st[1] = nx; }
        const unsigned old = xb_add(&bar[XB_XSUB(bx_)], 1u);
        const unsigned gen = old / nloc;
        if (old + 1u == (gen + 1u) * nloc) {
            __builtin_amdgcn_fence(__ATOMIC_RELEASE, "agent");
            asm volatile("s_waitcnt vmcnt(0)" ::: "memory");
            const unsigned og = xb_add(&bar[XB_TOP], 1u);
            const unsigned tg = og / nx;
            if (og + 1u == (tg + 1u) * nx) xb_add(&bar[XB_TOPGEN], 1u);
            else XB_SPIN(xb_ld(&bar[XB_TOPGEN]) == tg, bar);
            __builtin_amdgcn_fence(__ATOMIC_ACQUIRE, "agent");
            xb_add(&bar[XB_XGEN(bx_)], 1u);
            asm volatile("s_waitcnt vmcnt(0)" ::: "memory");
        } else {
            XB_SPIN(xb_ld(&bar[XB_XGEN(bx_)]) == gen, bar);
            __builtin_amdgcn_fence(__ATOMIC_ACQUIRE, "agent");
            asm volatile("s_waitcnt vmcnt(0)" ::: "memory");
        }
    }
    __syncthreads();
}

struct Frame {
    LAS unsigned char* lds;
    unsigned char* ws;
    float* out;
    int tid, lane, wave, bx;
    static constexpr int G = 256;
};
enum { I_XP = 0, I_XS, I_CK, I_CV, I_CP, I_CS, I_WADA, I_BADA, I_WIN, I_SINK, I_SG, I_SB, I_SW, I_SBS, I_WPA, I_WPB, I_WO, I_LNG, I_LNB };
__device__ __forceinline__ const float* inp(const Frame& F, int k) {
    volatile LAS unsigned* t = (volatile LAS unsigned*)(F.lds + PTAB_OFF) + 2 * k;
    const unsigned lo = __builtin_amdgcn_readfirstlane(t[0]), hi = __builtin_amdgcn_readfirstlane(t[1]);
    return (const float*)(const GAS float*)(((unsigned long long)hi << 32) | lo);
}
#define WSP(T, off) ((T*)(F.ws + (off)))
__device__ __forceinline__ int row_seq(int row) { return row < MP ? (row >> 11) : 4 + ((row - MP) >> 2); }

__device__ __forceinline__ void ada_item(Frame& F, int item) {
    const int l = item / 96, cb = item % 96;
    LAS float* sc = (LAS float*)(F.lds);
    LAS float* red = (LAS float*)(F.lds + 40960);
    const float* W = inp(F, I_WADA) + (size_t)l * D * NMOD + cb * 128;
    const float* cp = inp(F, I_CP); const float* cs = inp(F, I_CS);
    const int half = F.lane >> 5, c4 = (F.lane & 31) * 4;
    f32x4 acc[18];
#pragma unroll
    for (int s = 0; s < 18; ++s) acc[s] = (f32x4){0.f, 0.f, 0.f, 0.f};
    f32x4 w[8];
    const float* Wl = W + (size_t)(F.wave * 16) * NMOD + c4;
#pragma unroll
    for (int j = 0; j < 8; ++j) w[j] = __builtin_nontemporal_load((const f32x4*)(Wl + (size_t)j * NMOD));
    const int sq0 = F.tid >> 7, kk = F.tid & 127;
    float cv[9];
    cv[0] = cp[sq0 * D + kk];
#pragma unroll
    for (int j = 1; j < 9; ++j) cv[j] = cs[(sq0 + 4 * j - 4) * D + kk];
    for (int ch = 0; ch < 32; ++ch) {
        LAS float* scb = sc + (ch & 1) * 5120;
#pragma unroll
        for (int j = 0; j < 9; ++j) { const int s = sq0 + 4 * j; scb[kk * 40 + (s < 18 ? s : s + 2)] = siluf_(cv[j]); }
        { const int cn = (ch + 1 < 32 ? ch + 1 : ch) * 128 + kk;
          cv[0] = cp[sq0 * D + cn];
#pragma unroll
          for (int j = 1; j < 9; ++j) cv[j] = cs[(sq0 + 4 * j - 4) * D + cn]; }
        __syncthreads();
#pragma unroll
        for (int h2 = 0; h2 < 2; ++h2) {
            const float* Wn = Wl + (size_t)((h2 == 0 ? ch * 128 + 8 : (ch + 1 < 32 ? (ch + 1) * 128 : ch * 128))) * NMOD;
            f32x4 ac[5];
            { const LAS f32x4* a4 = (const LAS f32x4*)(scb + (F.wave * 16 + h2 * 8) * 40 + half * 20);
#pragma unroll
              for (int s4 = 0; s4 < 5; ++s4) ac[s4] = a4[s4]; }
#pragma unroll
            for (int j = 0; j < 8; ++j) {
                f32x4 an[5];
                if (j + 1 < 8) { const LAS f32x4* a4 = (const LAS f32x4*)(scb + (F.wave * 16 + h2 * 8 + j + 1) * 40 + half * 20);
#pragma unroll
                    for (int s4 = 0; s4 < 5; ++s4) an[s4] = a4[s4]; }
                const f32x4 wv = w[j];
#pragma unroll
                for (int s4 = 0; s4 < 5; ++s4) { const f32x4 a = ac[s4];
                    acc[4 * s4 + 0] += a.x * wv; acc[4 * s4 + 1] += a.y * wv;
                    if (s4 < 4) { acc[4 * s4 + 2] += a.z * wv; acc[4 * s4 + 3] += a.w * wv; } }
                w[j] = __builtin_nontemporal_load((const f32x4*)(Wn + (size_t)j * NMOD));
                if (j + 1 < 8) {
#pragma unroll
                    for (int s4 = 0; s4 < 5; ++s4) ac[s4] = an[s4]; }
                __builtin_amdgcn_sched_barrier(0);
            }
        }
    }
    float* mod = WSP(float, WS_MOD); const float* bada = inp(F, I_BADA);
#pragma unroll
    for (int p = 0; p < 2; ++p) {
        __syncthreads();
#pragma unroll
        for (int s9 = 0; s9 < 9; ++s9) *(LAS f32x4*)(red + (F.wave * 18 + half * 9 + s9) * 128 + c4) = acc[p * 9 + s9];
        __syncthreads();
        for (int i = F.tid; i < 18 * 128; i += 512) { const int r = i >> 7, c = i & 127; float v = 0.f;
#pragma unroll
            for (int w8 = 0; w8 < 8; ++w8) v += red[(w8 * 18 + r) * 128 + c];
            const int sq = (r < 9) ? p * 9 + r : 18 + p * 9 + (r - 9), col = cb * 128 + c;
            mod[(size_t)(l * NSEQ + sq) * NMOD + col] = v + bada[l * NMOD + col]; }
    }
    __syncthreads();
}

__device__ __forceinline__ void tr_load(const float* src, int Nsrc, int lane, float (&v)[32]) {
    unsigned off = (unsigned)((lane >> 5) * Nsrc + (lane & 31)) * 4u; const unsigned step = (unsigned)Nsrc * 8u;
#pragma unroll
    for (int i = 0; i < 32; ++i) { v[i] = __builtin_nontemporal_load((const float*)((const char*)src + off)); off += step; }
}
__device__ __forceinline__ void tr_store(void* dst, int f8, float scale, LAS float* scr, int lane, const float (&v)[32]) {
#pragma unroll
    for (int i = 0; i < 32; ++i) scr[(2 * i + (lane >> 5)) * 33 + (lane & 31)] = v[i];
    LDS_WAIT(); asm volatile("" ::: "memory");
    const int c = lane & 7;
#pragma unroll
    for (int j = 0; j < 4; ++j) { const int n = (lane >> 3) + 8 * j; const LAS float* s = scr + (8 * c) * 33 + n;
        if (f8) { v2u o; o.x = pk4_fp8(s[0 * 33] * scale, s[1 * 33] * scale, s[2 * 33] * scale, s[3 * 33] * scale); o.y = pk4_fp8(s[4 * 33] * scale, s[5 * 33] * scale, s[6 * 33] * scale, s[7 * 33] * scale);
            *(GAS v2u*)((unsigned char*)dst + (size_t)n * PB8 + 8 * c) = o; }
        else { v4u o; o.x = pg8::cvt_pk_bf16(s[0 * 33], s[1 * 33]); o.y = pg8::cvt_pk_bf16(s[2 * 33], s[3 * 33]); o.z = pg8::cvt_pk_bf16(s[4 * 33], s[5 * 33]); o.w = pg8::cvt_pk_bf16(s[6 * 33], s[7 * 33]);
            *(GAS v4u*)((bf16*)dst + (size_t)n * LDK + 8 * c) = o; } }
    LDS_WAIT(); asm volatile("" ::: "memory");
}
__host__ __device__ __forceinline__ int win_row(int c) {
    if (c < 4608) return c;
    if (c < 6656) { const int j = (c - 4608) >> 7, i = (c - 4608) & 127; return 4608 + 256 * j + i; }
    if (c < 8704) return 8704 + (c - 6656);
    if (c < 10752) { const int j = (c - 8704) >> 7, i = (c - 8704) & 127; return 4608 + 256 * j + 128 + i; }
    if (c < 14848) { const int j = (c - 10752) >> 7, i = (c - 10752) & 127; return 10752 + 256 * j + i; }
    { const int j = (c - 14848) >> 7, i = (c - 14848) & 127; return 10752 + 256 * j + 128 + i; }
}
constexpr int I_IN = 64 * 592, I_PA = 32 * 128, I_O = 64 * 128, I_LAYER = I_IN + 2 * I_PA + I_O, I_TR = 2 * I_LAYER, I_WS = 128, I_ALL = I_TR + I_WS;
static_assert(I_TR % 8 == 0 && I_WS % 8 == 0 && I_IN % 8 == 0, "chunks of 8 items never straddle the item kinds");
__device__ __forceinline__ void tr_desc(Frame& F, int it, const float*& src, int& Nsrc, void*& dst, void*& dst2, int& f8, float& scale) {
    const int l = it / I_LAYER; int r = it % I_LAYER; f8 = 0; scale = 1.f; dst2 = nullptr;
    if (r < I_IN) { const int kb = r / 592, nb = r % 592, wrow = win_row(32 * nb); Nsrc = NIN; f8 = 1; scale = SWI;
        src = inp(F, I_WIN) + (size_t)l * D * NIN + (size_t)(64 * kb) * NIN + 32 * nb; dst = WSP(unsigned char, WS_WIN8) + (size_t)l * NIN * PB8 + (size_t)wrow * PB8 + 64 * kb;
        if ((wrow >= 2048 && wrow < 2560) || (wrow >= 8704 && wrow < 10752)) { f8 = 2; dst2 = WSP(bf16, WS_WIN) + (size_t)l * NIN * LDK + (size_t)wrow * LDK + 64 * kb; }
        return; }
    r -= I_IN; Nsrc = D; f8 = 1; scale = SWP;
    if (r < I_PA) { const int kb = r / 128, nb = r % 128;
        src = inp(F, I_WPA) + (size_t)l * DA * D + (size_t)(64 * kb) * D + 32 * nb; dst = WSP(unsigned char, WS_WP) + (size_t)l * D * PB8 + (size_t)(32 * nb) * PB8 + 64 * kb; return; }
    r -= I_PA;
    if (r < I_PA) { const int kb = r / 128, nb = r % 128;
        src = inp(F, I_WPB) + (size_t)l * DSG * D + (size_t)(64 * kb) * D + 32 * nb; dst = WSP(unsigned char, WS_WP) + (size_t)l * D * PB8 + (size_t)(32 * nb) * PB8 + 2048 + 64 * kb; return; }
    r -= I_PA; scale = SWO;
    { const int kb = r / 128, nb = r % 128;
        src = inp(F, I_WO) + (size_t)l * D * D + (size_t)(64 * kb) * D + 32 * nb; dst = WSP(unsigned char, WS_WO) + (size_t)l * D * PB8 + (size_t)(32 * nb) * PB8 + 64 * kb; }
}
__device__ __forceinline__ void copy_chunk(Frame& F, int base, LAS float* scr) {
    if (base >= I_TR) {
        const float* sw = inp(F, I_SW); bf16* Wsb = WSP(bf16, WS_WSB);
        for (int it = base; it < base + 8; ++it) { const int e0 = (it - I_TR) * 2048 + F.lane * 4;
#pragma unroll
            for (int j = 0; j < 8; ++j) { const int e = e0 + j * 256; const f32x4 v = *(const f32x4*)(sw + e); const int s = e & 127, t = (e >> 7) & 127;
                v2u o; o.x = pk2(s <= t ? v.x : 0.f, s + 1 <= t ? v.y : 0.f); o.y = pk2(s + 2 <= t ? v.z : 0.f, s + 3 <= t ? v.w : 0.f);
                *(GAS v2u*)(Wsb + e) = o; } }
        return;
    }
    float va[32], vb[32]; const float* src; int ns; void *da, *db, *da2, *db2; int fa, fb; float sa, sb;
    tr_desc(F, base, src, ns, da, da2, fa, sa); tr_load(src, ns, F.lane, va);
#pragma unroll 1
    for (int j = 0; j < 8; j += 2) {
        tr_desc(F, base + j + 1, src, ns, db, db2, fb, sb); tr_load(src, ns, F.lane, vb);
        tr_store(da, fa != 0, sa, scr, F.lane, va); if (fa == 2) tr_store(da2, 0, 1.f, scr, F.lane, va);
        if (j + 2 < 8) { tr_desc(F, base + j + 2, src, ns, da, da2, fa, sa); tr_load(src, ns, F.lane, va); }
        tr_store(db, fb != 0, sb, scr, F.lane, vb); if (fb == 2) tr_store(db2, 0, 1.f, scr, F.lane, vb);
    }
}

__device__ __forceinline__ int pull8(gu32* q, int nchunks, int& s, int& left, int lane) {
    while (left > 0) { int k = 0; if (lane == 0) k = (int)__hip_atomic_fetch_add((unsigned*)(q + 64 * s), 1u, RLX_AGENT);
        const int c = 8 * __builtin_amdgcn_readfirstlane(k) + s; if (c < nchunks) return 8 * c;
        s = (s + 1) & 7; --left; }
    return -1; }
__device__ __forceinline__ void steal_copies(Frame& F, bool until_done, int q, int quota) {
    gu32* ctl = (gu32*)(F.ws + WS_CTL); LAS float* scr = (LAS float*)(F.lds + F.wave * 16384);
    gu32* head = ctl + (q == 1 ? CW_WORK1 : CW_WORK2); const int n = q == 1 ? I_IN : I_LAYER - I_IN, base = q == 1 ? I_LAYER : I_LAYER + I_IN;
    int sh = F.bx & 7, left = 8;
    for (int it = 0; it < quota; ++it) {
        if (until_done) { unsigned d = 0; if (F.lane == 0) d = __hip_atomic_load((unsigned*)(ctl + CW_DONE1), RLX_AGENT); if ((unsigned)__builtin_amdgcn_readfirstlane(d) >= (unsigned)Frame::G) break; }
        const int v = pull8(head, n / 8, sh, left, F.lane); if (v < 0) break;
        copy_chunk(F, base + v, scr);
    }
}

__device__ __forceinline__ void h_rows(Frame& F, const float* x, int row0, int nrows, int seq, int slice, int l) {
    const int col = slice * 1024 + F.lane * 4;
    const float* md = WSP(float, WS_MOD) + (size_t)(l * NSEQ + seq) * NMOD; bf16* Hb = WSP(bf16, WS_HB); unsigned char* Hb8 = WSP(unsigned char, WS_HB8);
    const bool wb = row0 >= MP || (row0 & 2047) >= 1792;
    f32x4 sh[4], sc[4];
#pragma unroll
    for (int j = 0; j < 4; ++j) { sh[j] = *(const f32x4*)(md + col + 256 * j); sc[j] = *(const f32x4*)(md + D + col + 256 * j) + 1.0f; }
    for (int r0 = 0; r0 < nrows; r0 += 4) {
        f32x4 xv[4][4];
#pragma unroll
        for (int rr = 0; rr < 4; ++rr)
#pragma unroll
            for (int j = 0; j < 4; ++j) xv[rr][j] = __builtin_nontemporal_load((const f32x4*)(x + (size_t)(r0 + rr) * D + col + 256 * j));
#pragma unroll
        for (int rr = 0; rr < 4; ++rr) { const int r = r0 + rr;
#pragma unroll
            for (int j = 0; j < 4; ++j) { const f32x4 v = xv[rr][j] * sc[j] + sh[j];
                *(GAS unsigned*)(Hb8 + (size_t)(row0 + r) * PB8 + col + 256 * j) = pk4_fp8(v.x * SH8, v.y * SH8, v.z * SH8, v.w * SH8);
                if (wb) { v2u o; o.x = pk2(v.x, v.y); o.y = pk2(v.z, v.w); *(GAS v2u*)(Hb + (size_t)(row0 + r) * LDK + col + 256 * j) = o; } } }
    }
}

constexpr int G1_NBF = 18, G1_NF8W = 256 - G1_NBF, G1_UNITS = 33 * 74;
struct OrderF8 { int c;
    __device__ __forceinline__ bool next(int i, pg8::Unit& u) const {
        int L;
        if (i < 8) L = i * 256 + c;
        else { if (c >= G1_NF8W) return false; L = 2048 + (i - 8) * G1_NF8W + c; if (L >= G1_UNITS) return false; }
        pg8::StaticOrderC<MPAD, NIN>::map(L, u); return true; }
    __device__ __forceinline__ void a_ready(const pg8::Unit&) const {}
    __device__ __forceinline__ void done(const pg8::Unit&) const {} };
struct OrderBf { int c;
    __device__ __forceinline__ bool next(int i, pg8::Unit& u) const {
        const int j = c - G1_NF8W; if (i != 0 || j < 0) return false;
        if (j < 8) { u.pm = 8 * (j >> 1) + 7; u.pn = 8 + (j & 1); }
        else { const int jj = j - 8; u.pm = 32; u.pn = jj < 2 ? 8 + jj : 34 + (jj - 2); }
        return true; }
    __device__ __forceinline__ void a_ready(const pg8::Unit&) const {}
    __device__ __forceinline__ void done(const pg8::Unit&) const {} };

__host__ __device__ __forceinline__ bool is_bf16_unit(int pm, int pn) { return ((pn == 8 || pn == 9) && ((pm & 7) == 7 || pm == 32)) || (pm == 32 && pn >= 34 && pn < 42); }
template <bool F8> struct EpiInT {
    static constexpr bool PERM = true, MIDK = false;
    unsigned char* ws; float* outl;
    int l;
    __device__ __forceinline__ void mid(pg8::f32x4 (&)[2][2][4][2], const pg8::Unit&, int, int, int, int) const {}
    __device__ __forceinline__ void operator()(const pg8::f32x4 (&acc)[2][2][4][2], const pg8::Unit& u, int wr, int wc, int fr_, int fq_) const {
        if (F8 && is_bf16_unit(u.pm, u.pn)) return;
        constexpr float DS = F8 ? 1.0f / (SH8 * SWI) : 1.0f;
        const int ln_ = lane_now(), fr = ln_ & 15, fq = ln_ >> 4; (void)fr_; (void)fq_;
        const int row0 = u.pm * 256 + wr * 64 + fr, c8 = wc * 32 + 8 * fq, pn = u.pn;
        if (pn < 8 || (pn >= 10 && pn < 18) || (pn >= 34 && pn < 42)) {
            const int kind = pn < 8 ? 0 : (pn < 18 ? 1 : 2);
            unsigned char* base = kind == 0 ? (ws + WS_QB) + pn * 256 : (kind == 1 ? (ws + WS_ZA) + (pn - 10) * 256 : (ws + WS_VBB) + (pn - 34) * 256);
            const float osc = kind == 0 ? QSCALE * SQ8 : (kind == 1 ? SZA8 : SVB8);
            f32x2* vst = (f32x2*)(ws + WS_VST);
#pragma unroll
            for (int ai = 0; ai < 2; ++ai)
#pragma unroll
                for (int m = 0; m < 4; ++m) { const int row = row0 + ai * 128 + m * 16; unsigned char* rowp = base + (size_t)row * 2048 + c8; float s1 = 0.f, s2 = 0.f;
#pragma unroll
                    for (int bj = 0; bj < 2; ++bj) { f32x4 v0 = acc[ai][bj][m][0] * DS, v1 = acc[ai][bj][m][1] * DS;
                        if (kind == 1) { v0 = (f32x4){siluf_(v0.x), siluf_(v0.y), siluf_(v0.z), siluf_(v0.w)}; v1 = (f32x4){siluf_(v1.x), siluf_(v1.y), siluf_(v1.z), siluf_(v1.w)}; }
                        if (kind == 2) { s1 += (v0.x + v0.y) + (v0.z + v0.w) + (v1.x + v1.y) + (v1.z + v1.w);
                                         s2 += (v0.x * v0.x + v0.y * v0.y) + (v0.z * v0.z + v0.w * v0.w) + (v1.x * v1.x + v1.y * v1.y) + (v1.z * v1.z + v1.w * v1.w); }
                        if (!F8 && kind == 2) {
                            v4u w; w.x = pg8::cvt_pk_bf16(v0.x, v0.y); w.y = pg8::cvt_pk_bf16(v0.z, v0.w); w.z = pg8::cvt_pk_bf16(v1.x, v1.y); w.w = pg8::cvt_pk_bf16(v1.z, v1.w);
                            *(v4u*)((bf16*)(ws + WS_VBS) + (size_t)(row - MP) * 2048 + (pn - 34) * 256 + c8 + bj * 128) = w;
                        } else {
                            v0 = v0 * osc; v1 = v1 * osc;
                            v2u w; w.x = pk4_fp8(v0.x, v0.y, v0.z, v0.w); w.y = pk4_fp8(v1.x, v1.y, v1.z, v1.w);
                            *(v2u*)(rowp + bj * 128) = w; } }
                    if (kind == 2) { s1 = xadd<32>(xadd<16>(s1)); s2 = xadd<32>(xadd<16>(s2));
                        if (fq == 0) vst[(size_t)row * 32 + (pn - 34) * 4 + wc] = (f32x2){s1, s2}; }
                }
        } else if (pn < 10) {
            bf16* base = (bf16*)(ws + (pn == 8 ? WS_KB : WS_VB));
            float* ow = outl + (pn == 8 ? O_WK : O_WV) + (size_t)l * 131072; float* on = outl + (pn == 8 ? O_NK : O_NV) + (size_t)l * 32768;
#pragma unroll
            for (int ai = 0; ai < 2; ++ai)
#pragma unroll
                for (int m = 0; m < 4; ++m) { const int row = row0 + ai * 128 + m * 16; bf16* rowp = base + (size_t)row * 256 + c8;
                    const int rin = wr * 64 + m * 16 + fr;
                    float* fo = nullptr;
                    if (!F8) { if (u.pm < 32) { if ((u.pm & 7) == 7 && ai == 1) fo = ow + ((size_t)(u.pm >> 3) * 128 + rin) * 256; } else if (ai == 0) fo = on + (size_t)rin * 256; }
#pragma unroll
                    for (int bj = 0; bj < 2; ++bj) { const f32x4 v0 = acc[ai][bj][m][0] * DS, v1 = acc[ai][bj][m][1] * DS;
                        v4u w; w.x = pg8::cvt_pk_bf16(v0.x, v0.y); w.y = pg8::cvt_pk_bf16(v0.z, v0.w); w.z = pg8::cvt_pk_bf16(v1.x, v1.y); w.w = pg8::cvt_pk_bf16(v1.z, v1.w);
                        *(v4u*)(rowp + bj * 128) = w;
                        if (fo) { *(f32x4*)(fo + bj * 128 + c8) = v0; *(f32x4*)(fo + bj * 128 + c8 + 4) = v1; } }
                }
        } else if (pn < 34) {
            unsigned char* base = (ws + WS_UZ) + (pn - 18) * 128;
#pragma unroll
            for (int ai = 0; ai < 2; ++ai)
#pragma unroll
                for (int m = 0; m < 4; ++m) { const int row = row0 + ai * 128 + m * 16;
                    const f32x4 u0 = acc[ai][0][m][0] * DS, u1 = acc[ai][0][m][1] * DS, z0 = acc[ai][1][m][0] * DS, z1 = acc[ai][1][m][1] * DS;
                    v2u w; w.x = pk4_fp8(u0.x * siluf_(z0.x) * SUZ8, u0.y * siluf_(z0.y) * SUZ8, u0.z * siluf_(z0.z) * SUZ8, u0.w * siluf_(z0.w) * SUZ8);
                    w.y = pk4_fp8(u1.x * siluf_(z1.x) * SUZ8, u1.y * siluf_(z1.y) * SUZ8, u1.z * siluf_(z1.z) * SUZ8, u1.w * siluf_(z1.w) * SUZ8);
                    *(v2u*)(base + (size_t)row * 2048 + c8) = w; }
        } else {
            const int cb = (pn - 42) * 128 + c8; bf16* RR = (bf16*)(ws + WS_RR); unsigned char* SGB = ws + WS_SGB;
#pragma unroll
            for (int ai = 0; ai < 2; ++ai)
#pragma unroll
                for (int m = 0; m < 4; ++m) { const int row = row0 + ai * 128 + m * 16;
                    float ra[8], sb[8];
#pragma unroll
                    for (int n = 0; n < 2; ++n)
#pragma unroll
                        for (int e = 0; e < 4; ++e) {
                            const float xa = __builtin_amdgcn_fmed3f(acc[ai][0][m][n][e] * (-DS * LOG2E), -60.0f, 60.0f), xb = __builtin_amdgcn_fmed3f(acc[ai][1][m][n][e] * (-DS * LOG2E), -60.0f, 60.0f);
                            const float pa = 1.0f + __builtin_amdgcn_exp2f(xa), pb = 1.0f + __builtin_amdgcn_exp2f(xb), r = __builtin_amdgcn_rcpf(pa * pb);
                            sb[n * 4 + e] = fmaxf(r * pa, 1.52587890625e-05f);
                            ra[n * 4 + e] = fminf(pb, 65536.0f) * (r * pb); }
                    v4u w; w.x = pg8::cvt_pk_bf16(ra[0], ra[1]); w.y = pg8::cvt_pk_bf16(ra[2], ra[3]); w.z = pg8::cvt_pk_bf16(ra[4], ra[5]); w.w = pg8::cvt_pk_bf16(ra[6], ra[7]);
                    *(v4u*)(RR + (size_t)row * D + cb) = w;
                    v2u x; x.x = pk4_fp8(sb[0] * SG8, sb[1] * SG8, sb[2] * SG8, sb[3] * SG8); x.y = pk4_fp8(sb[4] * SG8, sb[5] * SG8, sb[6] * SG8, sb[7] * SG8);
                    *(v2u*)(SGB + (size_t)row * D + cb) = x; }
        }
    }
};

struct EpiMerge {
    static constexpr bool PERM = true, MIDK = true;
    const bf16* RR; const unsigned char* SGB; unsigned char* MG;
    __device__ __forceinline__ void mid(pg8::f32x4 (&acc)[2][2][4][2], const pg8::Unit& u, int wr, int wc, int, int) const {
        const int ln_ = lane_now(), fr = ln_ & 15, fq = ln_ >> 4;
        unsigned off0 = ((unsigned)(u.pm * 256 + wr * 64 + fr) * D + (unsigned)(u.pn * 256 + wc * 32 + 8 * fq)) * 2u;
        asm volatile("" : "+v"(off0));
        v4u w[2][4][2];
#pragma unroll
        for (int ai = 0; ai < 2; ++ai)
#pragma unroll
            for (int m = 0; m < 4; ++m)
#pragma unroll
                for (int bj = 0; bj < 2; ++bj) w[ai][m][bj] = *(const v4u*)((const char*)RR + off0 + (unsigned)((ai * 128 + m * 16) * D * 2) + bj * 256);
#pragma unroll
        for (int ai = 0; ai < 2; ++ai) {
#pragma unroll
            for (int m = 0; m < 4; ++m)
#pragma unroll
                for (int bj = 0; bj < 2; ++bj) { const v4u x = w[ai][m][bj];
                    acc[ai][bj][m][0] = acc[ai][bj][m][0] * ((f32x4){bflo(x.x), bfhi(x.x), bflo(x.y), bfhi(x.y)} * (SB8 / SA8));
                    acc[ai][bj][m][1] = acc[ai][bj][m][1] * ((f32x4){bflo(x.z), bfhi(x.z), bflo(x.w), bfhi(x.w)} * (SB8 / SA8)); }
            asm volatile("" ::: "memory");
        }
    }
    __device__ __forceinline__ void operator()(const pg8::f32x4 (&acc)[2][2][4][2], const pg8::Unit& u, int wr, int wc, int, int) const {
        const int ln_ = lane_now(), fr = ln_ & 15, fq = ln_ >> 4;
        unsigned off0 = (unsigned)(u.pm * 256 + wr * 64 + fr) * D + (unsigned)(u.pn * 256 + wc * 32 + 8 * fq);
        asm volatile("" : "+v"(off0));
        const unsigned offm = (unsigned)(u.pm * 256 + wr * 64 + fr) * (unsigned)PB8 + (unsigned)(u.pn * 256 + wc * 32 + 8 * fq);
        v2u sv[2][4][2];
#pragma unroll
        for (int ai = 0; ai < 2; ++ai)
#pragma unroll
            for (int m = 0; m < 4; ++m)
#pragma unroll
                for (int bj = 0; bj < 2; ++bj) sv[ai][m][bj] = *(const v2u*)(SGB + off0 + (unsigned)((ai * 128 + m * 16) * D) + bj * 128);
#pragma unroll
        for (int ai = 0; ai < 2; ++ai) {
#pragma unroll
            for (int m = 0; m < 4; ++m)
#pragma unroll
                for (int bj = 0; bj < 2; ++bj) { const v2u s = sv[ai][m][bj];
                    const f32x4 v0 = acc[ai][bj][m][0] * (f8x4(s.x) * (SMG / (SB8 * SWP * SG8)));
                    const f32x4 v1 = acc[ai][bj][m][1] * (f8x4(s.y) * (SMG / (SB8 * SWP * SG8)));
                    v2u w; w.x = pk4_fp8(v0.x, v0.y, v0.z, v0.w); w.y = pk4_fp8(v1.x, v1.y, v1.z, v1.w);
                    *(v2u*)(MG + offm + (unsigned)((ai * 128 + m * 16) * PB8) + bj * 128) = w; }
            asm volatile("" ::: "memory");
        }
    }
};

template <int L> struct EpiOutT {
    static constexpr bool PERM = false, MIDK = false;
    const float* xp; const bf16* rb0; const f32x2* st0; const float *g0, *b0;
    const float* gate;
    bf16* rb; f32x2* rst;
    __device__ __forceinline__ void mid(pg8::f32x4 (&)[2][2][4][2], const pg8::Unit&, int, int, int, int) const {}
    __device__ __forceinline__ void operator()(const pg8::f32x4 (&acc)[2][2][4][2], const pg8::Unit& u, int wr, int wc, int fr_, int fq_) const {
        const int ln_ = lane_now(), fr = ln_ & 15, fq = ln_ >> 4; (void)fr_; (void)fq_;
        const unsigned col0 = (unsigned)(u.pn * 256 + wc * 32 + 4 * fq);
        const unsigned rowb = (unsigned)(u.pm * 256 + wr * 64 + fr);
        const unsigned eo0 = rowb * D + col0;
        const char* gb = (const char*)(gate + (size_t)(u.pm >> 3) * NMOD) + col0 * 4u;
        f32x4 gv[2][2], g0v[2][2], b0v[2][2];
#pragma unroll
        for (int bj = 0; bj < 2; ++bj)
#pragma unroll
            for (int n = 0; n < 2; ++n) { gv[bj][n] = *(const f32x4*)(gb + (bj * 128 + n * 16) * 4);
                if (L == 1) { g0v[bj][n] = *(const f32x4*)((const char*)g0 + (col0 + bj * 128 + n * 16) * 4u); b0v[bj][n] = *(const f32x4*)((const char*)b0 + (col0 + bj * 128 + n * 16) * 4u); } }
#pragma unroll
        for (int ap = 0; ap < 4; ++ap) { const int ai = ap >> 1, m0 = (ap & 1) * 2;
            f32x4 xv[2][2][2]; v2u xb[2][2][2]; f32x2 st[2];
#pragma unroll
            for (int mm = 0; mm < 2; ++mm) { const unsigned eo = eo0 + (unsigned)((ai * 128 + (m0 + mm) * 16) * D);
                if (L == 1) st[mm] = st0[rowb + (unsigned)(ai * 128 + (m0 + mm) * 16)];
#pragma unroll
                for (int bj = 0; bj < 2; ++bj)
#pragma unroll
                    for (int n = 0; n < 2; ++n) {
                        if (L == 0) xv[mm][bj][n] = __builtin_nontemporal_load((const f32x4*)((const char*)xp + (eo + bj * 128 + n * 16) * 4u));
                        else xb[mm][bj][n] = *(const v2u*)((const char*)rb0 + (eo + bj * 128 + n * 16) * 2u); } }
#pragma unroll
            for (int mm = 0; mm < 2; ++mm) { const int m = m0 + mm; const unsigned eo = eo0 + (unsigned)((ai * 128 + m * 16) * D); const unsigned row = rowb + (unsigned)(ai * 128 + m * 16);
                float s1 = 0.f, s2 = 0.f;
#pragma unroll
                for (int bj = 0; bj < 2; ++bj)
#pragma unroll
                    for (int n = 0; n < 2; ++n) { f32x4 x;
                        if (L == 0) x = xv[mm][bj][n];
                        else { const v2u w = xb[mm][bj][n]; x = ((f32x4){bflo(w.x), bfhi(w.x), bflo(w.y), bfhi(w.y)} - st[mm].x) * st[mm].y * g0v[bj][n] + b0v[bj][n]; }
                        const f32x4 r = x * ALPHA + gv[bj][n] * (acc[ai][bj][m][n] * (1.0f / (SMG * SWO)));
                        v2u o; o.x = pg8::cvt_pk_bf16(r.x, r.y); o.y = pg8::cvt_pk_bf16(r.z, r.w);
                        *(v2u*)((char*)rb + (eo + bj * 128 + n * 16) * 2u) = o;
                        s1 += (r.x + r.y) + (r.z + r.w); s2 += (r.x * r.x + r.y * r.y) + (r.z * r.z + r.w * r.w); }
                s1 = xadd<32>(xadd<16>(s1)); s2 = xadd<32>(xadd<16>(s2));
                if (fq == 0) rst[(size_t)row * 64 + u.pn * 4 + wc] = (f32x2){s1, s2};
            }
            asm volatile("" ::: "memory");
        }
    }
};

typedef short bf16x8_t __attribute__((ext_vector_type(8)));
typedef short s16x4_t __attribute__((ext_vector_type(4)));
typedef float f32x16 __attribute__((ext_vector_type(16)));
__device__ __forceinline__ s16x4_t vtr(const LAS char* p) { return __builtin_bit_cast(s16x4_t, __builtin_amdgcn_ds_read_tr16_b64_v4i16((LAS s16x4_t*)p)); }
__device__ __forceinline__ bf16x8_t cat8(s16x4_t a, s16x4_t b) { return (bf16x8_t){a[0], a[1], a[2], a[3], b[0], b[1], b[2], b[3]}; }
#define MFMA32(a, b, c) __builtin_amdgcn_mfma_f32_32x32x16_bf16((a), (b), (c), 0, 0, 0)

__device__ __forceinline__ void attn_prompt_unit(Frame& F, int l, int unit) {
    const int kv = unit & 3, n = (unit >> 2) & 15, b = unit >> 6, tid = F.tid, lane = F.lane;
    LAS char* Kl = (LAS char*)F.lds; LAS char* Vl = Kl + 32768;
    const bf16* Kb = WSP(bf16, WS_KB); const bf16* Vb = WSP(bf16, WS_VB); const unsigned char* Qb = WSP(unsigned char, WS_QB); const unsigned char* Za = WSP(unsigned char, WS_ZA); unsigned char* AB = WSP(unsigned char, WS_AB);
    const int rowq0 = b * SEQ + n * 128, rowk0 = rowq0 - 128;
#pragma unroll
    for (int i = 0; i < 4; ++i) { const int idx = tid + 512 * i;
        { const int chunk = idx >> 8, key = idx & 255; v4u v = (v4u){0u, 0u, 0u, 0u};
          if (n > 0 || key >= 128) v = *(const v4u*)(Kb + (size_t)(rowk0 + key) * 256 + kv * 64 + chunk * 8);
          *(LAS v4u*)(Kl + chunk * 4096 + key * 16) = v; }
        { const int dh = idx >> 10, key = (idx >> 2) & 255, c4 = idx & 3; v4u v = (v4u){0u, 0u, 0u, 0u};
          if (n > 0 || key >= 128) v = *(const v4u*)(Vb + (size_t)(rowk0 + key) * 256 + kv * 64 + dh * 32 + c4 * 8);
          *(LAS v4u*)(Vl + dh * 16384 + key * 64 + c4 * 16) = v; } }
    const int h = lane >> 5, r32 = lane & 31, head = kv * 8 + F.wave;
    v2u qn[4];
#pragma unroll
    for (int ks = 0; ks < 4; ++ks) qn[ks] = *(const v2u*)(Qb + (size_t)(rowq0 + r32) * 2048 + head * 64 + 16 * ks + 8 * h);
    __syncthreads();
    const float sink2 = inp(F, I_SINK)[l * 32 + head] * LOG2E;
    const LAS char* kbase = Kl + h * 4096 + r32 * 16;
    const LAS char* vbase = Vl + (4 * h + ((lane & 15) >> 2)) * 64 + ((lane >> 4) & 1) * 32 + (lane & 3) * 8;
#pragma unroll 1
    for (int c = 0; c < 4; ++c) {
        const size_t qrow = (size_t)(rowq0 + 32 * c + r32);
        bf16x8_t qf[4];
#pragma unroll
        for (int ks = 0; ks < 4; ++ks) { const f32x4 a = f8x4(qn[ks].x) * (1.0f / SQ8), b2 = f8x4(qn[ks].y) * (1.0f / SQ8);
            v4u w; w.x = pg8::cvt_pk_bf16(a.x, a.y); w.y = pg8::cvt_pk_bf16(a.z, a.w); w.z = pg8::cvt_pk_bf16(b2.x, b2.y); w.w = pg8::cvt_pk_bf16(b2.z, b2.w);
            qf[ks] = __builtin_bit_cast(bf16x8_t, w); }
        { const size_t qnext = qrow + (c + 1 < 4 ? 32 : 0);
#pragma unroll
            for (int ks = 0; ks < 4; ++ks) qn[ks] = *(const v2u*)(Qb + qnext * 2048 + head * 64 + 16 * ks + 8 * h); }
        unsigned zv[2][4];
#pragma unroll
        for (int dt = 0; dt < 2; ++dt)
#pragma unroll
            for (int g4 = 0; g4 < 4; ++g4) zv[dt][g4] = *(const unsigned*)(Za + qrow * 2048 + head * 64 + 32 * dt + 8 * g4 + 4 * h);
        f32x16 S[5];
#pragma unroll
        for (int k5 = 0; k5 < 5; ++k5)
#pragma unroll
            for (int r = 0; r < 16; ++r) S[k5][r] = 0.f;
        {
          bf16x8_t kf[2][5];
#pragma unroll
          for (int k5 = 0; k5 < 5; ++k5) kf[0][k5] = *(const LAS bf16x8_t*)(kbase + (32 * (c + k5)) * 16);
#pragma unroll
          for (int ks = 0; ks < 4; ++ks) {
              if (ks + 1 < 4) {
#pragma unroll
                  for (int k5 = 0; k5 < 5; ++k5) kf[(ks + 1) & 1][k5] = *(const LAS bf16x8_t*)(kbase + (2 * (ks + 1)) * 4096 + (32 * (c + k5)) * 16); }
              __builtin_amdgcn_sched_barrier(0);
#pragma unroll
              for (int k5 = 0; k5 < 5; ++k5) S[k5] = MFMA32(kf[ks & 1][k5], qf[ks], S[k5]);
              __builtin_amdgcn_sched_barrier(0);
          } }
        float mx = sink2;
#pragma unroll
        for (int k5 = 0; k5 < 5; ++k5) { const bool dead = (n == 0) && (c + k5 < 4);
            float bm = -INFINITY;
#pragma unroll
            for (int r = 0; r < 16; ++r) { const int kk = (r & 3) + 8 * (r >> 2) + 4 * h; float v = S[k5][r];
                if (k5 == 0) v = (kk > r32) ? v : -INFINITY;
                if (k5 == 4) v = (kk <= r32) ? v : -INFINITY;
                S[k5][r] = v; bm = fmaxf(bm, v); }
            mx = fmaxf(mx, dead ? -INFINITY : bm); }
        mx = xmax<32>(mx);
        float ls = 0.f;
#pragma unroll
        for (int k5 = 0; k5 < 5; ++k5) { const float off = ((n == 0) && (c + k5 < 4)) ? INFINITY : mx;
#pragma unroll
            for (int r = 0; r < 16; ++r) { const float p = __builtin_amdgcn_exp2f(S[k5][r] - off); S[k5][r] = p; ls += p; } }
        ls = xadd<32>(ls); ls += __builtin_amdgcn_exp2f(sink2 - mx);
        f32x16 O[2];
#pragma unroll
        for (int r = 0; r < 16; ++r) { O[0][r] = 0.f; O[1][r] = 0.f; }
        {
          s16x4_t vq[2][2][2];
          const LAS char* vp0 = vbase + (32 * c) * 64;
#pragma unroll
          for (int dt = 0; dt < 2; ++dt) { vq[0][dt][0] = vtr(vp0 + dt * 16384); vq[0][dt][1] = vtr(vp0 + dt * 16384 + 512); }
#pragma unroll
          for (int j = 0; j < 10; ++j) { const int k5 = j >> 1, s = j & 1;
              if (j + 1 < 10) { const LAS char* vp = vp0 + (16 * (j + 1)) * 64;
#pragma unroll
                  for (int dt = 0; dt < 2; ++dt) { vq[(j + 1) & 1][dt][0] = vtr(vp + dt * 16384); vq[(j + 1) & 1][dt][1] = vtr(vp + dt * 16384 + 512); } }
              v4u pw; pw.x = pg8::cvt_pk_bf16(S[k5][8 * s + 0], S[k5][8 * s + 1]); pw.y = pg8::cvt_pk_bf16(S[k5][8 * s + 2], S[k5][8 * s + 3]);
              pw.z = pg8::cvt_pk_bf16(S[k5][8 * s + 4], S[k5][8 * s + 5]); pw.w = pg8::cvt_pk_bf16(S[k5][8 * s + 6], S[k5][8 * s + 7]);
              const bf16x8_t pf = __builtin_bit_cast(bf16x8_t, pw);
              __builtin_amdgcn_sched_barrier(0);
#pragma unroll
              for (int dt = 0; dt < 2; ++dt) O[dt] = MFMA32(cat8(vq[j & 1][dt][0], vq[j & 1][dt][1]), pf, O[dt]);
              __builtin_amdgcn_sched_barrier(0);
          } }
        const float inv = SA8 / (SZA8 * ls);
#pragma unroll
        for (int dt = 0; dt < 2; ++dt)
#pragma unroll
            for (int g4 = 0; g4 < 4; ++g4) { const int d0 = head * 64 + 32 * dt + 8 * g4 + 4 * h;
                const f32x4 z = f8x4(zv[dt][g4]);
                *(unsigned*)(AB + qrow * PB8 + d0) = pk4_fp8(O[dt][4 * g4 + 0] * inv * z.x, O[dt][4 * g4 + 1] * inv * z.y, O[dt][4 * g4 + 2] * inv * z.z, O[dt][4 * g4 + 3] * inv * z.w); }
    }
    __syncthreads();
}
__device__ __forceinline__ void attn_sample_unit(Frame& F, int l, int unit) {
    const int kv = unit & 3, b = unit >> 2, h = kv * 8 + F.wave, lane = F.lane, tid = F.tid;
    LAS float* Kf = (LAS float*)F.lds;
    LAS float* Vf = Kf + 8704;
    LAS float* qs = Kf + 17408 + F.wave * 1024;
    LAS float* ps = qs + 256;
    const unsigned char* Qb = WSP(unsigned char, WS_QB); const unsigned char* Za = WSP(unsigned char, WS_ZA); unsigned char* AB = WSP(unsigned char, WS_AB);
    const int row0 = MP + b * 4;
    const float* ck = inp(F, I_CK) + ((size_t)(l * 32 + b) * 128) * 256 + kv * 64;
    const float* cv = inp(F, I_CV) + ((size_t)(l * 32 + b) * 128) * 256 + kv * 64;
    const float* nk = F.out + O_NK + (size_t)(l * 128 + b * 4) * 256 + kv * 64;
    const float* nv = F.out + O_NV + (size_t)(l * 128 + b * 4) * 256 + kv * 64;
    unsigned char zq[4];
#pragma unroll
    for (int t = 0; t < 4; ++t) zq[t] = Za[(size_t)(row0 + t) * 2048 + h * 64 + lane];
    { f32x4 kx[5], vx[5]; unsigned char qv[4];
#pragma unroll
      for (int j = 0; j < 5; ++j) { const int i = tid + 512 * j, ic = i < 132 * 16 ? i : 132 * 16 - 1, key = ic >> 4, d4 = (ic & 15) * 4;
        kx[j] = *(const f32x4*)((key < 128 ? ck + (size_t)key * 256 : nk + (size_t)(key - 128) * 256) + d4);
        vx[j] = *(const f32x4*)((key < 128 ? cv + (size_t)key * 256 : nv + (size_t)(key - 128) * 256) + d4); }
#pragma unroll
      for (int t = 0; t < 4; ++t) qv[t] = Qb[(size_t)(row0 + t) * 2048 + h * 64 + lane];
#pragma unroll
      for (int j = 0; j < 5; ++j) { const int i = tid + 512 * j, key = i >> 4, d4 = (i & 15) * 4;
        if (i < 132 * 16) { LAS float* kd = Kf + key * 65 + d4; kd[0] = kx[j].x; kd[1] = kx[j].y; kd[2] = kx[j].z; kd[3] = kx[j].w;
            *(LAS f32x4*)(Vf + key * 64 + d4) = vx[j]; } }
#pragma unroll
      for (int t = 0; t < 4; ++t) qs[t * 64 + lane] = f8x1(qv[t]) * (1.0f / SQ8); }
    __syncthreads();
    const float sink2 = inp(F, I_SINK)[l * 32 + h] * LOG2E;
    float sc[3][4];
#pragma unroll
    for (int ps_ = 0; ps_ < 3; ++ps_) {
        const int key = ps_ * 64 + lane; const bool inr = key < 132; const LAS float* kr = Kf + (inr ? key : 0) * 65;
        float s[4] = {0.f, 0.f, 0.f, 0.f};
#pragma unroll 4
        for (int d4 = 0; d4 < 16; ++d4) { const float k0 = kr[d4 * 4], k1 = kr[d4 * 4 + 1], k2 = kr[d4 * 4 + 2], k3 = kr[d4 * 4 + 3];
#pragma unroll
            for (int t = 0; t < 4; ++t) { const f32x4 qx = *(const LAS f32x4*)(qs + t * 64 + d4 * 4); s[t] += (qx.x * k0 + qx.y * k1) + (qx.z * k2 + qx.w * k3); } }
#pragma unroll
        for (int t = 0; t < 4; ++t) { const bool ok = inr && (key < 128 ? key > t : (key - 128) <= t); sc[ps_][t] = ok ? s[t] : -INFINITY; }
    }
#pragma unroll
    for (int t = 0; t < 4; ++t) {
        float mx = fmaxf(fmaxf(sc[0][t], sc[1][t]), fmaxf(sc[2][t], sink2));
        mx = xmax_wave(mx);
        float p0 = __builtin_amdgcn_exp2f(sc[0][t] - mx), p1 = __builtin_amdgcn_exp2f(sc[1][t] - mx), p2 = __builtin_amdgcn_exp2f(sc[2][t] - mx);
        float sum = p0 + p1 + p2;
        sum = xadd_wave(sum);
        const float inv = 1.0f / (sum + __builtin_amdgcn_exp2f(sink2 - mx));
        ps[t * 136 + lane] = p0 * inv; ps[t * 136 + 64 + lane] = p1 * inv; if (lane < 8) ps[t * 136 + 128 + lane] = p2 * inv;
    }
    LDS_WAIT(); asm volatile("" ::: "memory");
    float o[4] = {0.f, 0.f, 0.f, 0.f};
#pragma unroll 4
    for (int key = 0; key < 132; ++key) { const float v = Vf[key * 64 + lane];
#pragma unroll
        for (int t = 0; t < 4; ++t) o[t] += ps[t * 136 + key] * v; }
#pragma unroll
    for (int t = 0; t < 4; ++t) { const size_t row = (size_t)(row0 + t); const float z = f8x1(zq[t]) * (1.0f / SZA8);
        AB[row * PB8 + h * 64 + lane] = (unsigned char)(pk4_fp8(o[t] * z * SA8, 0.f, 0.f, 0.f) & 0xffu); }
    __syncthreads();
}
__device__ __forceinline__ void sgu_prompt_unit(Frame& F, int l, int unit, int par) {
    const int g = unit & 7, n = (unit >> 3) & 15, b = unit >> 7, tid = F.tid, lane = F.lane, w = F.wave;
    LAS f32x2* rs = (LAS f32x2*)(F.lds + 65536) + par * 128;
    LAS char* Lw = (LAS char*)F.lds + w * 8192;
    const f32x2* vst = WSP(f32x2, WS_VST); const unsigned char* Vbb = WSP(unsigned char, WS_VBB); const unsigned char* UZ = WSP(unsigned char, WS_UZ); unsigned char* AB = WSP(unsigned char, WS_AB); const bf16* Wsb = WSP(bf16, WS_WSB);
    const int row0 = b * SEQ + n * 128, colw = g * 256 + 32 * w, h = lane >> 5, r32 = lane & 31, ch = lane & 3;
    f32x2 pst[8];
    { const int row = tid >> 2, part = tid & 3;
#pragma unroll
      for (int k = 0; k < 8; ++k) pst[k] = vst[(size_t)(row0 + row) * 32 + part * 8 + k]; }
    v2u xv[8];
#pragma unroll
    for (int i = 0; i < 8; ++i) xv[i] = *(const v2u*)(Vbb + (size_t)(row0 + (lane >> 2) + 16 * i) * 2048 + colw + ch * 8);
    unsigned uzv[4][4];
#pragma unroll
    for (int tb = 0; tb < 4; ++tb)
#pragma unroll
        for (int g4 = 0; g4 < 4; ++g4) uzv[tb][g4] = *(const unsigned*)(UZ + (size_t)(row0 + 32 * tb + r32) * 2048 + colw + 8 * g4 + 4 * h);
    const float* sg = inp(F, I_SG) + l * 2048 + colw + ch * 8; const float* sb = inp(F, I_SB) + l * 2048 + colw + ch * 8;
    const f32x4 g0 = *(const f32x4*)sg, g1 = *(const f32x4*)(sg + 4), b0 = *(const f32x4*)sb, b1 = *(const f32x4*)(sb + 4);
    const float* bs = inp(F, I_SBS) + (size_t)(l * 8 + g) * 128;
    float bst[4];
#pragma unroll
    for (int tb = 0; tb < 4; ++tb) bst[tb] = bs[32 * tb + r32];
    const bf16* Wg = Wsb + (size_t)(l * 8 + g) * 16384 + 8 * h;
    bf16x8_t bfr[20];
#pragma unroll
    for (int tb = 0; tb < 4; ++tb)
#pragma unroll
        for (int ks = 0; ks < 2 * tb + 2; ++ks) bfr[tb * (tb + 1) + ks] = *(const bf16x8_t*)(Wg + (32 * tb + r32) * 128 + 16 * ks);
    { const int row = tid >> 2, part = tid & 3; float s1 = 0.f, s2 = 0.f;
#pragma unroll
      for (int k = 0; k < 8; ++k) { s1 += pst[k].x; s2 += pst[k].y; }
      s1 = xadd<2>(xadd<1>(s1)); s2 = xadd<2>(xadd<1>(s2));
      const float mean = s1 * (1.0f / 2048.0f), var = s2 * (1.0f / 2048.0f) - mean * mean;
      if (part == 0) rs[row] = (f32x2){mean, 1.0f / sqrtf(var + LN_EPS)}; }
    __syncthreads();
    f32x2 stv[8];
#pragma unroll
    for (int i = 0; i < 8; ++i) stv[i] = rs[(lane >> 2) + 16 * i];
#pragma unroll
    for (int i = 0; i < 8; ++i) { const int sp = (lane >> 2) + 16 * i; const v2u x = xv[i]; const f32x2 st = stv[i];
        const f32x4 v0 = (f8x4(x.x) * (1.0f / SVB8) - st.x) * st.y * g0 + b0;
        const f32x4 v1 = (f8x4(x.y) * (1.0f / SVB8) - st.x) * st.y * g1 + b1;
        v4u o; o.x = pg8::cvt_pk_bf16(v0.x, v0.y); o.y = pg8::cvt_pk_bf16(v0.z, v0.w); o.z = pg8::cvt_pk_bf16(v1.x, v1.y); o.w = pg8::cvt_pk_bf16(v1.z, v1.w);
        *(LAS v4u*)(Lw + sp * 64 + ch * 16) = o; }
    LDS_WAIT(); asm volatile("" ::: "memory");
    bf16x8_t af[8];
    { const LAS char* ap = Lw + (8 * h + ((lane & 15) >> 2)) * 64 + ((lane >> 4) & 1) * 32 + (lane & 3) * 8;
#pragma unroll
      for (int ks = 0; ks < 8; ++ks) af[ks] = cat8(vtr(ap + ks * 1024), vtr(ap + ks * 1024 + 256)); }
#pragma unroll
    for (int tb = 0; tb < 4; ++tb) { const int t = 32 * tb + r32; f32x16 a;
#pragma unroll
        for (int r = 0; r < 16; ++r) a[r] = 0.f;
#pragma unroll
        for (int ks = 0; ks < 2 * tb + 2; ++ks) a = MFMA32(af[ks], bfr[tb * (tb + 1) + ks], a);
        const size_t row = (size_t)(row0 + t);
#pragma unroll
        for (int g4 = 0; g4 < 4; ++g4) { const int c0 = colw + 8 * g4 + 4 * h;
            const f32x4 uz = f8x4(uzv[tb][g4]) * (SB8 / SUZ8);
            *(unsigned*)(AB + row * PB8 + 2048 + c0) = pk4_fp8(uz.x * (a[4 * g4 + 0] + bst[tb]), uz.y * (a[4 * g4 + 1] + bst[tb]), uz.z * (a[4 * g4 + 2] + bst[tb]), uz.w * (a[4 * g4 + 3] + bst[tb])); }
    }
    LDS_WAIT(); asm volatile("" ::: "memory");
}
__device__ __forceinline__ void sgu_sample_unit(Frame& F, int l, int b) {
    const int tid = F.tid, c0 = tid * 4, g = c0 >> 8, row0 = MP + b * 4;
    LAS f32x2* rs = (LAS f32x2*)(F.lds);
    const f32x2* vst = WSP(f32x2, WS_VST); const unsigned char* UZ = WSP(unsigned char, WS_UZ); unsigned char* AB = WSP(unsigned char, WS_AB);
    const bf16* Vbs = WSP(bf16, WS_VBS);
    if (tid < 128) { const int row = tid >> 5, k = tid & 31; const f32x2 p = vst[(size_t)(row0 + row) * 32 + k]; float s1 = p.x, s2 = p.y;
        s1 = xadd_32(s1); s2 = xadd_32(s2);
        const float mean = s1 * (1.0f / 2048.0f), var = s2 * (1.0f / 2048.0f) - mean * mean;
        if (k == 0) rs[row] = (f32x2){mean, 1.0f / sqrtf(var + LN_EPS)}; }
    __syncthreads();
    const f32x4 gn = *(const f32x4*)(inp(F, I_SG) + l * 2048 + c0), bi = *(const f32x4*)(inp(F, I_SB) + l * 2048 + c0);
    f32x4 ln[4];
#pragma unroll
    for (int t = 0; t < 4; ++t) { const v2u w = *(const v2u*)(Vbs + (size_t)(b * 4 + t) * 2048 + c0); const f32x2 st = rs[t];
        ln[t] = ((f32x4){bflo(w.x), bfhi(w.x), bflo(w.y), bfhi(w.y)} - st.x) * st.y * gn + bi;
        *(f32x4*)(F.out + O_SV + ((size_t)(l * 32 + b) * 4 + t) * 2048 + c0) = ln[t]; }
    const float* Wg = inp(F, I_SW) + (size_t)(l * 8 + g) * 16384; const float* bs = inp(F, I_SBS) + (size_t)(l * 8 + g) * 128;
#pragma unroll
    for (int t = 0; t < 4; ++t) { f32x4 a = (f32x4){bs[t], bs[t], bs[t], bs[t]};
#pragma unroll
        for (int s = 0; s <= t; ++s) a += Wg[t * 128 + s] * ln[s];
        const f32x4 uz = f8x4(*(const unsigned*)(UZ + (size_t)(row0 + t) * 2048 + c0)) * (SB8 / SUZ8);
        *(unsigned*)(AB + (size_t)(row0 + t) * PB8 + 2048 + c0) = pk4_fp8(uz.x * a.x, uz.y * a.y, uz.z * a.z, uz.w * a.w); }
    __syncthreads();
}

template <int MODE> __device__ __forceinline__ void skinny_gemm(Frame& F, int l, int unit) {
    const int lane = F.lane, w = F.wave, r16 = lane & 15, kq = lane >> 4, rb = w & 1, cb = w >> 1;
    const int rin = 32 * (unit & 3) + 16 * rb + r16, row = MP + rin, n0 = 64 * (unit >> 2), col = n0 + 16 * cb + 4 * kq;
    LAS char* R0 = (LAS char*)F.lds;
    const int lr = lane >> 5, lc = lane & 31;
    const char* Ag[2]; const char* Bg[4];
#pragma unroll
    for (int i = 0; i < 2; ++i) { const int r = 2 * (2 * w + i) + lr; Ag[i] = (const char*)(MODE == 0 ? WSP(unsigned char, WS_AB) : WSP(unsigned char, WS_MG)) + (size_t)(MP + 32 * (unit & 3) + r) * PB8 + ((lc ^ (r & 15)) & 31) * 16; }
#pragma unroll
    for (int i = 0; i < 4; ++i) { const int r = 2 * (4 * w + i) + lr; Bg[i] = (const char*)(MODE == 0 ? WSP(unsigned char, WS_WP) : WSP(unsigned char, WS_WO)) + (size_t)l * D * PB8 + (size_t)(n0 + r) * PB8 + ((lc ^ (r & 15)) & 31) * 16; }
#define SK_STAGE(blk) do { LAS char* Rd = R0 + ((blk) % 3) * 49152; \
        _Pragma("unroll") for (int i = 0; i < 2; ++i) __builtin_amdgcn_global_load_lds((const unsigned*)(Ag[i] + (blk) * 512), (LAS unsigned*)(Rd + (2 * w + i) * 1024), 16, 0, 0); \
        _Pragma("unroll") for (int i = 0; i < 4; ++i) __builtin_amdgcn_global_load_lds((const unsigned*)(Bg[i] + (blk) * 512), (LAS unsigned*)(Rd + 16384 + (4 * w + i) * 1024), 16, 0, 0); } while (0)
    SK_STAGE(0); SK_STAGE(1);
    f32x4 acc = (f32x4){0.f, 0.f, 0.f, 0.f};
#pragma unroll 1
    for (int blk = 0; blk < 8; ++blk) {
        if (blk + 1 < 8) asm volatile("s_waitcnt vmcnt(6)" ::: "memory");
        else asm volatile("s_waitcnt vmcnt(0)" ::: "memory");
        __builtin_amdgcn_s_barrier(); asm volatile("" ::: "memory");
        if (blk + 2 < 8) SK_STAGE(blk + 2);
        if (MODE == 0 && blk == 4) { const v2u x = *(const v2u*)(WSP(bf16, WS_RR) + (size_t)row * D + col); acc = acc * ((f32x4){bflo(x.x), bfhi(x.x), bflo(x.y), bfhi(x.y)} * (SB8 / SA8)); }
        const LAS char* Ab = R0 + (blk % 3) * 49152 + (16 * rb + r16) * 512; const LAS char* Bb = R0 + (blk % 3) * 49152 + 16384 + (16 * cb + r16) * 512;
        pg8::v4i_t fa[4][2], fb[4][2];
#pragma unroll
        for (int u = 0; u < 4; ++u) { const int c0 = ((8 * u + kq) ^ r16) & 31, c1 = ((8 * u + 4 + kq) ^ r16) & 31;
            fa[u][0] = *(const LAS pg8::v4i_t*)(Ab + c0 * 16); fa[u][1] = *(const LAS pg8::v4i_t*)(Ab + c1 * 16);
            fb[u][0] = *(const LAS pg8::v4i_t*)(Bb + c0 * 16); fb[u][1] = *(const LAS pg8::v4i_t*)(Bb + c1 * 16); }
        __builtin_amdgcn_sched_barrier(0);
#pragma unroll
        for (int u = 0; u < 4; ++u)
            acc = __builtin_amdgcn_mfma_scale_f32_16x16x128_f8f6f4(__builtin_shufflevector(fb[u][0], fb[u][1], 0, 1, 2, 3, 4, 5, 6, 7), __builtin_shufflevector(fa[u][0], fa[u][1], 0, 1, 2, 3, 4, 5, 6, 7), acc, 0, 0, 0, 0x7f7f7f7f, 0, 0x7f7f7f7f);
        asm volatile("s_waitcnt lgkmcnt(0)" ::: "memory");
    }
    __builtin_amdgcn_s_barrier(); asm volatile("" ::: "memory");
#undef SK_STAGE
    if (MODE == 0) {
        const unsigned sg = *(const unsigned*)(WSP(unsigned char, WS_SGB) + (size_t)row * D + col);
        const f32x4 v = acc * (f8x4(sg) * (SMG / (SB8 * SWP * SG8)));
        *(unsigned*)(WSP(unsigned char, WS_MG) + (size_t)row * PB8 + col) = pk4_fp8(v.x, v.y, v.z, v.w);
    } else {
        const float* xr = (l == 0 ? inp(F, I_XS) : WSP(float, WS_X1S)) + (size_t)rin * D + col;
        const float* gr = WSP(float, WS_MOD) + (size_t)(l * NSEQ + 4 + (rin >> 2)) * NMOD + 2 * D + col;
        const f32x4 r = *(const f32x4*)xr * ALPHA + *(const f32x4*)gr * (acc * (1.0f / (SMG * SWO)));
        *(f32x4*)(WSP(float, WS_RS) + (size_t)rin * D + col) = r;
    }
}
__device__ __forceinline__ void ln_sample_row(Frame& F, int l, int rin, float* dst, bool hb) {
    const int row = MP + rin, seq = 4 + (rin >> 2), lane = F.lane;
    const float* rp = WSP(float, WS_RS) + (size_t)rin * D + lane * 4;
    f32x4 v[16]; float s1 = 0.f;
#pragma unroll
    for (int j = 0; j < 16; ++j) { v[j] = *(const f32x4*)(rp + 256 * j); s1 += (v[j].x + v[j].y) + (v[j].z + v[j].w); }
    s1 = xadd_wave(s1);
    const float mean = s1 * (1.0f / 4096.0f); float s2 = 0.f;
#pragma unroll
    for (int j = 0; j < 16; ++j) { v[j] = v[j] - mean; s2 += (v[j].x * v[j].x + v[j].y * v[j].y) + (v[j].z * v[j].z + v[j].w * v[j].w); }
    s2 = xadd_wave(s2);
    const float rstd = 1.0f / sqrtf(s2 * (1.0f / 4096.0f) + LN_EPS);
    const float* lg = inp(F, I_LNG) + l * D + lane * 4; const float* lb = inp(F, I_LNB) + l * D + lane * 4;
    const float* md = WSP(float, WS_MOD) + (size_t)(1 * NSEQ + seq) * NMOD + lane * 4; bf16* Hb = WSP(bf16, WS_HB) + (size_t)row * LDK + lane * 4; unsigned char* Hb8 = WSP(unsigned char, WS_HB8) + (size_t)row * PB8 + lane * 4;
#pragma unroll
    for (int j = 0; j < 16; ++j) { const f32x4 o = v[j] * rstd * *(const f32x4*)(lg + 256 * j) + *(const f32x4*)(lb + 256 * j);
        *(f32x4*)(dst + lane * 4 + 256 * j) = o;
        if (hb) { const f32x4 hv = o * (*(const f32x4*)(md + D + 256 * j) + 1.0f) + *(const f32x4*)(md + 256 * j); v2u p; p.x = pk2(hv.x, hv.y); p.y = pk2(hv.z, hv.w); *(GAS v2u*)(Hb + 256 * j) = p;
            *(GAS unsigned*)(Hb8 + 256 * j) = pk4_fp8(hv.x * SH8, hv.y * SH8, hv.z * SH8, hv.w * SH8); } }
}

__device__ __forceinline__ void ln_rows(Frame& F, int l, int row0, int nrows, int seq, int slice, float* dst  ) {
    const int col = slice * 1024 + F.lane * 4; const bool hb = (l == 0);
    f32x4 gn[4], bi[4], sh[4], sc[4];
    const float* md = WSP(float, WS_MOD) + (size_t)(1 * NSEQ + seq) * NMOD; const float* lg = inp(F, I_LNG) + l * D; const float* lb = inp(F, I_LNB) + l * D;
    const f32x2* rst = WSP(f32x2, WS_RST); const bf16* Rb = l == 0 ? WSP(bf16, WS_RB0) : WSP(bf16, WS_RB1); bf16* Hb = WSP(bf16, WS_HB); unsigned char* Hb8 = WSP(unsigned char, WS_HB8); f32x2* st0 = WSP(f32x2, WS_ST0);
    const bool wb = (row0 & 2047) >= 1792;
#pragma unroll
    for (int j = 0; j < 4; ++j) { gn[j] = *(const f32x4*)(lg + col + 256 * j); bi[j] = *(const f32x4*)(lb + col + 256 * j);
        if (hb) { sh[j] = *(const f32x4*)(md + col + 256 * j); sc[j] = *(const f32x4*)(md + D + col + 256 * j) + 1.0f; } else { sh[j] = (f32x4){0.f, 0.f, 0.f, 0.f}; sc[j] = sh[j]; } }
    for (int r0 = 0; r0 < nrows; r0 += 4) {
      f32x2 pp[4]; v2u wv[4][4];
#pragma unroll
      for (int rr = 0; rr < 4; ++rr) pp[rr] = rst[(size_t)(row0 + r0 + rr) * 64 + F.lane];
#pragma unroll
      for (int rr = 0; rr < 4; ++rr)
#pragma unroll
          for (int j = 0; j < 4; ++j) wv[rr][j] = *(const v2u*)(Rb + (size_t)(row0 + r0 + rr) * D + col + 256 * j);
#pragma unroll
      for (int rr = 0; rr < 4; ++rr) { const int r = r0 + rr;
        float s1 = pp[rr].x, s2 = pp[rr].y;
        s1 = xadd_wave(s1); s2 = xadd_wave(s2);
        const float mean = s1 * (1.0f / 4096.0f), var = s2 * (1.0f / 4096.0f) - mean * mean, rstd = 1.0f / sqrtf(var + LN_EPS);
        if (hb && slice == 0 && F.lane == 0) st0[row0 + r] = (f32x2){mean, rstd};
#pragma unroll
        for (int j = 0; j < 4; ++j) { const v2u w = wv[rr][j];
            const f32x4 v = ((f32x4){bflo(w.x), bfhi(w.x), bflo(w.y), bfhi(w.y)} - mean) * rstd * gn[j] + bi[j];
            if (hb) { const f32x4 hv = v * sc[j] + sh[j]; *(GAS unsigned*)(Hb8 + (size_t)(row0 + r) * PB8 + col + 256 * j) = pk4_fp8(hv.x * SH8, hv.y * SH8, hv.z * SH8, hv.w * SH8);
                if (wb) { v2u o; o.x = pk2(hv.x, hv.y); o.y = pk2(hv.z, hv.w); *(GAS v2u*)(Hb + (size_t)(row0 + r) * LDK + col + 256 * j) = o; } }
            else *(f32x4*)(dst + (size_t)r * D + col + 256 * j) = v; }
      }
    }
}

struct Args { const float* in[19]; float* out; unsigned char* ws; int ph_lo, ph_hi; };
#ifndef PH_MASK
#define PH_MASK 0xfff
#endif
__global__ void __launch_bounds__(NWAVES * 64, 2) mk_fwd(Args args) {
    extern __shared__ __attribute__((aligned(16))) unsigned char lds[];
    Frame F;
    F.lds = (LAS unsigned char*)lds;
    volatile LAS unsigned* MISC = (volatile LAS unsigned*)(F.lds + MISC_OFF);
    F.tid = threadIdx.x; F.lane = F.tid & 63; F.wave = __builtin_amdgcn_readfirstlane(F.tid >> 6); F.bx = blockIdx.x;
    F.ws = args.ws; F.out = args.out;
    gu32* ctl = (gu32*)(F.ws + WS_CTL);
    asm volatile("s_setreg_imm32_b32 hwreg(HW_REG_MODE, 23, 1), 1");
    for (int u = F.tid; u < (LDS_BYTES - LDSCTL_OFF) / 4; u += NWAVES * 64) ((LAS unsigned*)(F.lds + LDSCTL_OFF))[u] = 0u;
    __syncthreads();
    if (F.tid == 0) { volatile LAS unsigned long long* pt = (volatile LAS unsigned long long*)(F.lds + PTAB_OFF);
#pragma unroll
        for (int k = 0; k < 19; ++k) pt[k] = (unsigned long long)args.in[k]; }
    __syncthreads();
#if MK_SPLIT
    const int lo = args.ph_lo, hi = args.ph_hi;
#else
    constexpr int lo = 0, hi = 12;
#endif
    const bool use_bar = (hi - lo) > 1;
    XcdBarrier bar; bar.bar = (unsigned*)(ctl + CW_BAR); bar.x = 0; bar.st = nullptr;
    if (use_bar) bar = xcd_barrier_post((unsigned*)(ctl + CW_BAR), MISC + 8);
#define IN(k) (((PH_MASK >> ((k) > 6 ? (k) - 5 : (k))) & 1) && lo <= (k) && (k) < hi)
#define SEAM(k) do { if (lo <= (k) && (k) + 1 < hi) { REFRESH(); xcd_barrier(bar, F.tid == 0); } } while (0)
#define REFRESH() do { int t_, w_ = wave0, b_ = bx0; asm volatile("v_mbcnt_lo_u32_b32 %0, -1, 0\n\tv_mbcnt_hi_u32_b32 %0, -1, %0" : "=v"(t_), "+s"(w_), "+s"(b_)); F.lane = t_; F.wave = w_; F.bx = b_; F.tid = w_ * 64 + t_; } while (0)
#define GW (F.bx * NWAVES + F.wave)
    const int NGW = F.G * NWAVES; const int wave0 = F.wave, bx0 = F.bx;

    if (IN(0)) {
        asm volatile("; MARK_P0a");
        REFRESH();
        if (F.bx < 192) ada_item(F, F.bx);
        LAS float* scr = (LAS float*)(F.lds + F.wave * 16384);
        int sh = F.bx & 7, left = 8;
        for (;;) {
            const int v = pull8(ctl + CW_WORK0, (I_LAYER + I_WS) / 8, sh, left, F.lane);
            if (v < 0) break;
            copy_chunk(F, v < I_LAYER ? I_LAYER - 8 - v : I_TR + (v - I_LAYER), scr);
        }
    }
    SEAM(0);
    if (IN(1)) {
        asm volatile("; MARK_P0b");
        REFRESH();
        for (int it = GW; it < 2048 + 128; it += NGW) {
            if (it < 2048) { const int rb = it >> 2, sl = it & 3; h_rows(F, inp(F, I_XP) + (size_t)rb * 16 * D, rb * 16, 16, rb >> 7, sl, 0); }
            else { const int q = it - 2048, sq = q >> 2, sl = q & 3; h_rows(F, inp(F, I_XS) + (size_t)sq * 4 * D, MP + sq * 4, 4, 4 + sq, sl, 0); }
        }
    }
    SEAM(1);
#pragma unroll 1
    for (int l = 0; l < 2; ++l) {
        const int pb = 2 + 5 * l;
        if (IN(pb)) {
            asm volatile("; MARK_GEMM1");
            REFRESH();
            { pg8::Gemm g8{WSP(bf16, WS_HB8), (const bf16*)(WSP(unsigned char, WS_WIN8) + (size_t)l * NIN * PB8), MPAD, NIN, K8};
              OrderF8 S; S.c = F.bx; EpiInT<true> E{F.ws, F.out, l};
              pg8::gemm_phase<K8, LD8, EpiInT<true>, OrderF8, PG8_ALIGN, PG8_SP2, false, true>(F.lds, g8, S, E, F.wave); }
            REFRESH();
            { pg8::Gemm g{WSP(bf16, WS_HB), WSP(bf16, WS_WIN) + (size_t)l * NIN * LDK, MPAD, NIN, D};
              OrderBf S; S.c = F.bx; EpiInT<false> E{F.ws, F.out, l};
              pg8::gemm_phase<D, LDK, EpiInT<false>, OrderBf, PG8_ALIGN, PG8_SP2>(F.lds, g, S, E, F.wave); }
            if (l == 0) {
                REFRESH();
                if (F.tid == 0) (void)__hip_atomic_fetch_add((unsigned*)(ctl + CW_DONE1), 1u, RLX_AGENT);
                if (F.bx >= G1_UNITS - 2048 - G1_NF8W && F.bx < G1_NF8W) steal_copies(F, true, 1, 3);
            } else {
                REFRESH();
                if (F.bx >= G1_UNITS - 2048 - G1_NF8W && F.bx < G1_NF8W) steal_copies(F, false, 2, 1 << 20);
            }
        }
        SEAM(pb);
        if (IN(pb + 1)) {
            asm volatile("; MARK_MIX");
            REFRESH();
            for (int u = F.bx; u < 256; u += F.G) attn_prompt_unit(F, l, u);
            REFRESH();
            { int par = 0; for (int u = F.bx; u < 512; u += F.G) { sgu_prompt_unit(F, l, u, par); par ^= 1; } }
            __syncthreads();
            REFRESH();
            for (int u = F.bx; u < 128; u += F.G) attn_sample_unit(F, l, u);
            REFRESH();
            for (int u = F.bx - 128; u < 32; u += F.G) if (u >= 0) sgu_sample_unit(F, l, u);
            if (F.bx >= 160) {
                const unsigned char* wp = WSP(unsigned char, WS_WP) + (size_t)l * D * PB8; const unsigned char* wo = WSP(unsigned char, WS_WO) + (size_t)l * D * PB8;
                constexpr unsigned NB16 = (unsigned)((size_t)D * PB8 / 16);
                unsigned acc_ = 0;
                static_assert(NB16 == 22u * 96u * 512u, "22 pieces of each matrix per thread");
                const unsigned i0 = (unsigned)(F.bx - 160) * 512u + (unsigned)F.tid;
#pragma unroll
                for (int hh = 0; hh < 2; ++hh) { v4u a[11], b[11];
#pragma unroll
                    for (int j = 0; j < 11; ++j) { const size_t o = (size_t)(i0 + (unsigned)(hh * 11 + j) * 96u * 512u) * 16; a[j] = *(const v4u*)(wp + o); b[j] = *(const v4u*)(wo + o); }
#pragma unroll
                    for (int j = 0; j < 11; ++j) acc_ |= (a[j].x ^ b[j].x) & (a[j].y ^ b[j].y) & (a[j].z ^ b[j].z) & (a[j].w ^ b[j].w); }
                if (acc_ == 0x12345678u && F.tid == 99999) WSP(unsigned, WS_CTL)[8000] = acc_;
            }
        }
        SEAM(pb + 1);
        if (IN(pb + 2)) {
            asm volatile("; MARK_GEMM2");
            REFRESH();
            pg8::Gemm g{WSP(bf16, WS_AB), (const bf16*)(WSP(unsigned char, WS_WP) + (size_t)l * D * PB8), MP, D, K8}; pg8::StaticOrderC<MP, D> S; S.init(F.G, F.bx);
            EpiMerge E{WSP(bf16, WS_RR), WSP(unsigned char, WS_SGB), WSP(unsigned char, WS_MG)};
            if (F.bx & 8) { skinny_gemm<0>(F, l, F.bx); REFRESH(); }
            pg8::gemm_phase<K8, LD8, EpiMerge, pg8::StaticOrderC<MP, D>, PG8_ALIGN, PG8_SP2, false, true>(F.lds, g, S, E, F.wave);
            REFRESH();
            if (!(F.bx & 8)) skinny_gemm<0>(F, l, F.bx);
        }
        SEAM(pb + 2);
        if (IN(pb + 3)) {
            asm volatile("; MARK_GEMM3");
            REFRESH();
            pg8::Gemm g{WSP(bf16, WS_MG), (const bf16*)(WSP(unsigned char, WS_WO) + (size_t)l * D * PB8), MP, D, K8}; pg8::StaticOrderC<MP, D> S; S.init(F.G, F.bx);
            if (F.bx & 8) { skinny_gemm<1>(F, l, F.bx); REFRESH(); }
            if (l == 0) { EpiOutT<0> E{inp(F, I_XP), nullptr, nullptr, nullptr, nullptr, WSP(float, WS_MOD) + 2 * D, WSP(bf16, WS_RB0), WSP(f32x2, WS_RST)};
                pg8::gemm_phase<K8, LD8, EpiOutT<0>, pg8::StaticOrderC<MP, D>, PG8_ALIGN, PG8_SP2, false, true>(F.lds, g, S, E, F.wave); }
            else { EpiOutT<1> E{nullptr, WSP(bf16, WS_RB0), WSP(f32x2, WS_ST0), inp(F, I_LNG), inp(F, I_LNB), WSP(float, WS_MOD) + (size_t)NSEQ * NMOD + 2 * D, WSP(bf16, WS_RB1), WSP(f32x2, WS_RST)};
                pg8::gemm_phase<K8, LD8, EpiOutT<1>, pg8::StaticOrderC<MP, D>, PG8_ALIGN, PG8_SP2, false, true>(F.lds, g, S, E, F.wave); }
            REFRESH();
            if (!(F.bx & 8)) skinny_gemm<1>(F, l, F.bx);
        }
        SEAM(pb + 3);
        if (IN(pb + 4)) {
            asm volatile("; MARK_LN");
            REFRESH();
            float* dp = F.out + O_YP; float* ds = l == 0 ? WSP(float, WS_X1S) : F.out + O_YS;
            for (int it = GW; it < 2048 + 128; it += NGW) {
                if (it < 2048) { const int rb = it >> 2, sl = it & 3; ln_rows(F, l, rb * 16, 16, rb >> 7, sl, dp + (size_t)rb * 16 * D); }
                else { const int rin = it - 2048; ln_sample_row(F, l, rin, ds + (size_t)rin * D, l == 0); }
            }
            if (l == 0) steal_copies(F, false, 1, 1 << 20);
        }
        if (l == 0) SEAM(pb + 4);
    }
#undef IN
#undef SEAM
}

extern "C" void kernel_launch(void* const* d_in, const int* in_sizes, int n_in, void* d_out, int out_size, void* d_ws, size_t ws_size, hipStream_t stream) {
    static int grid = 0;
    if (grid == 0) {
        if (n_in != 19 || out_size != (int)O_END || ws_size < WS_END) { fprintf(stderr, "kernel_launch: unexpected sizes (n_in %d, out %d, ws %zu); nothing launched\n", n_in, out_size, ws_size); grid = -1; return; }
        int dev = 0, cus = 0, per_cu = 0;
        if (hipGetDevice(&dev) != hipSuccess || hipDeviceGetAttribute(&cus, hipDeviceAttributeMultiprocessorCount, dev) != hipSuccess) { grid = -1; return; }
        if (hipFuncSetAttribute((const void*)mk_fwd, hipFuncAttributeMaxDynamicSharedMemorySize, LDS_BYTES) != hipSuccess) { fprintf(stderr, "kernel_launch: hipFuncSetAttribute failed\n"); grid = -1; return; }
        if (hipOccupancyMaxActiveBlocksPerMultiprocessor(&per_cu, (const void*)mk_fwd, NWAVES * 64, LDS_BYTES) != hipSuccess || per_cu < 1)
            fprintf(stderr, "kernel_launch: note: occupancy query reports %d workgroups per CU\n", per_cu);
        (void)hipGetLastError();
        if (cus != Frame::G) { fprintf(stderr, "kernel_launch: built for a %d-CU device, found %d CUs; nothing launched\n", Frame::G, cus); grid = -1; return; }
        grid = cus;
    }
    if (grid < 0) return;
    if (hipMemsetAsync((char*)d_ws + WS_CTL, 0, CTL_ZERO_BYTES, stream) != hipSuccess) return;
    Args a{};
    for (int i = 0; i < 19; ++i) a.in[i] = (const float*)d_in[i];
    a.out = (float*)d_out; a.ws = (unsigned char*)d_ws;
#if MK_SPLIT
    for (int p = 0; p < 12; ++p) { a.ph_lo = p; a.ph_hi = p + 1; hipLaunchKernelGGL(mk_fwd, dim3(grid), dim3(NWAVES * 64), LDS_BYTES, stream, a); }
#else
    a.ph_lo = 0; a.ph_hi = 12;
    hipLaunchKernelGGL(mk_fwd, dim3(grid), dim3(NWAVES * 64), LDS_BYTES, stream, a);
#endif
    const hipError_t le = hipPeekAtLastError();
    if (le != hipSuccess) fprintf(stderr, "kernel_launch: launch failed: %s\n", hipGetErrorName(le));
}
```
